# Optimizing an MI355X kernel written in HIP

```python
import jax
import jax.numpy as jnp
from jax import lax
import numpy as np


D_MODEL = 1024
BATCH = 4
SEQ = 4096
DEPTH = 4

GRID_W = 64
CTX_LEN = 256
HEAD_DIM = 64
A_HEADS = 8
A_KV = 2
R_HEADS = 4
R_DK = 64
R_DV = 128
C_HEADS = 8
C_KV = 2
WINDOW = 128
BLOCK = 128
ROPE_BASE = 10000.0
D_FF = 2816
N_EXPERTS = 8
TOP_K = 2
D_FF_EXPERT = 3584
N_DENSE = (DEPTH + 1) // 2
N_MOE = DEPTH // 2
EPS = 1e-6
NEG = -1e30
COL_SIZES = (A_HEADS * HEAD_DIM, A_KV * HEAD_DIM, A_KV * HEAD_DIM,
             R_HEADS * R_DK, R_HEADS * R_DK, R_HEADS * R_DV, R_HEADS * R_DV,
             C_HEADS * HEAD_DIM, C_KV * HEAD_DIM, C_KV * HEAD_DIM,
             3 * D_MODEL)
IN_COLS = sum(COL_SIZES)

kernel_name = "hybrid_dit_gated_branch_block"


def _rmsnorm(x, g):
    x32 = x.astype(jnp.float32)
    y = x32 * lax.rsqrt(jnp.mean(x32 * x32, axis=-1, keepdims=True) + EPS)
    return (y * g.astype(jnp.float32)).astype(x.dtype)


def _modulate(h, shift, scale):
    return h * (1.0 + scale) + shift


def _heads(t, n):
    return t.reshape(t.shape[0], t.shape[1], n, -1)


def _flip(t):
    return None if t is None else t[:, ::-1]


def _rms_heads(t, g):
    t32 = t.astype(jnp.float32)
    y = t32 * lax.rsqrt(jnp.mean(t32 * t32, axis=-1, keepdims=True) + EPS)
    return (y * g.astype(jnp.float32)).astype(t.dtype)


def _rope_tables(row, col, dim):
    n_freq = dim // 4
    inv = ROPE_BASE ** (-jnp.arange(n_freq, dtype=jnp.float32) / n_freq)
    ang = jnp.concatenate([row[:, None] * inv[None, :], col[:, None] * inv[None, :]], axis=-1)
    return jnp.cos(ang), jnp.sin(ang)


def _rope(t, cos, sin):
    half = t.shape[-1] // 2
    cs = cos[None, :, None, :].astype(t.dtype)
    sn = sin[None, :, None, :].astype(t.dtype)
    t1, t2 = t[..., :half], t[..., half:]
    return jnp.concatenate([t1 * cs - t2 * sn, t1 * sn + t2 * cs], axis=-1)


def _split_cols(p):
    out, off = [], 0
    for n in COL_SIZES:
        out.append(p[..., off:off + n])
        off += n
    return out


def _gqa_attend(q, k, v):
    B, Q, Hq, dh = q.shape
    Hkv = k.shape[2]
    qg = q.reshape(B, Q, Hkv, Hq // Hkv, dh)
    s = jnp.einsum('bqkgd,bskd->bkgqs', qg, k).astype(jnp.float32) * (dh ** -0.5)
    p = jax.nn.softmax(s, axis=-1).astype(v.dtype)
    o = jnp.einsum('bkgqs,bskd->bqkgd', p, v)
    return o.reshape(B, Q, Hq * dh)


def _gqa_blocked(q, k, v):
    B, S, Hq, dh = q.shape
    nb = S // BLOCK
    qb = q.reshape(B, nb, BLOCK, Hq, dh).transpose(1, 0, 2, 3, 4)
    o = lax.map(lambda qblk: _gqa_attend(qblk, k, v), qb)
    return o.transpose(1, 0, 2, 3).reshape(B, S, Hq * dh)


def _window_sink_attend(q, k_lat, v_lat, k_ctx, v_ctx, sink):
    B, S, Hq, dh = q.shape
    Hkv = k_lat.shape[2]
    G = Hq // Hkv
    nb = S // BLOCK
    qb = q.reshape(B, nb, BLOCK, Hkv, G, dh)

    def band(t):
        tp = jnp.pad(t, ((0, 0), (BLOCK, BLOCK), (0, 0), (0, 0))).reshape(B, nb + 2, BLOCK, Hkv, dh)
        return jnp.concatenate([tp[:, :-2], tp[:, 1:-1], tp[:, 2:]], axis=2)

    kb, vb = band(k_lat), band(v_lat)
    scale = dh ** -0.5
    s_loc = jnp.einsum('bnqkgd,bnskd->bnkgqs', qb, kb).astype(jnp.float32) * scale
    blk = jnp.arange(nb)[:, None] * BLOCK
    qpos = blk + jnp.arange(BLOCK)[None, :]
    kpos = blk - BLOCK + jnp.arange(3 * BLOCK)[None, :]
    kp = kpos[:, None, :]
    valid = (jnp.abs(kp - qpos[:, :, None]) <= WINDOW) & (kp >= 0) & (kp < S)
    s_loc = jnp.where(valid[None, :, None, None], s_loc, NEG)
    s_ctx = jnp.einsum('bnqkgd,bskd->bnkgqs', qb, k_ctx).astype(jnp.float32) * scale
    snk = sink.astype(jnp.float32).reshape(1, 1, Hkv, G, 1, 1)
    m = jnp.maximum(jnp.maximum(s_loc.max(-1, keepdims=True), s_ctx.max(-1, keepdims=True)), snk)
    e_loc = jnp.exp(s_loc - m)
    e_ctx = jnp.exp(s_ctx - m)
    denom = e_loc.sum(-1, keepdims=True) + e_ctx.sum(-1, keepdims=True) + jnp.exp(snk - m)
    o = (jnp.einsum('bnkgqs,bnskd->bnqkgd', (e_loc / denom).astype(v_lat.dtype), vb)
         + jnp.einsum('bnkgqs,bskd->bnqkgd', (e_ctx / denom).astype(v_lat.dtype), v_ctx))
    return o.reshape(B, S, Hq * dh)


def _sink_attend(q, k, v, sink):
    B, Q, Hq, dh = q.shape
    Hkv = k.shape[2]
    G = Hq // Hkv
    qg = q.reshape(B, Q, Hkv, G, dh)
    s = jnp.einsum('bqkgd,bskd->bkgqs', qg, k).astype(jnp.float32) * (dh ** -0.5)
    snk = sink.astype(jnp.float32).reshape(1, Hkv, G, 1, 1)
    m = jnp.maximum(s.max(-1, keepdims=True), snk)
    e = jnp.exp(s - m)
    denom = e.sum(-1, keepdims=True) + jnp.exp(snk - m)
    o = jnp.einsum('bkgqs,bskd->bqkgd', (e / denom).astype(v.dtype), v)
    return o.reshape(B, Q, Hq * dh)


def _chunk_retention(q, k, v, log_gamma, state0):
    B, T, H, dk = k.shape
    dv = v.shape[-1]
    n = T // BLOCK
    kc = k.astype(jnp.float32).reshape(B, n, BLOCK, H, dk)
    vc = v.astype(jnp.float32).reshape(B, n, BLOCK, H, dv)
    pos = jnp.arange(BLOCK, dtype=jnp.float32)
    to_end = jnp.exp((BLOCK - 1.0 - pos)[:, None] * log_gamma[None, :])
    kv = jnp.einsum('bnjhd,jh,bnjhe->nbhde', kc, to_end, vc)
    chunk_decay = jnp.exp(BLOCK * log_gamma)[None, :, None, None]

    def step(state, kv_n):
        return state * chunk_decay + kv_n, state

    final, prev = lax.scan(step, state0, kv)
    if q is None:
        return None, final
    qc = q.astype(jnp.float32).reshape(B, n, BLOCK, H, dk)
    rel = pos[:, None] - pos[None, :]
    decay = jnp.where(rel >= 0, jnp.exp(jnp.maximum(rel, 0.0)[None] * log_gamma[:, None, None]), 0.0)
    scores = jnp.einsum('bnihd,bnjhd->bnhij', qc, kc) * decay
    intra = jnp.einsum('bnhij,bnjhe->bnihe', scores, vc)
    from_start = jnp.exp((pos + 1.0)[:, None] * log_gamma[None, :])
    inter = jnp.einsum('bnihd,ih,nbhde->bnihe', qc, from_start, prev)
    return (intra + inter).reshape(B, T, H, dv), final


def _retention_out(o, g, gain):
    B, T, H, dv = o.shape
    mu = jnp.mean(o, axis=-1, keepdims=True)
    var = jnp.mean((o - mu) ** 2, axis=-1, keepdims=True)
    y = ((o - mu) * lax.rsqrt(var + EPS)).reshape(B, T, H * dv) * gain.astype(jnp.float32)
    return jax.nn.silu(g) * y.astype(g.dtype)


def _merge(ya, yr, yc, gl, b_gate, w_br_a, w_br_b, w_br_c, w_out):
    ga, gb, gc = jnp.split(jax.nn.sigmoid(gl + b_gate), 3, axis=-1)
    m = ga * (ya @ w_br_a) + gb * (yr @ w_br_b) + gc * (yc @ w_br_c)
    return m @ w_out


def _token_mixer(h_lat, h_ctx, w_in, b_gate, qn_a, kn_a, ret_a, ret_g, sink_c,
                 w_br_a, w_br_b, w_br_c, w_out, cos, sin, need_ctx):
    B = h_lat.shape[0]
    qa, ka, va, qr, kr, vr, gr, qc, kc, vc, gl = _split_cols(h_lat @ w_in)
    qa_x, ka_x, va_x, qr_x, kr_x, vr_x, gr_x, qc_x, kc_x, vc_x, gl_x = _split_cols(h_ctx @ w_in)

    qa = _rope(_rms_heads(_heads(qa, A_HEADS), qn_a), cos, sin)
    ka = _rope(_rms_heads(_heads(ka, A_KV), kn_a), cos, sin)
    ka_x = _rms_heads(_heads(ka_x, A_KV), kn_a)
    va, va_x = _heads(va, A_KV), _heads(va_x, A_KV)
    ya = _gqa_blocked(qa, jnp.concatenate([ka_x, ka], axis=1), jnp.concatenate([va_x, va], axis=1))

    lg = -jax.nn.softplus(-ret_a.astype(jnp.float32))
    rs = R_DK ** -0.5
    qr = _rope(_heads(qr, R_HEADS) * rs, cos, sin)
    kr = _rope(_heads(kr, R_HEADS), cos, sin)
    vr = _heads(vr, R_HEADS)
    kr_x, vr_x = _heads(kr_x, R_HEADS), _heads(vr_x, R_HEADS)
    qr_x = _heads(qr_x, R_HEADS) * rs if need_ctx else None
    zero = jnp.zeros((B, R_HEADS, R_DK, R_DV), jnp.float32)
    or_xf, st_f = _chunk_retention(qr_x, kr_x, vr_x, lg[0], zero)
    or_xb, st_b = _chunk_retention(_flip(qr_x), _flip(kr_x), _flip(vr_x), lg[1], zero)
    or_f, _ = _chunk_retention(qr, kr, vr, lg[0], st_f)
    or_b, _ = _chunk_retention(_flip(qr), _flip(kr), _flip(vr), lg[1], st_b)
    yr = _retention_out(or_f + _flip(or_b), gr, ret_g)

    qc = _rope(_heads(qc, C_HEADS), cos, sin)
    kc = _rope(_heads(kc, C_KV), cos, sin)
    vc = _heads(vc, C_KV)
    kc_x, vc_x = _heads(kc_x, C_KV), _heads(vc_x, C_KV)
    yc = _window_sink_attend(qc, kc, vc, kc_x, vc_x, sink_c)

    out_lat = _merge(ya, yr, yc, gl, b_gate, w_br_a, w_br_b, w_br_c, w_out)
    if not need_ctx:
        return out_lat, None

    ya_x = _gqa_attend(_rms_heads(_heads(qa_x, A_HEADS), qn_a), ka_x, va_x)
    yr_x = _retention_out(or_xf + _flip(or_xb), gr_x, ret_g)
    yc_x = _sink_attend(_heads(qc_x, C_HEADS), kc_x, vc_x, sink_c)
    out_ctx = _merge(ya_x, yr_x, yc_x, gl_x, b_gate, w_br_a, w_br_b, w_br_c, w_out)
    return out_lat, out_ctx


def _swiglu(h, w1, w3, w2):
    return (jax.nn.silu(h @ w1) * (h @ w3)) @ w2


def _moe_swiglu(h, router_w, router_b, w1, w3, w2):
    B, T, D = h.shape
    t = h.reshape(B * T, D)
    logits = (t @ router_w).astype(jnp.float32) + router_b.astype(jnp.float32)
    top_v, top_i = lax.top_k(logits, TOP_K)
    wts = jax.nn.softmax(top_v, axis=-1)
    combine = jnp.sum(jax.nn.one_hot(top_i, N_EXPERTS, dtype=jnp.float32) * wts[..., None], axis=1)
    combine = combine.astype(t.dtype)
    out = jnp.zeros_like(t)
    for e in range(N_EXPERTS):
        out = out + combine[:, e:e + 1] * _swiglu(t, w1[e], w3[e], w2[e])
    return out.reshape(B, T, D)


def setup_inputs(seed: int = 0) -> dict:
    key = jax.random.key(seed)
    ks = jax.random.split(key, 28)
    f32 = jnp.float32

    def nrm(k, shape, scale):
        return jax.random.normal(k, shape, f32) * scale

    def gain(k, shape):
        return 1.0 + 0.02 * jax.random.normal(k, shape, f32)

    base = jnp.log(2.0 ** (5.0 + jnp.arange(R_HEADS, dtype=f32)) - 1.0)
    ret_a = base[None, None, :] + 0.1 * jax.random.normal(ks[13], (DEPTH, 2, R_HEADS), f32)
    D = D_MODEL
    return {
        "x": nrm(ks[0], (BATCH, SEQ, D), 1.0),
        "c": nrm(ks[1], (BATCH, D), 1.0),
        "ctx": nrm(ks[2], (BATCH, CTX_LEN, D), 1.0),
        "c_ctx": nrm(ks[3], (D,), 1.0),
        "w_ada": nrm(ks[4], (DEPTH, D, 6 * D), 0.5 * D ** -0.5),
        "b_ada": nrm(ks[5], (DEPTH, 6 * D), 0.02),
        "norm1_g": gain(ks[6], (DEPTH, D)),
        "norm2_g": gain(ks[7], (DEPTH, D)),
        "final_g": gain(ks[8], (D,)),
        "w_in": nrm(ks[9], (DEPTH, D, IN_COLS), D ** -0.5),
        "b_gate": nrm(ks[10], (DEPTH, 3 * D), 0.02),
        "qn_a": gain(ks[11], (DEPTH, HEAD_DIM)),
        "kn_a": gain(ks[12], (DEPTH, HEAD_DIM)),
        "ret_a": ret_a,
        "ret_g": gain(ks[14], (DEPTH, R_HEADS * R_DV)),
        "sink_c": nrm(ks[15], (DEPTH, C_HEADS), 0.5),
        "w_br_a": nrm(ks[16], (DEPTH, A_HEADS * HEAD_DIM, D), (A_HEADS * HEAD_DIM) ** -0.5),
        "w_br_b": nrm(ks[17], (DEPTH, R_HEADS * R_DV, D), (R_HEADS * R_DV) ** -0.5),
        "w_br_c": nrm(ks[18], (DEPTH, C_HEADS * HEAD_DIM, D), (C_HEADS * HEAD_DIM) ** -0.5),
        "w_out": nrm(ks[19], (DEPTH, D, D), D ** -0.5),
        "ffn_w1": nrm(ks[20], (N_DENSE, D, D_FF), D ** -0.5),
        "ffn_w3": nrm(ks[21], (N_DENSE, D, D_FF), D ** -0.5),
        "ffn_w2": nrm(ks[22], (N_DENSE, D_FF, D), D_FF ** -0.5),
        "router_w": nrm(ks[23], (N_MOE, D, N_EXPERTS), D ** -0.5),
        "router_b": nrm(ks[24], (N_MOE, N_EXPERTS), 0.01),
        "exp_w1": nrm(ks[25], (N_MOE, N_EXPERTS, D, D_FF_EXPERT), D ** -0.5),
        "exp_w3": nrm(ks[26], (N_MOE, N_EXPERTS, D, D_FF_EXPERT), D ** -0.5),
        "exp_w2": nrm(ks[27], (N_MOE, N_EXPERTS, D_FF_EXPERT, D), D_FF_EXPERT ** -0.5),
    }


def reference(x, c, ctx, c_ctx, w_ada, b_ada, norm1_g, norm2_g, final_g, w_in, b_gate,
              qn_a, kn_a, ret_a, ret_g, sink_c, w_br_a, w_br_b, w_br_c, w_out,
              ffn_w1, ffn_w3, ffn_w2, router_w, router_b, exp_w1, exp_w3, exp_w2):
    S = x.shape[1]
    L = ctx.shape[1]
    rows = S // GRID_W
    row = jnp.repeat(jnp.arange(rows), GRID_W).astype(jnp.float32)
    col = jnp.tile(jnp.arange(GRID_W), rows).astype(jnp.float32)
    cos, sin = _rope_tables(row, col, HEAD_DIM)
    sc = jax.nn.silu(c)
    scx = jax.nn.silu(c_ctx)
    xl, xc = x, ctx
    for l in range(DEPTH):
        need_ctx = l < DEPTH - 1
        mod_l = jnp.split((sc @ w_ada[l] + b_ada[l])[:, None, :], 6, axis=-1)
        mod_c = jnp.split(scx @ w_ada[l] + b_ada[l], 6, axis=-1)
        hl = _modulate(_rmsnorm(xl, norm1_g[l]), mod_l[0], mod_l[1])
        hc = _modulate(_rmsnorm(xc, norm1_g[l]), mod_c[0], mod_c[1])
        ol, oc = _token_mixer(hl, hc, w_in[l], b_gate[l], qn_a[l], kn_a[l], ret_a[l], ret_g[l],
                              sink_c[l], w_br_a[l], w_br_b[l], w_br_c[l], w_out[l], cos, sin, need_ctx)
        xl = xl + mod_l[2] * ol
        hl2 = _modulate(_rmsnorm(xl, norm2_g[l]), mod_l[3], mod_l[4])
        if need_ctx:
            xc = xc + mod_c[2] * oc
            hc2 = _modulate(_rmsnorm(xc, norm2_g[l]), mod_c[3], mod_c[4])
            h2 = jnp.concatenate([hc2, hl2], axis=1)
        else:
            h2 = hl2
        j = l // 2
        if l % 2 == 0:
            f = _swiglu(h2, ffn_w1[j], ffn_w3[j], ffn_w2[j])
        else:
            f = _moe_swiglu(h2, router_w[j], router_b[j], exp_w1[j], exp_w3[j], exp_w2[j])
        xl = xl + mod_l[5] * f[:, f.shape[1] - S:]
        if need_ctx:
            xc = xc + mod_c[5] * f[:, :L]
    return _rmsnorm(xl, final_g)
```

```cpp
#include <hip/hip_runtime.h>
#include <cstdio>
#include <cstdint>
#include <cmath>

constexpr int NB = 4, SEQ = 4096, CTXL = 256, TPB = SEQ + CTXL, M = NB * TPB, D = 1024, DEPTH = 4;
constexpr int INC = 6144, PC = 3072, DFF = 2816, DFE = 3584, NEXP = 8;
constexpr int NMT = M / 256;
constexpr int MOE_ROWS = 2 * M + NEXP * 256;
constexpr float EPS = 1e-6f;
constexpr float LOG2E = 1.4426950408889634f;
constexpr float C2 = 0.125f * LOG2E;

constexpr size_t MiB = 1u << 20;
constexpr size_t WS_CTL = 0, CTL_ZERO_BYTES = 1 * MiB;
constexpr size_t WS_MODS = 1 * MiB;
constexpr size_t WS_ROPE = WS_MODS + 512 * 1024;
constexpr size_t WS_RETC = WS_ROPE + 16 * 1024;
constexpr size_t WS_META = 2 * MiB;
constexpr size_t WS_WIN = 3 * MiB;
constexpr size_t WS_WBR = WS_WIN + 48 * MiB;
constexpr size_t WS_WOUT = WS_WBR + 12 * MiB;
constexpr size_t WS_W13 = WS_WOUT + 8 * MiB;
constexpr size_t WS_W2 = WS_W13 + 22 * MiB;
constexpr size_t WS_E13 = WS_W2 + 11 * MiB;
constexpr size_t WS_E2 = WS_E13 + 224 * MiB;
constexpr size_t WS_XS = WS_E2 + 112 * MiB;
constexpr size_t WS_HN = WS_XS + 68 * MiB;
constexpr size_t WS_P = WS_HN + 34 * MiB;
constexpr size_t WS_G = WS_P + 102 * MiB;
constexpr size_t WS_Y3 = WS_G + 102 * MiB;
constexpr size_t WS_R2 = WS_Y3 + 51 * MiB;
constexpr size_t WS_MB = WS_R2, WS_KVS = WS_R2 + 34 * MiB;
constexpr size_t WS_END = WS_R2 + 72 * MiB;
constexpr size_t WS_H = WS_P;
static_assert((size_t)MOE_ROWS * DFE * 2 <= WS_R2 - WS_P, "HM overlay");
static_assert((size_t)MOE_ROWS * D * 2 <= 72 * MiB, "HS overlay");
constexpr size_t MT_PE = 0, MT_PPOS = MT_PE + (size_t)M * 8, MT_PW = MT_PPOS + (size_t)M * 8, MT_DST = MT_PW + (size_t)M * 8, MT_CW = MT_DST + (size_t)M * 8, MT_END = MT_CW + (size_t)MOE_ROWS * 4;
static_assert(MT_END <= 1 * MiB, "meta");
constexpr int CW_TMO = 0, CW_CODE = 1, CW_BAR = 4096, CW_CNT = 8192;

constexpr int RING_BYTES = 131072, LDSCTL_OFF = RING_BYTES, MISC_OFF = LDSCTL_OFF + 320, LDS_BYTES = 147456;
constexpr int NWAVES = 8, NTHR = 512;

#define GAS __attribute__((address_space(1)))
#define LAS __attribute__((address_space(3)))
typedef unsigned short bf16_t;
typedef unsigned u32x4 __attribute__((ext_vector_type(4)));
typedef unsigned u32x2 __attribute__((ext_vector_type(2)));
typedef float f32x4 __attribute__((ext_vector_type(4)));
typedef float f32x2 __attribute__((ext_vector_type(2)));
typedef float f32x16 __attribute__((ext_vector_type(16)));
typedef short bf16x8 __attribute__((ext_vector_type(8)));
typedef short s16x4 __attribute__((ext_vector_type(4)));
#define RLX_AGENT __ATOMIC_RELAXED, __HIP_MEMORY_SCOPE_AGENT
#define LDS_WAIT() asm volatile("s_waitcnt lgkmcnt(0)" ::: "memory")
#define VM_WAIT() asm volatile("s_waitcnt vmcnt(0)" ::: "memory")
__device__ __forceinline__ unsigned f2bf(float f) { unsigned u = __builtin_bit_cast(unsigned, f); return (u + 0x7fffu + ((u >> 16) & 1u)) >> 16; }
__device__ __forceinline__ unsigned pk2(float lo, float hi) { return f2bf(lo) | (f2bf(hi) << 16); }
__device__ __forceinline__ float bflo(unsigned w) { return __builtin_bit_cast(float, w << 16); }
__device__ __forceinline__ float bfhi(unsigned w) { return __builtin_bit_cast(float, w & 0xffff0000u); }
__device__ __forceinline__ float sigmoidf_(float x) { return 1.0f / (1.0f + __expf(-x)); }
__device__ __forceinline__ float siluf_(float x) { return x / (1.0f + __expf(-x)); }
__device__ __forceinline__ int fresh_lane() { int l; asm volatile("v_mbcnt_lo_u32_b32 %0, -1, 0\n\tv_mbcnt_hi_u32_b32 %0, -1, %0" : "=v"(l)); return l; }
__device__ __forceinline__ int fresh_tid(int wave_s) { int l; asm volatile("v_mbcnt_lo_u32_b32 %0, -1, 0\n\tv_mbcnt_hi_u32_b32 %0, -1, %0" : "=v"(l)); return wave_s * 64 + l; }
template <int MSK> __device__ __forceinline__ float swz_xor(float v) { return __builtin_bit_cast(float, __builtin_amdgcn_ds_swizzle(__builtin_bit_cast(int, v), (MSK << 10) | 0x1f)); }
__device__ __forceinline__ float xor32_sum(float v) { const unsigned u = __builtin_bit_cast(unsigned, v); auto rr = __builtin_amdgcn_permlane32_swap(u, u, false, false); return __builtin_bit_cast(float, (unsigned)rr[0]) + __builtin_bit_cast(float, (unsigned)rr[1]); }
__device__ __forceinline__ float half_sum(float v) { v += swz_xor<1>(v); v += swz_xor<2>(v); v += swz_xor<4>(v); v += swz_xor<8>(v); v += swz_xor<16>(v); return v; }
__device__ __forceinline__ float wave_sum(float v) { return xor32_sum(half_sum(v)); }

#define XB_TMO      128
#define XB_XCNT(j)  (256  + 64 * (j))
#define XB_XSUB(j)  (1280 + 64 * (j))
#define XB_XGEN(j)  (2304 + 64 * (j))
#define XB_TOP      3328
#define XB_TOPGEN   3392
#define XCD_BAR_WORDS 3456
#define XB_SPIN_CAP (1u << 20)
__device__ __forceinline__ unsigned xb_ld(unsigned* p)              { return __hip_atomic_load(p, __ATOMIC_RELAXED, __HIP_MEMORY_SCOPE_AGENT); }
__device__ __forceinline__ unsigned xb_add(unsigned* p, unsigned v) { return __hip_atomic_fetch_add(p, v, __ATOMIC_RELAXED, __HIP_MEMORY_SCOPE_AGENT); }
__device__ __forceinline__ unsigned xb_xcc_id() { return (unsigned)__builtin_amdgcn_s_getreg((3 << 11) | 20) & 0xFu; }
#define XB_SPIN(cond, bar) do { unsigned _sp = 0; while (cond) { __builtin_amdgcn_s_sleep(1); \
    if ((++_sp & 255u) == 0u) { if (xb_ld(&(bar)[XB_TMO])) break; if (_sp > XB_SPIN_CAP) { atomicAdd(&(bar)[XB_TMO], 1u); break; } } } } while (0)
struct XcdBarrier { unsigned* bar; unsigned x; volatile LAS unsigned* st; };
__device__ __forceinline__ XcdBarrier xcd_barrier_post(unsigned* bar, volatile LAS unsigned* st) {
    XcdBarrier b; b.bar = bar; b.x = xb_xcc_id(); b.st = st;
    if (threadIdx.x == 0) (void)xb_add(&bar[XB_XCNT(b.x)], 1u);
    return b;
}
__device__ __forceinline__ void xcd_barrier_complete(unsigned* bar, unsigned x, unsigned& nloc, unsigned& nx) {
    const unsigned G = gridDim.x * gridDim.y * gridDim.z;
    unsigned sum, cnt, mine, sp = 0u;
    for (;;) {
        sum = 0u; cnt = 0u; mine = 0u;
#pragma unroll
        for (unsigned j = 0; j < 16; ++j) { const unsigned c = xb_ld(&bar[XB_XCNT(j)]); sum += c; cnt += (c > 0u) ? 1u : 0u; mine = (j == x) ? c : mine; }
        if (sum == G) break;
        __builtin_amdgcn_s_sleep(1);
        if ((++sp & 255u) == 0u) { if (xb_ld(&bar[XB_TMO])) break; if (sp > XB_SPIN_CAP) { atomicAdd(&bar[XB_TMO], 1u); break; } }
    }
    nloc = mine > 0u ? mine : 1u; nx = cnt > 0u ? cnt : 1u;
}
__device__ __forceinline__ void xcd_barrier(const XcdBarrier& b) {
    asm volatile("s_waitcnt vmcnt(0)" ::: "memory");
    __syncthreads();
    if (threadIdx.x == 0) {
        unsigned* bar = b.bar;
        __builtin_amdgcn_s_waitcnt(0);
        unsigned nloc = b.st[0], nx = b.st[1];
        if (nloc == 0u) { xcd_barrier_complete(bar, b.x, nloc, nx); b.st[0] = nloc; b.st[1] = nx; }
        const unsigned old = xb_add(&bar[XB_XSUB(b.x)], 1u);
        const unsigned gen = old / nloc;
        if (old + 1u == (gen + 1u) * nloc) {
            __builtin_amdgcn_fence(__ATOMIC_RELEASE, "agent");
            asm volatile("s_waitcnt vmcnt(0)" ::: "memory");
            const unsigned og = xb_add(&bar[XB_TOP], 1u);
            const unsigned tg = og / nx;
            if (og + 1u == (tg + 1u) * nx) xb_add(&bar[XB_TOPGEN], 1u);
            else XB_SPIN(xb_ld(&bar[XB_TOPGEN]) == tg, bar);
            __builtin_amdgcn_fence(__ATOMIC_ACQUIRE, "agent");
            xb_add(&bar[XB_XGEN(b.x)], 1u);
            asm volatile("s_waitcnt vmcnt(0)" ::: "memory");
        } else {
            XB_SPIN(xb_ld(&bar[XB_XGEN(b.x)]) == gen, bar);
            __builtin_amdgcn_fence(__ATOMIC_ACQUIRE, "agent");
            asm volatile("s_waitcnt vmcnt(0)" ::: "memory");
        }
    }
    __syncthreads();
}
namespace pg8 {
constexpr int BM = 256, BK = 64, HALF = 128, HTB = HALF * BK * 2, STAGE_BYTES = 8 * HTB;
__device__ __forceinline__ int lds_byte(int r, int c) { const int st = (r >> 4) * 2 + (c >> 5), rr = r & 15, cc = c & 31, ob = rr * 64 + cc * 2; return st * 1024 + (ob ^ (((ob >> 9) & 1) << 5)); }
__device__ __forceinline__ void stage_rc(int b, int& R, int& C) { const int st = b / 1024, sb = b % 1024, swz = sb ^ (((sb >> 9) & 1) << 5); R = (st >> 1) * 16 + swz / 64; C = (st & 1) * 32 + (swz % 64) / 2; }
__device__ __forceinline__ int perm32(int rho) { const int n = rho >> 4, i = rho & 15; return 8 * (i >> 2) + 4 * n + (i & 3); }

struct Unit { int pm, pn, aux; const char* A; const char* B; };

__device__ __forceinline__ bool tile_of(long L, int nM, int nN, int& pm, int& pn) {
    const int nwg = nM * nN; if (L >= nwg) return false;
    int wgid = (int)L; { const int q = nwg / 8, r = nwg % 8, xcd = wgid % 8, off = wgid / 8; wgid = (xcd < r ? xcd * (q + 1) : r * (q + 1) + (xcd - r) * q) + off; }
    const int nig = 8 * nN, gid = wgid / nig, fm = gid * 8, gsz = (nM - fm) < 8 ? (nM - fm) : 8;
    pm = fm + ((wgid % nig) % gsz); pn = (wgid % nig) / gsz; return true;
}
__device__ __forceinline__ unsigned cvt_pk_bf16(float lo, float hi) { unsigned r; asm volatile("v_cvt_pk_bf16_f32 %0, %1, %2" : "=v"(r) : "v"(lo), "v"(hi)); return r; }

template <class Epi, class Sched, bool ALIGN_EPI>
__device__ __forceinline__ void gemm_phase(LAS unsigned char* lds, const int tid, const int K, const int lda, const int ldb, const Sched& S, const Epi& E) {
    const int wid = __builtin_amdgcn_readfirstlane(tid >> 6), lane = tid & 63, wr = wid >> 2, wc = wid & 3, fr = lane & 15, fq = lane >> 4;
    const int nt = K / BK;
    unsigned voffA[2], voffB[2];
#pragma unroll
    for (int i = 0; i < 2; ++i) { int R, C; stage_rc(tid * 16 + i * 8192, R, C); const int Rb = Epi::PERM ? ((R & ~31) + perm32(R & 31)) : R;
        voffA[i] = (unsigned)(R * lda + C) * 2u; voffB[i] = (unsigned)(Rb * ldb + C) * 2u; }
    const size_t kstep = (size_t)(BK * 2);
    const size_t hsA = (size_t)HALF * lda * 2, hsB = (size_t)HALF * ldb * 2;
    const unsigned ldsw = (unsigned)wid * 1024u;
    const int aoff = lds_byte(wr * 64 + fr, fq * 8), boff = lds_byte(wc * 32 + fr, fq * 8);
#define PG8_SA(b, h) (((b) * 2 + (h)) * HTB)
#define PG8_SB(b, h) ((4 + (b) * 2 + (h)) * HTB)
#define PG8_STAGE(bufoff, gbase, voff) do { _Pragma("unroll") for (int _i = 0; _i < 2; ++_i) \
        __builtin_amdgcn_global_load_lds((const unsigned*)((const char*)(gbase) + (voff)[_i]), (LAS unsigned*)(lds + (bufoff) + ldsw + _i * 8192), 16, 0, 0); } while (0)
#define PG8_LDA(dst, b, h) do { _Pragma("unroll") for (int m = 0; m < 4; ++m) _Pragma("unroll") for (int k = 0; k < 2; ++k) dst[m][k] = *(const LAS bf16x8*)(lds + PG8_SA(b, h) + aoff + m * 2048 + k * 1024); } while (0)
#define PG8_LDB(dst, b, h) do { _Pragma("unroll") for (int n = 0; n < 2; ++n) _Pragma("unroll") for (int k = 0; k < 2; ++k) dst[n][k] = *(const LAS bf16x8*)(lds + PG8_SB(b, h) + boff + n * 2048 + k * 1024); } while (0)
#define PG8_MMA(ai, bj, At, Bt) do { __builtin_amdgcn_s_setprio(1); _Pragma("unroll") for (int m = 0; m < 4; ++m) _Pragma("unroll") for (int n = 0; n < 2; ++n) _Pragma("unroll") for (int k = 0; k < 2; ++k) \
        acc[ai][bj][m][n] = __builtin_amdgcn_mfma_f32_16x16x32_bf16(Bt[n][k], At[m][k], acc[ai][bj][m][n], 0, 0, 0); __builtin_amdgcn_s_setprio(0); } while (0)
#define PG8_WAIT_V(n) asm volatile("s_waitcnt vmcnt(" #n ")" ::: "memory")
#define PG8_WAIT_L(n) asm volatile("s_waitcnt lgkmcnt(" #n ")" ::: "memory")
#define PG8_BAR __builtin_amdgcn_s_barrier()
#define PG8_SCHED __builtin_amdgcn_sched_barrier(0)
    Unit cur, nxt; int ui = 0;
    if (!S.next(0, cur)) return;
    f32x4 acc[2][2][4][2];
#pragma unroll
    for (int a = 0; a < 2; ++a)
#pragma unroll
        for (int b = 0; b < 2; ++b)
#pragma unroll
            for (int m = 0; m < 4; ++m)
#pragma unroll
                for (int n = 0; n < 2; ++n) acc[a][b][m][n] = (f32x4){0.f, 0.f, 0.f, 0.f};
    bf16x8 At[4][2], B0[2][2], B1[2][2];
    const char* cA = cur.A; const char* cB = cur.B;
    PG8_STAGE(PG8_SB(0, 0), cB, voffB); PG8_STAGE(PG8_SB(0, 1), cB + hsB, voffB); PG8_STAGE(PG8_SA(0, 0), cA, voffA); PG8_STAGE(PG8_SA(0, 1), cA + hsA, voffA);
    if (wr == 1) PG8_BAR;
    PG8_WAIT_V(2); PG8_BAR;
    PG8_STAGE(PG8_SB(1, 0), cB + kstep, voffB); PG8_STAGE(PG8_SA(1, 0), cA + kstep, voffA); PG8_STAGE(PG8_SB(1, 1), cB + hsB + kstep, voffB);
    PG8_WAIT_V(6); PG8_BAR;
    for (;;) {
        const bool has_next = S.next(ui + 1, nxt);
        const char* nA = has_next ? nxt.A : cA; const char* nB = has_next ? nxt.B : cB;
        for (int t = 0; t < nt; t += 2) {
            const bool last = (t == nt - 2);
            const char* a1 = cA + (size_t)(t + 1) * kstep;
            const char* a2 = last ? nA : cA + (size_t)(t + 2) * kstep; const char* b2 = last ? nB : cB + (size_t)(t + 2) * kstep;
            const char* a3 = a2 + kstep; const char* b3 = b2 + kstep;
            PG8_LDB(B0, 0, 0); PG8_LDB(B1, 0, 1); PG8_SCHED; PG8_LDA(At, 0, 0); PG8_STAGE(PG8_SA(1, 1), a1 + hsA, voffA);
            PG8_WAIT_V(8); PG8_WAIT_L(0); PG8_BAR; PG8_MMA(0, 0, At, B0); PG8_MMA(0, 1, At, B1); PG8_BAR; PG8_SCHED;
            PG8_LDA(At, 0, 1); PG8_STAGE(PG8_SB(0, 0), b2, voffB); PG8_STAGE(PG8_SB(0, 1), b2 + hsB, voffB); PG8_STAGE(PG8_SA(0, 0), a2, voffA);
            PG8_WAIT_V(8); PG8_WAIT_L(0); PG8_BAR; PG8_MMA(1, 0, At, B0); PG8_MMA(1, 1, At, B1); PG8_BAR; PG8_SCHED;
            PG8_LDB(B0, 1, 0); PG8_LDB(B1, 1, 1); PG8_SCHED; PG8_LDA(At, 1, 0); PG8_STAGE(PG8_SA(0, 1), a2 + hsA, voffA);
            PG8_WAIT_V(8); PG8_WAIT_L(0); PG8_BAR; PG8_MMA(0, 0, At, B0); PG8_MMA(0, 1, At, B1); PG8_BAR; PG8_SCHED;
            PG8_LDA(At, 1, 1); PG8_STAGE(PG8_SB(1, 0), b3, voffB); PG8_STAGE(PG8_SB(1, 1), b3 + hsB, voffB); PG8_STAGE(PG8_SA(1, 0), a3, voffA);
            PG8_WAIT_V(8); PG8_WAIT_L(0); PG8_BAR; PG8_MMA(1, 0, At, B0); PG8_MMA(1, 1, At, B1); PG8_BAR; PG8_SCHED;
        }
        if constexpr (ALIGN_EPI) { if (wr == 0) PG8_BAR; }
        { const int l2 = fresh_lane(); E(acc, cur, wr, wc, l2 & 15, l2 >> 4); }
        if (!has_next) break;
#pragma unroll
        for (int a = 0; a < 2; ++a)
#pragma unroll
            for (int b = 0; b < 2; ++b)
#pragma unroll
                for (int m = 0; m < 4; ++m)
#pragma unroll
                    for (int n = 0; n < 2; ++n) acc[a][b][m][n] = (f32x4){0.f, 0.f, 0.f, 0.f};
        cur = nxt; cA = nA; cB = nB; ++ui;
        if constexpr (ALIGN_EPI) { if (wr == 1) PG8_BAR; }
    }
    PG8_WAIT_V(0);
    if constexpr (!ALIGN_EPI) { if (wr == 0) PG8_BAR; }
    PG8_BAR;
#undef PG8_SA
#undef PG8_SB
#undef PG8_STAGE
#undef PG8_LDA
#undef PG8_LDB
#undef PG8_MMA
#undef PG8_WAIT_V
#undef PG8_WAIT_L
#undef PG8_BAR
#undef PG8_SCHED
}

__device__ __forceinline__ u32x4 pack8(const f32x4& a, const f32x4& b) { u32x4 w; w.x = cvt_pk_bf16(a[0], a[1]); w.y = cvt_pk_bf16(a[2], a[3]); w.z = cvt_pk_bf16(b[0], b[1]); w.w = cvt_pk_bf16(b[2], b[3]); return w; }
__device__ __forceinline__ void unpack8(const u32x4& w, f32x4& a, f32x4& b) { a = (f32x4){bflo(w.x), bfhi(w.x), bflo(w.y), bfhi(w.y)}; b = (f32x4){bflo(w.z), bfhi(w.z), bflo(w.w), bfhi(w.w)}; }

struct EpiInProj {
    static constexpr bool PERM = true;
    bf16_t* P; bf16_t* G; const float* qn; const float* kn; const float* bgate; const float* rope;
    __device__ __forceinline__ void operator()(const f32x4 (&acc)[2][2][4][2], const Unit& u, int wr, int wc, int fr, int fq) const {
        const int T = u.pn, jt = u.pm % 17; const bool lat = (jt != 0);
        const int row0 = u.pm * BM + wr * 64 + fr;
        if (T >= 12) {
            const int c0 = (T - 12) * 256 + wc * 32 + 8 * fq;
            f32x4 bv[2][2];
#pragma unroll
            for (int bj = 0; bj < 2; ++bj)
#pragma unroll
                for (int n = 0; n < 2; ++n) bv[bj][n] = *(const f32x4*)(bgate + c0 + bj * HALF + 4 * n);
#pragma unroll
            for (int ai = 0; ai < 2; ++ai)
#pragma unroll
                for (int m = 0; m < 4; ++m) { bf16_t* rowp = G + (size_t)(row0 + ai * HALF + m * 16) * PC + c0;
#pragma unroll
                    for (int bj = 0; bj < 2; ++bj) { f32x4 v0 = acc[ai][bj][m][0] + bv[bj][0], v1 = acc[ai][bj][m][1] + bv[bj][1];
#pragma unroll
                        for (int x = 0; x < 4; ++x) { v0[x] = sigmoidf_(v0[x]); v1[x] = sigmoidf_(v1[x]); }
                        *(u32x4*)(rowp + bj * HALF) = pack8(v0, v1); } }
            return;
        }
        if (T >= 5 && T <= 8) {
            const int c0 = T * 256 + wc * 32 + 8 * fq; const bool sl = (T >= 7);
#pragma unroll
            for (int ai = 0; ai < 2; ++ai)
#pragma unroll
                for (int m = 0; m < 4; ++m) { bf16_t* rowp = P + (size_t)(row0 + ai * HALF + m * 16) * PC + c0;
#pragma unroll
                    for (int bj = 0; bj < 2; ++bj) { f32x4 v0 = acc[ai][bj][m][0], v1 = acc[ai][bj][m][1];
                        if (sl) {
#pragma unroll
                            for (int x = 0; x < 4; ++x) { v0[x] = siluf_(v0[x]); v1[x] = siluf_(v1[x]); } }
                        *(u32x4*)(rowp + bj * HALF) = pack8(v0, v1); } }
            return;
        }
        const bool isv = ((T == 2 || T == 11) && wc >= 2);
        const bool donorm = (T <= 1) || (T == 2 && wc < 2);
        const bool dorope = lat && !isv;
        const float scale = (T <= 1 || T == 9 || T == 10) ? C2 : (T == 3 ? 0.125f : 1.0f);
        const float* gain = (T <= 1) ? qn : kn;
        f32x4 g1[2], g2[2];
        if (donorm) {
#pragma unroll
            for (int n = 0; n < 2; ++n) { g1[n] = *(const f32x4*)(gain + 8 * fq + 4 * n); g2[n] = *(const f32x4*)(gain + 32 + 8 * fq + 4 * n); }
        }
        const int cbase = T * 256 + 64 * wc + 8 * fq;
#pragma unroll
        for (int ai = 0; ai < 2; ++ai)
#pragma unroll
            for (int m = 0; m < 4; ++m) {
                f32x4 t1[2], t2[2];
#pragma unroll
                for (int n = 0; n < 2; ++n) { t1[n] = acc[ai][0][m][n]; t2[n] = acc[ai][1][m][n]; }
                if (donorm) {
                    float ss = 0.f;
#pragma unroll
                    for (int n = 0; n < 2; ++n)
#pragma unroll
                        for (int x = 0; x < 4; ++x) ss += t1[n][x] * t1[n][x] + t2[n][x] * t2[n][x];
                    ss += swz_xor<16>(ss); ss = xor32_sum(ss);
                    const float inv = rsqrtf(ss * (1.0f / 64.0f) + EPS);
#pragma unroll
                    for (int n = 0; n < 2; ++n) { t1[n] = t1[n] * inv * g1[n]; t2[n] = t2[n] * inv * g2[n]; }
                }
                if (dorope) {
                    const int grow = 4 * (jt - 1) + 2 * ai + wr, gcol = 16 * m + fr;
                    const int pos = (fq < 2) ? grow : gcol;
                    const float* rp = rope + ((size_t)pos * 16 + 8 * (fq & 1)) * 2;
#pragma unroll
                    for (int n = 0; n < 2; ++n) {
                        const f32x4 cs0 = *(const f32x4*)(rp + 8 * n), cs1 = *(const f32x4*)(rp + 8 * n + 4);
                        const f32x4 c = (f32x4){cs0[0], cs0[2], cs1[0], cs1[2]}, s = (f32x4){cs0[1], cs0[3], cs1[1], cs1[3]};
                        const f32x4 a = t1[n], b = t2[n];
                        t1[n] = a * c - b * s; t2[n] = a * s + b * c;
                    }
                }
#pragma unroll
                for (int n = 0; n < 2; ++n) { t1[n] = t1[n] * scale; t2[n] = t2[n] * scale; }
                bf16_t* rowp = P + (size_t)(row0 + ai * HALF + m * 16) * PC + cbase;
                *(u32x4*)(rowp) = pack8(t1[0], t1[1]);
                *(u32x4*)(rowp + 32) = pack8(t2[0], t2[1]);
            }
    }
};

struct EpiBranch {
    static constexpr bool PERM = true;
    const bf16_t* G; bf16_t* MB;
    __device__ __forceinline__ void operator()(const f32x4 (&acc)[2][2][4][2], const Unit& u, int wr, int wc, int fr, int fq) const {
        const int br = u.aux, row0 = u.pm * BM + wr * 64 + fr, c0 = u.pn * BM + wc * 32 + 8 * fq;
#pragma unroll
        for (int ai = 0; ai < 2; ++ai)
#pragma unroll
            for (int m = 0; m < 4; ++m) { const size_t row = (size_t)(row0 + ai * HALF + m * 16);
#pragma unroll
                for (int bj = 0; bj < 2; ++bj) { const int col = c0 + bj * HALF;
                    const u32x4 gw = *(const u32x4*)(G + row * PC + br * 1024 + col); f32x4 ga, gb; unpack8(gw, ga, gb);
                    f32x4 v0 = acc[ai][bj][m][0] * ga, v1 = acc[ai][bj][m][1] * gb;
                    if (br > 0) { const u32x4 ow = *(const u32x4*)(MB + row * D + col); f32x4 oa, ob; unpack8(ow, oa, ob); v0 += oa; v1 += ob; }
                    *(u32x4*)(MB + row * D + col) = pack8(v0, v1); } }
    }
};

struct EpiResid {
    static constexpr bool PERM = false;
    float* XS; const float* gate;
    __device__ __forceinline__ void operator()(const f32x4 (&acc)[2][2][4][2], const Unit& u, int wr, int wc, int fr, int fq) const {
        const int who = (u.pm % 17 == 0) ? 4 : (u.pm / 17);
        const float* gp = gate + (size_t)who * INC;
        const int row0 = u.pm * BM + wr * 64 + fr, c0 = u.pn * BM + wc * 32 + 4 * fq;
        f32x4 gv[2][2];
#pragma unroll
        for (int bj = 0; bj < 2; ++bj)
#pragma unroll
            for (int n = 0; n < 2; ++n) gv[bj][n] = *(const f32x4*)(gp + c0 + bj * HALF + n * 16);
#pragma unroll
        for (int ai = 0; ai < 2; ++ai)
#pragma unroll
            for (int m = 0; m < 4; ++m) { float* rowp = XS + (size_t)(row0 + ai * HALF + m * 16) * D + c0;
#pragma unroll
                for (int bj = 0; bj < 2; ++bj)
#pragma unroll
                    for (int n = 0; n < 2; ++n) { f32x4* p = (f32x4*)(rowp + bj * HALF + n * 16); *p = *p + gv[bj][n] * acc[ai][bj][m][n]; } }
    }
};

struct EpiSwiGLU {
    static constexpr bool PERM = true;
    bf16_t* H; int ldh;
    __device__ __forceinline__ void operator()(const f32x4 (&acc)[2][2][4][2], const Unit& u, int wr, int wc, int fr, int fq) const {
        const int row0 = u.pm * BM + wr * 64 + fr, c0 = u.pn * HALF + wc * 32 + 8 * fq;
#pragma unroll
        for (int ai = 0; ai < 2; ++ai)
#pragma unroll
            for (int m = 0; m < 4; ++m) { f32x4 v[2];
#pragma unroll
                for (int n = 0; n < 2; ++n)
#pragma unroll
                    for (int x = 0; x < 4; ++x) v[n][x] = siluf_(acc[ai][0][m][n][x]) * acc[ai][1][m][n][x];
                *(u32x4*)(H + (size_t)(row0 + ai * HALF + m * 16) * ldh + c0) = pack8(v[0], v[1]); }
    }
};

struct EpiMoEDown {
    static constexpr bool PERM = true;
    bf16_t* Y; const float* cw;
    __device__ __forceinline__ void operator()(const f32x4 (&acc)[2][2][4][2], const Unit& u, int wr, int wc, int fr, int fq) const {
        const int row0 = u.pm * BM + wr * 64 + fr, c0 = u.pn * BM + wc * 32 + 8 * fq;
#pragma unroll
        for (int ai = 0; ai < 2; ++ai)
#pragma unroll
            for (int m = 0; m < 4; ++m) { const int row = row0 + ai * HALF + m * 16; const float w = cw[row];
#pragma unroll
                for (int bj = 0; bj < 2; ++bj) *(u32x4*)(Y + (size_t)row * D + c0 + bj * HALF) = pack8(acc[ai][bj][m][0] * w, acc[ai][bj][m][1] * w); }
    }
};
}
namespace attn_body {
using bf16=unsigned short;
constexpr int D=64, QKP=3072  , OPITCH=1536  ;
constexpr int NW=8,QBLK=32,QB=QBLK*NW,KVBLK=64;
__device__ __forceinline__ int crow(int r,int hi){return (r&3)+8*(r>>2)+4*hi;}
#define SBAR() __builtin_amdgcn_sched_barrier(0)
__device__ __forceinline__ void wmask(f32x16&p0,f32x16&p1,int t,int qrel,int hi,int qoff){
  const float NEG=-INFINITY; const int base=64*(t-4)+4*hi-qrel-qoff;
  #pragma unroll
  for(int r=0;r<16;++r){const int d=base+(r&3)+8*(r>>2); if(d>128||d<-128)p0[r]=NEG; const int d1=d+32; if(d1>128||d1<-128)p1[r]=NEG;}
}

constexpr int NSLOT=3, SLOTB=8192;
constexpr int LDS_K=0, LDS_V=NSLOT*SLOTB, LDS_WS=2*NSLOT*SLOTB, LDS_OST=LDS_WS+NW*64*4, LDS_BYTES=LDS_OST+NW*4096;
__device__ __forceinline__ void glds16(const void*gsrc,unsigned lds_dst){unsigned keep;
  asm volatile("s_mov_b32 %0, m0\n\ts_mov_b32 m0, %2\n\ts_nop 0\n\tglobal_load_lds_dwordx4 %1, off\n\ts_mov_b32 m0, %0":"=&s"(keep):"v"(gsrc),"s"(lds_dst):"memory");}
__device__ __forceinline__ float max3f(float a,float b,float c){float r;asm("v_max3_f32 %0, %1, %2, %3":"=v"(r):"v"(a),"v"(b),"v"(c));return r;}
__device__ __forceinline__ float max2f(float a,float b){float r;asm("v_max_f32_e32 %0, %1, %2":"=v"(r):"v"(a),"v"(b));return r;}
__device__ __forceinline__ float fadd_s(float a,float b){float r;asm("v_add_f32_e32 %0, %1, %2":"=v"(r):"v"(a),"v"(b));return r;}
__device__ __forceinline__ float fsub_s(float a,float b){float r;asm("v_sub_f32_e32 %0, %1, %2":"=v"(r):"v"(a),"v"(b));return r;}
typedef float f32x2_t __attribute__((ext_vector_type(2))); typedef __bf16 bf16x2_t __attribute__((ext_vector_type(2)));
__device__ __forceinline__ unsigned cvtpk_s(float lo,float hi){f32x2_t v={lo,hi};bf16x2_t b=__builtin_convertvector(v,bf16x2_t);return __builtin_bit_cast(unsigned,b);}
#define WAIT_BAR(N) asm volatile("s_waitcnt vmcnt(" #N ") lgkmcnt(0)\n\ts_barrier":::"memory")

__device__ __forceinline__ void qkt(f32x16&p0,f32x16&p1,const char*Kslot,const bf16x8*qr,const f32x16&negm,int r32,int hi){
  const char*kb=Kslot+hi*1024+r32*16;
  #pragma unroll
  for(int d0=0;d0<4;++d0){
    const bf16x8 b0=*reinterpret_cast<const bf16x8*>(kb+d0*2048);
    const bf16x8 b1=*reinterpret_cast<const bf16x8*>(kb+d0*2048+512);
    if(d0==0){p0=__builtin_amdgcn_mfma_f32_32x32x16_bf16(b0,qr[0],negm,0,0,0);p1=__builtin_amdgcn_mfma_f32_32x32x16_bf16(b1,qr[0],negm,0,0,0);}
    else{p0=__builtin_amdgcn_mfma_f32_32x32x16_bf16(b0,qr[d0],p0,0,0,0);p1=__builtin_amdgcn_mfma_f32_32x32x16_bf16(b1,qr[d0],p1,0,0,0);}}
}
typedef __attribute__((address_space(3))) const char* lds_cptr;
typedef short v4i16_t __attribute__((ext_vector_type(4)));
__device__ __forceinline__ void kload8(bf16x8*kf,lds_cptr kp){
  kf[0]=*(const __attribute__((address_space(3))) bf16x8*)(kp);      kf[1]=*(const __attribute__((address_space(3))) bf16x8*)(kp+512);
  kf[2]=*(const __attribute__((address_space(3))) bf16x8*)(kp+2048); kf[3]=*(const __attribute__((address_space(3))) bf16x8*)(kp+2560);
  kf[4]=*(const __attribute__((address_space(3))) bf16x8*)(kp+4096); kf[5]=*(const __attribute__((address_space(3))) bf16x8*)(kp+4608);
  kf[6]=*(const __attribute__((address_space(3))) bf16x8*)(kp+6144); kf[7]=*(const __attribute__((address_space(3))) bf16x8*)(kp+6656);
}
__device__ __forceinline__ void kload2(bf16x8*kf,lds_cptr kp,int j){ kf[2*j]=*(const __attribute__((address_space(3))) bf16x8*)(kp+j*2048); kf[2*j+1]=*(const __attribute__((address_space(3))) bf16x8*)(kp+j*2048+512); }
__device__ __forceinline__ s16x4 vtr(lds_cptr p){ return __builtin_bit_cast(s16x4,__builtin_amdgcn_ds_read_tr16_b64_v4i16((__attribute__((address_space(3))) v4i16_t*)p)); }
__device__ __forceinline__ float rowmax(const f32x16&p0,const f32x16&p1){
  float a=max3f(p0[0],p0[1],p1[0]),b=max3f(p0[2],p0[3],p1[1]);a=max3f(a,p1[2],p1[3]);
  #pragma unroll
  for(int r=4;r<16;r+=4){a=max3f(a,p0[r],p0[r+1]);b=max3f(b,p0[r+2],p0[r+3]);a=max3f(a,p1[r],p1[r+1]);b=max3f(b,p1[r+2],p1[r+3]);}
  const float m=max2f(a,b);
  auto rr=__builtin_amdgcn_permlane32_swap(__float_as_uint(m),__float_as_uint(m),false,false);
  return max2f(__uint_as_float(rr[0]),__uint_as_float(rr[1]));
}
__device__ __forceinline__ void pv(f32x16*o,int vb,bf16x8 pa0,bf16x8 pa1,bf16x8 pa2,bf16x8 pa3){
  #pragma unroll
  for(int d0=0;d0<2;++d0){s16x4 lo[4],hi[4];
    #pragma unroll
    for(int ks=0;ks<4;++ks){
      asm volatile("ds_read_b64_tr_b16 %0,%1 offset:%c2":"=&v"(lo[ks]):"v"(vb),"i"(d0*4096+ks*1024):"memory");
      asm volatile("ds_read_b64_tr_b16 %0,%1 offset:%c2":"=&v"(hi[ks]):"v"(vb),"i"(d0*4096+ks*1024+512):"memory");}
    asm volatile("s_waitcnt lgkmcnt(0)":::"memory");SBAR();
    #define PK(k) (bf16x8){lo[k][0],lo[k][1],lo[k][2],lo[k][3],hi[k][0],hi[k][1],hi[k][2],hi[k][3]}
    o[d0]=__builtin_amdgcn_mfma_f32_32x32x16_bf16(pa0,PK(0),o[d0],0,0,0);
    o[d0]=__builtin_amdgcn_mfma_f32_32x32x16_bf16(pa1,PK(1),o[d0],0,0,0);
    o[d0]=__builtin_amdgcn_mfma_f32_32x32x16_bf16(pa2,PK(2),o[d0],0,0,0);
    o[d0]=__builtin_amdgcn_mfma_f32_32x32x16_bf16(pa3,PK(3),o[d0],0,0,0);
    #undef PK
  }
}

#ifndef ATTN_STORE16
#define ATTN_STORE16(p,v) (*(u32x4*)(p)=(v))
#endif
template<int THRL,int MODE> __device__ __forceinline__ void attn_unit(const bf16*Qu,const bf16*__restrict__ Kh,const bf16*__restrict__ Vh,bf16*Ou,const int NT,const int kgap,const int qoff,const float sink2,char*shm,const int tid){
  const int lane=tid&63,r32=lane&31,hi=lane>>5; const int wid=__builtin_amdgcn_readfirstlane(tid>>6);
  const bf16*Qw=Qu+(long)(wid*QBLK)*QKP;
  const unsigned lds0=(unsigned)(uintptr_t)shm;
  float*wsf=(float*)(shm+LDS_WS)+wid*64;
  const bf16*ksrc=Kh+(long)lane*QKP+wid*8;
  const bf16*vsrc=Vh+(long)(16*(wid&3)+(lane>>2))*QKP+(wid>>2)*32+(lane&3)*8;
  const unsigned kdst=lds0+LDS_K+wid*1024, vdst=lds0+LDS_V+wid*1024;
  #define ROWOFF(t) ((long)((t)*KVBLK+(((t)>=4)?kgap:0))*QKP)
  #define DMA_K(t,slot) glds16(ksrc+ROWOFF(t),(unsigned)__builtin_amdgcn_readfirstlane(kdst+(slot)))
  #define DMA_V(t,slot) glds16(vsrc+ROWOFF(t),(unsigned)__builtin_amdgcn_readfirstlane(vdst+(slot)))
  const int vb0=(int)(lds0+LDS_V)+((lane>>4)&1)*32+(lane&3)*8+(4*hi+((lane&15)>>2))*64;
  const char*Kbase=shm+LDS_K; bf16x8 kf[8];
  const lds_cptr shm3=(lds_cptr)shm; const lds_cptr kp0=shm3+LDS_K+hi*1024+r32*16; const lds_cptr vp0=shm3+LDS_V+((lane>>4)&1)*32+(lane&3)*8+(4*hi+((lane&15)>>2))*64;
  DMA_K(0,0);DMA_V(0,0);DMA_K(1,SLOTB);
  bf16x8 qr[4];
  #pragma unroll
  for(int d0=0;d0<4;++d0)qr[d0]=*reinterpret_cast<const bf16x8*>(&Qw[(long)r32*QKP+d0*16+hi*8]);
  float mhat=0.f,l_reg=0.f;f32x16 o[2];o[0]=f32x16{};o[1]=f32x16{};f32x16 negm=f32x16{};asm volatile("":"+v"(negm));
  const int qrel=wid*QBLK+r32;
  #define CMASK(P0,P1,t) do{ if(MODE==1&&(t)>=4)wmask(P0,P1,(t),qrel,hi,qoff); }while(0)
  bool resc=false;
  #define START(P0,P1) do{ const float rm=rowmax(P0,P1); resc=false; \
    { const float dl=rm; mhat=fadd_s(mhat,dl); \
      _Pragma("unroll") for(int r=0;r<16;++r){P0[r]=fsub_s(P0[r],dl);P1[r]=fsub_s(P1[r],dl);} \
      _Pragma("unroll") for(int r=0;r<16;++r)negm[r]=-mhat; asm volatile("":"+v"(negm)); } \
    _Pragma("unroll") for(int r=0;r<16;++r)P0[r]=__builtin_amdgcn_exp2f(P0[r]); }while(0)
  #define RESC() do{ if(resc){ asm volatile("s_waitcnt lgkmcnt(0)":::"memory"); \
      _Pragma("unroll") for(int d_=0;d_<2;++d_) _Pragma("unroll") for(int r=0;r<16;++r)o[d_][r]*=wsf[crow(r,hi)]; } }while(0)
  f32x16 pA0,pA1,pB0,pB1;
  int sl_prev=0,sl_cur=0,sl_next=SLOTB;
  #define ROT() do{sl_prev=sl_cur;sl_cur=sl_next;sl_next=(sl_next==(NSLOT-1)*SLOTB)?0:sl_next+SLOTB;}while(0)
  DMA_K(2,2*SLOTB);
  WAIT_BAR(3);
  qkt(pA0,pA1,Kbase,qr,negm,r32,hi);asm volatile("s_nop 15\n\ts_nop 7":"+v"(pA0),"+v"(pA1));CMASK(pA0,pA1,0);
  START(pA0,pA1);
  _Pragma("unroll") for(int r=0;r<16;++r)pA1[r]=__builtin_amdgcn_exp2f(pA1[r]);
  WAIT_BAR(0);
  DMA_K(3,0);DMA_V(1,SLOTB);
  ROT();
  kload8(kf,kp0+sl_cur);
  WAIT_BAR(2);
  s16x4 vlo[8],vhi[8]; u32x4 pw0,pw1,pw2,pw3;
  #define PKW(P,B) cvtpk_s(P[B],P[B+1])
  #define PAF(k) __builtin_bit_cast(bf16x8,pw##k)
  #define VFR(i) (bf16x8){vlo[i][0],vlo[i][1],vlo[i][2],vlo[i][3],vhi[i][0],vhi[i][1],vhi[i][2],vhi[i][3]}
  #define PIN(x) asm volatile("":"+v"(x))
  #define MX3(a,b,c) __builtin_fmaxf(__builtin_fmaxf((a),(b)),(c))
  #define GAPA(MF,A0,A1,A2,A3,W0,W1,PW) do{ MF; sacc+=A0; sacc+=A1; sacc+=A2; sacc+=A3; PIN(sacc); W0; W1; PIN(PW); SBAR(); }while(0)
  #define EX(v) __builtin_amdgcn_exp2f(v)
  #define GAPB(MF,X,B) do{ MF; X[B]=EX(X[B]); X[B+1]=EX(X[B+1]); X[B+2]=EX(X[B+2]); X[B+3]=EX(X[B+3]); PIN(X); SBAR(); }while(0)
  #define VRD(i) do{ vlo[i]=vtr(vp_+(((i)>>2)*4096+((i)&3)*1024)); vhi[i]=vtr(vp_+(((i)>>2)*4096+((i)&3)*1024+512)); }while(0)
  #define KRD(G,j) do{ if(G){ kload2(kf,kp0+sl_next,j); SBAR(); } }while(0)
  #define STEP(C0,C1,P0,P1,t,GK,GV,GL) do{ SBAR(); \
    const lds_cptr vp_=vp0+sl_prev; \
    VRD(0); SBAR(); float sacc=(P0[0]+P0[1]); \
    GAPA(C0=__builtin_amdgcn_mfma_f32_32x32x16_bf16(kf[0],qr[0],negm,0,0,0), P0[2],P0[3],P0[4],P0[5],     pw0[0]=PKW(P0,0), pw0[1]=PKW(P0,2), pw0); \
    VRD(4); SBAR(); GAPA(C1=__builtin_amdgcn_mfma_f32_32x32x16_bf16(kf[1],qr[0],negm,0,0,0), P0[6],P0[7],P0[8],P0[9],     pw0[2]=PKW(P0,4), pw0[3]=PKW(P0,6), pw0); \
    VRD(1); SBAR(); GAPA(C0=__builtin_amdgcn_mfma_f32_32x32x16_bf16(kf[2],qr[1],C0,0,0,0),   P0[10],P0[11],P0[12],P0[13], pw1[0]=PKW(P0,8), pw1[1]=PKW(P0,10), pw1); \
    VRD(5); SBAR(); GAPA(C1=__builtin_amdgcn_mfma_f32_32x32x16_bf16(kf[3],qr[1],C1,0,0,0),   P0[14],P0[15],P1[0],P1[1],   pw1[2]=PKW(P0,12),pw1[3]=PKW(P0,14), pw1); \
    VRD(2); SBAR(); GAPA(C0=__builtin_amdgcn_mfma_f32_32x32x16_bf16(kf[4],qr[2],C0,0,0,0),   P1[2],P1[3],P1[4],P1[5],     pw2[0]=PKW(P1,0), pw2[1]=PKW(P1,2), pw2); \
    VRD(6); SBAR(); GAPA(C1=__builtin_amdgcn_mfma_f32_32x32x16_bf16(kf[5],qr[2],C1,0,0,0),   P1[6],P1[7],P1[8],P1[9],     pw2[2]=PKW(P1,4), pw2[3]=PKW(P1,6), pw2); \
    VRD(3); SBAR(); GAPA(C0=__builtin_amdgcn_mfma_f32_32x32x16_bf16(kf[6],qr[3],C0,0,0,0),   P1[10],P1[11],P1[12],P1[13], pw3[0]=PKW(P1,8), pw3[1]=PKW(P1,10), pw3); \
    VRD(7); SBAR(); GAPA(C1=__builtin_amdgcn_mfma_f32_32x32x16_bf16(kf[7],qr[3],C1,0,0,0),   P1[14],P1[15],0.f,0.f,       pw3[2]=PKW(P1,12),pw3[3]=PKW(P1,14), pw3); \
    l_reg+=sacc; \
    if(GK){DMA_K((t)+3,sl_cur);} if(GV){DMA_V((t)+1,sl_next);} \
    CMASK(C0,C1,t); \
    { float a=MX3(C0[0],C0[1],C1[0]),b=MX3(C0[2],C0[3],C1[1]); a=MX3(a,C1[2],C1[3]); \
      _Pragma("unroll") for(int r=4;r<16;r+=4){a=MX3(a,C0[r],C0[r+1]);b=MX3(b,C0[r+2],C0[r+3]);a=MX3(a,C1[r],C1[r+1]);b=MX3(b,C1[r+2],C1[r+3]);} \
      float rm=__builtin_fmaxf(a,b); { auto rr=__builtin_amdgcn_permlane32_swap(__float_as_uint(rm),__float_as_uint(rm),false,false); rm=__builtin_fmaxf(__uint_as_float(rr[0]),__uint_as_float(rr[1])); } \
      resc=false; \
      if(__builtin_expect(__any(rm>(float)THRL),0)){ const float dl=__builtin_fmaxf(rm,0.f); mhat+=dl; \
        _Pragma("unroll") for(int r=0;r<16;++r){C0[r]-=dl;C1[r]-=dl;} \
        _Pragma("unroll") for(int r=0;r<16;++r)negm[r]=-mhat; asm volatile("":"+v"(negm)); \
        const float f=__builtin_amdgcn_exp2f(-dl); l_reg*=f; if(hi==0)wsf[r32]=f; resc=true; } } \
    SBAR(); \
    GAPB(o[0]=__builtin_amdgcn_mfma_f32_32x32x16_bf16(PAF(0),VFR(0),o[0],0,0,0), C0,0); \
    GAPB(o[1]=__builtin_amdgcn_mfma_f32_32x32x16_bf16(PAF(0),VFR(4),o[1],0,0,0), C0,4); \
    KRD(GL,0); GAPB(o[0]=__builtin_amdgcn_mfma_f32_32x32x16_bf16(PAF(1),VFR(1),o[0],0,0,0), C0,8); \
    KRD(GL,1); GAPB(o[1]=__builtin_amdgcn_mfma_f32_32x32x16_bf16(PAF(1),VFR(5),o[1],0,0,0), C0,12); \
    KRD(GL,2); GAPB(o[0]=__builtin_amdgcn_mfma_f32_32x32x16_bf16(PAF(2),VFR(2),o[0],0,0,0), C1,0); \
    KRD(GL,3); GAPB(o[1]=__builtin_amdgcn_mfma_f32_32x32x16_bf16(PAF(2),VFR(6),o[1],0,0,0), C1,4); \
    GAPB(o[0]=__builtin_amdgcn_mfma_f32_32x32x16_bf16(PAF(3),VFR(3),o[0],0,0,0), C1,8); \
    GAPB(o[1]=__builtin_amdgcn_mfma_f32_32x32x16_bf16(PAF(3),VFR(7),o[1],0,0,0), C1,12); \
    }while(0)
  int t=1;
  for(;t+5<NT;t+=2){
    STEP(pB0,pB1,pA0,pA1,t,true,true,true);     WAIT_BAR(2); RESC(); ROT();
    STEP(pA0,pA1,pB0,pB1,t+1,true,true,true);   WAIT_BAR(2); RESC(); ROT();
  }
  #define ENDW(tt) do{ if((tt)+3<NT){WAIT_BAR(2);} else if((tt)+2<NT){WAIT_BAR(1);} else {WAIT_BAR(0);} }while(0)
  for(;t+1<NT;t+=2){
    STEP(pB0,pB1,pA0,pA1,t,(t+3<NT),(t+1<NT),(t+1<NT));       ENDW(t);   RESC(); ROT();
    STEP(pA0,pA1,pB0,pB1,t+1,(t+4<NT),(t+2<NT),(t+2<NT));     ENDW(t+1); RESC(); ROT();
  }
  STEP(pB0,pB1,pA0,pA1,NT-1,false,false,false); RESC();
  { float sacc=pB0[0]+pB0[1]; _Pragma("unroll") for(int r=2;r<16;++r)sacc+=pB0[r]; _Pragma("unroll") for(int r=0;r<16;++r)sacc+=pB1[r]; l_reg+=sacc;
    pw0=(u32x4){PKW(pB0,0),PKW(pB0,2),PKW(pB0,4),PKW(pB0,6)};pw1=(u32x4){PKW(pB0,8),PKW(pB0,10),PKW(pB0,12),PKW(pB0,14)};pw2=(u32x4){PKW(pB1,0),PKW(pB1,2),PKW(pB1,4),PKW(pB1,6)};pw3=(u32x4){PKW(pB1,8),PKW(pB1,10),PKW(pB1,12),PKW(pB1,14)};
    SBAR(); pv(o,vb0+sl_cur,PAF(0),PAF(1),PAF(2),PAF(3)); }
  #undef PKW
  #undef PAF
  #undef VFR
  #undef PIN
  #undef MX3
  #undef GAPA
  #undef GAPB
  #undef EX
  #undef VRD
  #undef KRD
  #undef STEP
  #undef ENDW
  {auto rr=__builtin_amdgcn_permlane32_swap(__float_as_uint(l_reg),__float_as_uint(l_reg),false,false);l_reg=__uint_as_float(rr[0])+__uint_as_float(rr[1]);}
  l_reg+=__builtin_amdgcn_exp2f(sink2-mhat);
  if(hi==0)wsf[32+r32]=l_reg;asm volatile("s_waitcnt lgkmcnt(0)":::"memory");
  float rli[16];
  #pragma unroll
  for(int r=0;r<16;++r)rli[r]=__builtin_amdgcn_rcpf(wsf[32+crow(r,hi)]);
  bf16*Ow=Ou+(long)(wid*QBLK)*OPITCH;
  { bf16*stg=(bf16*)(shm+LDS_OST)+wid*2048;
    #pragma unroll
    for(int r=0;r<16;++r){const int orow=crow(r,hi);
      #pragma unroll
      for(int d0=0;d0<2;++d0)stg[orow*64+d0*32+r32]=(bf16)f2bf(o[d0][r]*rli[r]);}
    asm volatile("s_waitcnt lgkmcnt(0)":::"memory");
    #pragma unroll
    for(int i=0;i<4;++i){const int row=i*8+(lane>>3),ch=lane&7; const u32x4 v=*(const u32x4*)(stg+row*64+ch*8); ATTN_STORE16(Ow+(long)row*OPITCH+ch*8,v);} }
  asm volatile("s_waitcnt lgkmcnt(0)\n\ts_barrier":::"memory");
  #undef ROWOFF
  #undef DMA_K
  #undef DMA_V
  #undef CMASK
  #undef START
  #undef RESC
  #undef ROT
}
constexpr int ATTN_LDS_BYTES=LDS_BYTES;
#undef SBAR
#undef WAIT_BAR
}
namespace ret {
constexpr int RSV = 136, RSK = 72;
constexpr int NCH = TPB / 128;
typedef short v4i16_t __attribute__((ext_vector_type(4)));
__device__ __forceinline__ s16x4 trd(const LAS char* p) { return __builtin_bit_cast(s16x4, __builtin_amdgcn_ds_read_tr16_b64_v4i16((LAS v4i16_t*)p)); }
#define RET_FRAG(lo, hi) (bf16x8){lo[0], lo[1], lo[2], lo[3], hi[0], hi[1], hi[2], hi[3]}
__device__ __forceinline__ size_t kvs_index(int dir, int b, int cidx, int hd) { return ((((size_t)dir * NB + b) * NCH + cidx) * 4 + hd) * 8192; }

__device__ __forceinline__ void stage_v(const bf16_t* P, int row0, int hd, LAS char* vimg, int tid) {
#pragma unroll
    for (int i = 0; i < 4; ++i) { const int c = tid + 512 * i, j = c >> 4, ch = c & 15;
        const u32x4 v = *(const u32x4*)(P + (size_t)(row0 + j) * PC + 1280 + 128 * hd + 8 * ch);
        *(LAS u32x4*)(vimg + (j * RSV + 8 * ch) * 2) = v; }
}

__device__ __forceinline__ void kvinc_unit(const bf16_t* P, float* KVS, int b, int hd, int cidx, float lgf2, float lgb2, LAS char* lds, const int tid) {
    const int lane = tid & 63, wid = __builtin_amdgcn_readfirstlane(tid >> 6), r = lane & 31, hh = lane >> 5;
    const int row0 = b * TPB + 128 * cidx;
    LAS char* kimg0 = lds; LAS char* kimg1 = lds + 128 * RSK * 2; LAS char* vimg = lds + 2 * 128 * RSK * 2;
#pragma unroll
    for (int i = 0; i < 2; ++i) { const int c = tid + 512 * i, j = c >> 3, ch = c & 7;
        const u32x4 kw = *(const u32x4*)(P + (size_t)(row0 + j) * PC + 1024 + 64 * hd + 8 * ch);
        const float wf = __builtin_amdgcn_exp2f((float)(127 - j) * lgf2), wb = __builtin_amdgcn_exp2f((float)j * lgb2);
        f32x4 a, bq; pg8::unpack8(kw, a, bq);
        *(LAS u32x4*)(kimg0 + (j * RSK + 8 * ch) * 2) = pg8::pack8(a * wf, bq * wf);
        *(LAS u32x4*)(kimg1 + (j * RSK + 8 * ch) * 2) = pg8::pack8(a * wb, bq * wb); }
    stage_v(P, row0, hd, vimg, tid);
    LDS_WAIT(); __syncthreads();
    const int dir = wid >> 2, eb = wid & 3;
    const LAS char* kimg = dir ? kimg1 : kimg0;
    const int q = (lane & 15) >> 2, p = lane & 3, c16 = 16 * ((lane >> 4) & 1) + 4 * p;
    f32x16 acc[2]; acc[0] = f32x16{}; acc[1] = f32x16{};
#pragma unroll
    for (int ks = 0; ks < 8; ++ks) {
        const int j0 = 16 * ks + 8 * hh + q;
        const s16x4 vlo = trd(vimg + (j0 * RSV + 32 * eb + c16) * 2), vhi = trd(vimg + ((j0 + 4) * RSV + 32 * eb + c16) * 2);
        const bf16x8 vf = RET_FRAG(vlo, vhi);
#pragma unroll
        for (int db = 0; db < 2; ++db) {
            const s16x4 klo = trd(kimg + (j0 * RSK + 32 * db + c16) * 2), khi = trd(kimg + ((j0 + 4) * RSK + 32 * db + c16) * 2);
            acc[db] = __builtin_amdgcn_mfma_f32_32x32x16_bf16(RET_FRAG(klo, khi), vf, acc[db], 0, 0, 0);
        }
    }
    float* out = KVS + kvs_index(dir, b, cidx, hd);
#pragma unroll
    for (int db = 0; db < 2; ++db)
#pragma unroll
        for (int reg = 0; reg < 16; ++reg) { const int d = 32 * db + (reg & 3) + 8 * (reg >> 2) + 4 * hh; out[d * 128 + 32 * eb + r] = acc[db][reg]; }
    __syncthreads();
}

__device__ __forceinline__ void scan_phase(float* KVS, const float* retc_l, int gtid, int gthreads) {
    for (int idx = gtid; idx < 2 * NB * 4 * 8192; idx += gthreads) {
        const int el = idx & 8191, seq = idx >> 13, hd = seq & 3, b = (seq >> 2) & 3, dir = seq >> 4;
        const float dec = retc_l[(dir * 4 + hd) * 2 + 1];
        float* base = KVS + kvs_index(dir, b, 0, hd) + el;
        float v[NCH];
#pragma unroll
        for (int n = 0; n < NCH; ++n) { const int cidx = dir == 0 ? n : (n < 2 ? 1 - n : 35 - n); v[n] = base[(size_t)cidx * 4 * 8192]; }
        float st = 0.f;
#pragma unroll
        for (int n = 0; n < NCH; ++n) { const int cidx = dir == 0 ? n : (n < 2 ? 1 - n : 35 - n); base[(size_t)cidx * 4 * 8192] = st; st = st * dec + v[n]; }
    }
}

__device__ __forceinline__ void retout_unit(const bf16_t* P, const float* KVS, bf16_t* Y3, const float* gainl, int b, int hd, int cidx, float lgf2, float lgb2, LAS char* lds, const int tid) {
    const int lane = tid & 63, wid = __builtin_amdgcn_readfirstlane(tid >> 6), r = lane & 31, hh = lane >> 5;
    const int row0 = b * TPB + 128 * cidx, ib = wid & 3, eh = wid >> 2;
    LAS char* vimg = lds; LAS char* himg0 = lds + 128 * RSV * 2; LAS char* himg1 = himg0 + 64 * RSV * 2;
    LAS float* part1 = (LAS float*)(himg1 + 64 * RSV * 2); LAS float* part2 = part1 + 256;
    stage_v(P, row0, hd, vimg, tid);
#pragma unroll
    for (int dir = 0; dir < 2; ++dir) { const float* H = KVS + kvs_index(dir, b, cidx, hd); LAS char* himg = dir ? himg1 : himg0;
#pragma unroll
        for (int i = 0; i < 4; ++i) { const int c = tid + 512 * i, d = c >> 5, e4 = (c & 31) * 4;
            const f32x4 v = *(const f32x4*)(H + d * 128 + e4);
            u32x2 w; w.x = pk2(v[0], v[1]); w.y = pk2(v[2], v[3]);
            *(LAS u32x2*)(himg + (d * RSV + e4) * 2) = w; } }
    const int iloc = 32 * ib + r;
    bf16x8 qr[4];
#pragma unroll
    for (int d0 = 0; d0 < 4; ++d0) qr[d0] = *(const bf16x8*)(P + (size_t)(row0 + iloc) * PC + 768 + 64 * hd + 16 * d0 + 8 * hh);
    LDS_WAIT(); __syncthreads();
    const int q = (lane & 15) >> 2, p = lane & 3, c16 = 16 * ((lane >> 4) & 1) + 4 * p;
    f32x16 O[2]; O[0] = f32x16{}; O[1] = f32x16{};
#pragma unroll 1
    for (int jb = 0; jb < 4; ++jb) {
        f32x16 X = f32x16{};
#pragma unroll
        for (int d0 = 0; d0 < 4; ++d0) { const bf16x8 kf = *(const bf16x8*)(P + (size_t)(row0 + 32 * jb + r) * PC + 1024 + 64 * hd + 16 * d0 + 8 * hh);
            X = __builtin_amdgcn_mfma_f32_32x32x16_bf16(kf, qr[d0], X, 0, 0, 0); }
#pragma unroll
        for (int reg = 0; reg < 16; ++reg) { const int jloc = 32 * jb + (reg & 3) + 8 * (reg >> 2) + 4 * hh, dl = iloc - jloc;
            const float w = dl > 0 ? __builtin_amdgcn_exp2f((float)dl * lgf2) : (dl < 0 ? __builtin_amdgcn_exp2f((float)(-dl) * lgb2) : 2.0f);
            X[reg] *= w; }
        u32x4 pw[2];
        pw[0] = (u32x4){pk2(X[0], X[1]), pk2(X[2], X[3]), pk2(X[4], X[5]), pk2(X[6], X[7])};
        pw[1] = (u32x4){pk2(X[8], X[9]), pk2(X[10], X[11]), pk2(X[12], X[13]), pk2(X[14], X[15])};
#pragma unroll
        for (int s = 0; s < 2; ++s) { const int j0 = 32 * jb + 16 * s + 4 * hh + q;
#pragma unroll
            for (int eb = 0; eb < 2; ++eb) { const int ec = 32 * (2 * eh + eb) + c16;
                const s16x4 lo = trd(vimg + (j0 * RSV + ec) * 2), hi = trd(vimg + ((j0 + 8) * RSV + ec) * 2);
                O[eb] = __builtin_amdgcn_mfma_f32_32x32x16_bf16(__builtin_bit_cast(bf16x8, pw[s]), RET_FRAG(lo, hi), O[eb], 0, 0, 0); } }
    }
#pragma unroll
    for (int dir = 0; dir < 2; ++dir) {
        const float fac = dir == 0 ? __builtin_amdgcn_exp2f((float)(iloc + 1) * lgf2) : __builtin_amdgcn_exp2f((float)(128 - iloc) * lgb2);
        const LAS char* himg = dir ? himg1 : himg0;
#pragma unroll
        for (int d0 = 0; d0 < 4; ++d0) {
            f32x4 a, bq; pg8::unpack8(__builtin_bit_cast(u32x4, qr[d0]), a, bq);
            const u32x4 qs = (u32x4){pk2(a[0] * fac, a[1] * fac), pk2(a[2] * fac, a[3] * fac), pk2(bq[0] * fac, bq[1] * fac), pk2(bq[2] * fac, bq[3] * fac)};
            const int dd0 = 16 * d0 + 8 * hh + q;
#pragma unroll
            for (int eb = 0; eb < 2; ++eb) { const int ec = 32 * (2 * eh + eb) + c16;
                const s16x4 lo = trd(himg + (dd0 * RSV + ec) * 2), hi = trd(himg + ((dd0 + 4) * RSV + ec) * 2);
                O[eb] = __builtin_amdgcn_mfma_f32_32x32x16_bf16(__builtin_bit_cast(bf16x8, qs), RET_FRAG(lo, hi), O[eb], 0, 0, 0); } }
    }
    float mean[16], rstd[16];
#pragma unroll
    for (int reg = 0; reg < 16; ++reg) { float s = O[0][reg] + O[1][reg];
        s = half_sum(s);
        mean[reg] = s; }
    if (r == 0) {
#pragma unroll
        for (int reg = 0; reg < 16; ++reg) part1[eh * 128 + 32 * ib + (reg & 3) + 8 * (reg >> 2) + 4 * hh] = mean[reg]; }
    LDS_WAIT(); __syncthreads();
#pragma unroll
    for (int reg = 0; reg < 16; ++reg) { const int i = 32 * ib + (reg & 3) + 8 * (reg >> 2) + 4 * hh; mean[reg] = (part1[i] + part1[128 + i]) * (1.0f / 128.0f); }
#pragma unroll
    for (int reg = 0; reg < 16; ++reg) { const float d0 = O[0][reg] - mean[reg], d1 = O[1][reg] - mean[reg]; float s = d0 * d0 + d1 * d1;
        s = half_sum(s);
        rstd[reg] = s; }
    if (r == 0) {
#pragma unroll
        for (int reg = 0; reg < 16; ++reg) part2[eh * 128 + 32 * ib + (reg & 3) + 8 * (reg >> 2) + 4 * hh] = rstd[reg]; }
    LDS_WAIT(); __syncthreads();
#pragma unroll
    for (int reg = 0; reg < 16; ++reg) { const int i = 32 * ib + (reg & 3) + 8 * (reg >> 2) + 4 * hh; rstd[reg] = rsqrtf((part2[i] + part2[128 + i]) * (1.0f / 128.0f) + EPS); }
#pragma unroll
    for (int eb = 0; eb < 2; ++eb) { const int e = 32 * (2 * eh + eb) + r; const float gn = gainl[128 * hd + e];
#pragma unroll
        for (int reg = 0; reg < 16; ++reg) { const size_t row = (size_t)(row0 + 32 * ib + (reg & 3) + 8 * (reg >> 2) + 4 * hh);
            const float sg = bflo((unsigned)P[row * PC + 1792 + 128 * hd + e]);
            Y3[row * 1536 + 512 + 128 * hd + e] = (bf16_t)f2bf((O[eb][reg] - mean[reg]) * rstd[reg] * gn * sg); } }
    __syncthreads();
}
}
__device__ __forceinline__ void tr_item(const float* W, int K, int N, bf16_t* WT, int mode, int item, LAS float* scr, int lane) {
    const int nblk = N / 32, kb = item / nblk, nb = item % nblk, k0 = 64 * kb, n0 = 32 * nb;
    int drow0 = n0;
    if (mode == 1) { const int T = n0 >> 8, cl = n0 & 255; const bool head = (T <= 4) || (T >= 9 && T <= 11); if (head) drow0 = 256 * T + 128 * ((cl >> 5) & 1) + 32 * (cl >> 6); }
    else if (mode >= 2) { drow0 = 256 * (n0 >> 7) + 128 * (mode - 2) + (n0 & 127); }
    float v[32];
#pragma unroll
    for (int i = 0; i < 32; ++i) { const int kk = 2 * i + (lane >> 5); v[i] = W[(size_t)(k0 + kk) * N + n0 + (lane & 31)]; }
#pragma unroll
    for (int i = 0; i < 32; ++i) { const int kk = 2 * i + (lane >> 5); scr[kk * 33 + (lane & 31)] = v[i]; }
    LDS_WAIT(); asm volatile("" ::: "memory");
    const int c = lane & 7;
#pragma unroll
    for (int j = 0; j < 4; ++j) { const int n = (lane >> 3) + 8 * j; const LAS float* s = scr + (8 * c) * 33 + n;
        u32x4 o; o.x = pk2(s[0 * 33], s[1 * 33]); o.y = pk2(s[2 * 33], s[3 * 33]); o.z = pk2(s[4 * 33], s[5 * 33]); o.w = pk2(s[6 * 33], s[7 * 33]);
        *(u32x4*)(WT + (size_t)(drow0 + n) * K + k0 + 8 * c) = o; }
    LDS_WAIT(); asm volatile("" ::: "memory");
}

struct Ptrs {
    const float *x, *c, *ctx, *c_ctx, *w_ada, *b_ada, *norm1_g, *norm2_g, *final_g, *w_in, *b_gate, *qn_a, *kn_a, *ret_a, *ret_g, *sink_c,
                *w_br_a, *w_br_b, *w_br_c, *w_out, *ffn_w1, *ffn_w3, *ffn_w2, *router_w, *router_b, *exp_w1, *exp_w3, *exp_w2;
};

__device__ __forceinline__ void prologue_phase(const Ptrs& I, unsigned char* ws, LAS unsigned char* lds, int tid, int lane, int wave, int G) {
    LAS float* sv = (LAS float*)(lds + 69632);
    LAS float* part = (LAS float*)(lds + 69632 + 20480);
    for (int i = tid; i < 5 * 1024; i += NTHR) { const int who = i >> 10, k = i & 1023; const float cv = who < 4 ? I.c[who * 1024 + k] : I.c_ctx[k]; sv[i] = siluf_(cv); }
    LDS_WAIT(); __syncthreads();
    float* MODS = (float*)(ws + WS_MODS);
    for (int it = blockIdx.x; it < DEPTH * 96; it += G) {
        const int l = it / 96, cg = it % 96, col = cg * 64 + lane;
        const float* wp = I.w_ada + ((size_t)l * 1024 + wave * 128) * INC + col;
        float a0 = 0.f, a1 = 0.f, a2 = 0.f, a3 = 0.f, a4 = 0.f;
#pragma unroll 16
        for (int k = 0; k < 128; ++k) { const float w = wp[(size_t)k * INC]; const int kk = wave * 128 + k;
            a0 += sv[kk] * w; a1 += sv[1024 + kk] * w; a2 += sv[2048 + kk] * w; a3 += sv[3072 + kk] * w; a4 += sv[4096 + kk] * w; }
        part[(wave * 5 + 0) * 64 + lane] = a0; part[(wave * 5 + 1) * 64 + lane] = a1; part[(wave * 5 + 2) * 64 + lane] = a2; part[(wave * 5 + 3) * 64 + lane] = a3; part[(wave * 5 + 4) * 64 + lane] = a4;
        LDS_WAIT(); __syncthreads();
        if (tid < 320) { const int who = tid >> 6, ln = tid & 63; float s = I.b_ada[(size_t)l * INC + cg * 64 + ln];
#pragma unroll
            for (int w = 0; w < 8; ++w) s += part[(w * 5 + who) * 64 + ln];
            MODS[((size_t)l * 5 + who) * INC + cg * 64 + ln] = s; }
        __syncthreads();
    }
    if (blockIdx.x == 0) { float* R = (float*)(ws + WS_ROPE);
        for (int i = tid; i < 1024; i += NTHR) { const int pos = i >> 4, f = i & 15; const float inv = powf(10000.0f, -(float)f / 16.0f); const float ang = (float)pos * inv; R[2 * i] = cosf(ang); R[2 * i + 1] = sinf(ang); } }
    if (blockIdx.x == 1 % G && tid < DEPTH * 8) { float* RC = (float*)(ws + WS_RETC); const float a = I.ret_a[tid]; const float lg = -log1pf(expf(-a)); RC[2 * tid] = lg * LOG2E; RC[2 * tid + 1] = expf(128.0f * lg); }
    LAS float* scr = (LAS float*)(lds + wave * 8704);
    const int gw = blockIdx.x * NWAVES + wave, NGW = G * NWAVES;
    constexpr int NA = 4 * 3072, NBR = 12 * 256, NO = 4 * 512, ND13 = 4 * 1408, ND2 = 2 * 1408, NE13 = 32 * 1792, NE2 = 16 * 1792;
    constexpr int TOT = NA + NBR + NO + ND13 + ND2 + NE13 + NE2;
    for (int it = gw; it < TOT; it += NGW) {
        int r = it;
        if (r < NA) { const int l = r / 3072; tr_item(I.w_in + (size_t)l * D * INC, D, INC, (bf16_t*)(ws + WS_WIN) + (size_t)l * INC * D, 1, r % 3072, scr, lane); continue; } r -= NA;
        if (r < NBR) { const int q = r / 256, l = q / 3, br = q % 3; const float* src = (br == 0 ? I.w_br_a : br == 1 ? I.w_br_b : I.w_br_c) + (size_t)l * 512 * D;
            tr_item(src, 512, D, (bf16_t*)(ws + WS_WBR) + (size_t)q * D * 512, 0, r % 256, scr, lane); continue; } r -= NBR;
        if (r < NO) { const int l = r / 512; tr_item(I.w_out + (size_t)l * D * D, D, D, (bf16_t*)(ws + WS_WOUT) + (size_t)l * D * D, 0, r % 512, scr, lane); continue; } r -= NO;
        if (r < ND13) { const int q = r / 1408, j = q >> 1, wh = q & 1; tr_item((wh ? I.ffn_w3 : I.ffn_w1) + (size_t)j * D * DFF, D, DFF, (bf16_t*)(ws + WS_W13) + (size_t)j * 2 * DFF * D, 2 + wh, r % 1408, scr, lane); continue; } r -= ND13;
        if (r < ND2) { const int j = r / 1408; tr_item(I.ffn_w2 + (size_t)j * DFF * D, DFF, D, (bf16_t*)(ws + WS_W2) + (size_t)j * D * DFF, 0, r % 1408, scr, lane); continue; } r -= ND2;
        if (r < NE13) { const int q = r / 1792, je = q >> 1, wh = q & 1; tr_item((wh ? I.exp_w3 : I.exp_w1) + (size_t)je * D * DFE, D, DFE, (bf16_t*)(ws + WS_E13) + (size_t)je * 2 * DFE * D, 2 + wh, r % 1792, scr, lane); continue; } r -= NE13;
        { const int je = r / 1792; tr_item(I.exp_w2 + (size_t)je * DFE * D, DFE, D, (bf16_t*)(ws + WS_E2) + (size_t)je * D * DFE, 0, r % 1792, scr, lane); }
    }
}

struct NormArgs {
    const float* g; const float* shift; const float* scale;
    const float* gate2p; const bf16_t* Y; const int* DST;
    const float* rw; const float* rb; unsigned* cnt; int* PE; int* PPOS; float* PW;
};
__device__ __forceinline__ void norm_row(const float* src, float* xs_out, bf16_t* hn, int row, const NormArgs& A, int lane) {
    f32x4 v[4]; float ss = 0.f;
#pragma unroll
    for (int j = 0; j < 4; ++j) v[j] = *(const f32x4*)(src + 4 * lane + 256 * j);
    if (A.gate2p) { const int d0 = A.DST[2 * row], d1 = A.DST[2 * row + 1];
#pragma unroll
        for (int j = 0; j < 4; ++j) { const int c = 4 * lane + 256 * j; const u32x2 y0 = *(const u32x2*)(A.Y + (size_t)d0 * D + c), y1 = *(const u32x2*)(A.Y + (size_t)d1 * D + c); const f32x4 gt = *(const f32x4*)(A.gate2p + c);
            v[j][0] += gt[0] * (bflo(y0.x) + bflo(y1.x)); v[j][1] += gt[1] * (bfhi(y0.x) + bfhi(y1.x)); v[j][2] += gt[2] * (bflo(y0.y) + bflo(y1.y)); v[j][3] += gt[3] * (bfhi(y0.y) + bfhi(y1.y)); } }
    if (xs_out) {
#pragma unroll
        for (int j = 0; j < 4; ++j) *(f32x4*)(xs_out + 4 * lane + 256 * j) = v[j]; }
#pragma unroll
    for (int j = 0; j < 4; ++j) ss += (v[j][0] * v[j][0] + v[j][1] * v[j][1]) + (v[j][2] * v[j][2] + v[j][3] * v[j][3]);
    const float rs = rsqrtf(wave_sum(ss) * (1.0f / D) + EPS);
    float lg[8];
#pragma unroll
    for (int e = 0; e < 8; ++e) lg[e] = 0.f;
#pragma unroll
    for (int j = 0; j < 4; ++j) { const int c = 4 * lane + 256 * j; const f32x4 gg = *(const f32x4*)(A.g + c), sh = *(const f32x4*)(A.shift + c), sc = *(const f32x4*)(A.scale + c);
        f32x4 h = v[j] * rs * gg * (sc + 1.0f) + sh;
        u32x2 w; w.x = pk2(h[0], h[1]); w.y = pk2(h[2], h[3]); *(u32x2*)(hn + c) = w;
        if (A.rw) {
#pragma unroll
            for (int x = 0; x < 4; ++x) { const f32x4 r0 = *(const f32x4*)(A.rw + (size_t)(c + x) * 8), r1 = *(const f32x4*)(A.rw + (size_t)(c + x) * 8 + 4);
                lg[0] += h[x] * r0[0]; lg[1] += h[x] * r0[1]; lg[2] += h[x] * r0[2]; lg[3] += h[x] * r0[3]; lg[4] += h[x] * r1[0]; lg[5] += h[x] * r1[1]; lg[6] += h[x] * r1[2]; lg[7] += h[x] * r1[3]; } } }
    if (A.rw) {
#pragma unroll
        for (int e = 0; e < 8; ++e) lg[e] = wave_sum(lg[e]) + A.rb[e];
        int i1 = 0; float v1 = lg[0];
#pragma unroll
        for (int e = 1; e < 8; ++e) if (lg[e] > v1) { v1 = lg[e]; i1 = e; }
        int i2 = -1; float v2 = -INFINITY;
#pragma unroll
        for (int e = 0; e < 8; ++e) if (e != i1 && lg[e] > v2) { v2 = lg[e]; i2 = e; }
        if (lane == 0) { const float w1 = 1.0f / (1.0f + __expf(v2 - v1));
            const unsigned p1 = __hip_atomic_fetch_add(A.cnt + 64 * i1, 1u, RLX_AGENT), p2 = __hip_atomic_fetch_add(A.cnt + 64 * i2, 1u, RLX_AGENT);
            A.PE[2 * row] = i1; A.PE[2 * row + 1] = i2; A.PPOS[2 * row] = (int)p1; A.PPOS[2 * row + 1] = (int)p2; A.PW[2 * row] = w1; A.PW[2 * row + 1] = 1.0f - w1; }
    }
}
struct SchedPlain {
    const char* A; const char* B; size_t aTile, bTile; int nM, nN, G, c; bool latOnly;
    __device__ __forceinline__ bool next(int i, pg8::Unit& u) const {
        int pm, pn; if (!pg8::tile_of((long)i * G + c, nM, nN, pm, pn)) return false;
        if (latOnly) pm = pm + pm / 16 + 1;
        u.pm = pm; u.pn = pn; u.aux = 0; u.A = A + (size_t)pm * aTile; u.B = B + (size_t)pn * bTile; return true; }
};
struct SchedBranch {
    const char* Y3; const char* W; int nM, G, c; bool latOnly;
    __device__ __forceinline__ bool next(int i, pg8::Unit& u) const {
        const int ti = i / 3, br = i - 3 * ti; int pm, pn; if (!pg8::tile_of((long)ti * G + c, nM, 4, pm, pn)) return false;
        if (latOnly) pm = pm + pm / 16 + 1;
        u.pm = pm; u.pn = pn; u.aux = br; u.A = Y3 + (size_t)pm * (256 * 1536 * 2) + br * 1024; u.B = W + (size_t)br * (1024 * 512 * 2) + (size_t)pn * (256 * 512 * 2); return true; }
};
struct SchedMoE {
    const char* A; const char* B; size_t aTile, bTile, eStride; int nM, nN, G, c; int ts1, ts2, ts3, ts4, ts5, ts6, ts7;
    __device__ __forceinline__ bool next(int i, pg8::Unit& u) const {
        int pm, pn; if (!pg8::tile_of((long)i * G + c, nM, nN, pm, pn)) return false;
        const int e = (pm >= ts1) + (pm >= ts2) + (pm >= ts3) + (pm >= ts4) + (pm >= ts5) + (pm >= ts6) + (pm >= ts7);
        u.pm = pm; u.pn = pn; u.aux = e; u.A = A + (size_t)pm * aTile; u.B = B + (size_t)e * eStride + (size_t)pn * bTile; return true; }
};

struct Args { Ptrs in; float* out; unsigned char* ws; };
typedef const __attribute__((address_space(4))) unsigned char* kargp_t;
__device__ __forceinline__ kargp_t kfresh() { kargp_t p = (kargp_t)__builtin_amdgcn_kernarg_segment_ptr(); asm volatile("" : "+s"(p)); return p; }
#define KIN(idx) (((const float* const __attribute__((address_space(4)))*)kfresh())[idx])
#define KOUT() (((float* const __attribute__((address_space(4)))*)kfresh())[28])
#define KWS() (((unsigned char* const __attribute__((address_space(4)))*)kfresh())[29])
enum { I_x, I_c, I_ctx, I_c_ctx, I_w_ada, I_b_ada, I_norm1_g, I_norm2_g, I_final_g, I_w_in, I_b_gate, I_qn_a, I_kn_a, I_ret_a, I_ret_g, I_sink_c, I_w_br_a, I_w_br_b, I_w_br_c, I_w_out, I_ffn_w1, I_ffn_w3, I_ffn_w2, I_router_w, I_router_b, I_exp_w1, I_exp_w3, I_exp_w2 };
static_assert(sizeof(Args) == 30 * 8, "Args layout");
#define WSP(T, off) ((T*)(ws + (off)))
__global__ void __launch_bounds__(NTHR, 2) fwd_kernel(Args) {
    extern __shared__ __attribute__((aligned(16))) unsigned char lds_raw[];
    LAS unsigned char* lds = (LAS unsigned char*)lds_raw;
    volatile LAS unsigned* MISC = (volatile LAS unsigned*)(lds + MISC_OFF);
    const int G = gridDim.x, bx = blockIdx.x, wave_s = __builtin_amdgcn_readfirstlane((int)threadIdx.x >> 6);
#define PHASE_IDS() const int tid = fresh_tid(wave_s), lane = tid & 63, wave = __builtin_amdgcn_readfirstlane(tid >> 6), gw = bx * NWAVES + wave, NGW = G * NWAVES; (void)lane; (void)gw; (void)NGW
    const int vcu = (G % 8 == 0) ? (bx % 8) * (G / 8) + bx / 8 : bx;
    for (int u = threadIdx.x; u < (LDS_BYTES - LDSCTL_OFF) / 4; u += NTHR) ((LAS unsigned*)(lds + LDSCTL_OFF))[u] = 0u;
    __syncthreads();
    (void)xcd_barrier_post((unsigned*)(KWS() + WS_CTL) + CW_BAR, MISC + 8);
#define GRID_BAR() do { XcdBarrier b_; b_.bar = (unsigned*)(KWS() + WS_CTL) + CW_BAR; b_.x = xb_xcc_id(); b_.st = MISC + 8; xcd_barrier(b_); } while (0)

#ifndef SKIP_P0
    {
        PHASE_IDS(); Ptrs I; { const float** pp = (const float**)&I; kargp_t kp = kfresh();
#pragma unroll
            for (int i = 0; i < 28; ++i) pp[i] = ((const float* const __attribute__((address_space(4)))*)kp)[i]; }
        prologue_phase(I, KWS(), lds, tid, lane, wave, G);
    }
#endif
    GRID_BAR();

#pragma unroll 1
    for (int l = 0; l < DEPTH; ++l) {
        const bool need_ctx = (l < DEPTH - 1), moe = (l & 1) != 0; const int jf = l >> 1;
#ifndef SKIP_N1
        {
            PHASE_IDS(); unsigned char* ws = KWS(); float* XS = WSP(float, WS_XS); bf16_t* HN = WSP(bf16_t, WS_HN); const float* MODS = WSP(float, WS_MODS);
            const float* modl = MODS + (size_t)l * 5 * INC;
            const bool comb = (l == 2);
            const float* xin = KIN(I_x); const float* cin = KIN(I_ctx); const float* g1 = KIN(I_norm1_g) + (size_t)l * D;
            for (int row = gw; row < M; row += NGW) {
                const int b = row / TPB, tq = row - b * TPB, who = tq < CTXL ? 4 : b;
                const float* src = (l == 0) ? (tq < CTXL ? cin + ((size_t)b * CTXL + tq) * D : xin + ((size_t)b * SEQ + (tq - CTXL)) * D) : XS + (size_t)row * D;
                NormArgs A{}; A.g = g1; A.shift = modl + (size_t)who * INC; A.scale = modl + (size_t)who * INC + D;
                if (comb) { A.gate2p = MODS + ((size_t)(l - 1) * 5 + who) * INC + 5 * D; A.Y = WSP(bf16_t, WS_R2); A.DST = (const int*)(ws + WS_META + MT_DST); }
                norm_row(src, (l == 0 || comb) ? XS + (size_t)row * D : nullptr, HN + (size_t)row * D, row, A, lane);
            }
        }
#endif
        GRID_BAR();
#ifndef SKIP_G1
        {
            unsigned char* ws = KWS();
            SchedPlain S{(const char*)WSP(bf16_t, WS_HN), (const char*)(WSP(bf16_t, WS_WIN) + (size_t)l * INC * D), (size_t)256 * D * 2, (size_t)256 * D * 2, NMT, INC / 256, G, bx, false};
            pg8::EpiInProj E{WSP(bf16_t, WS_P), WSP(bf16_t, WS_G), KIN(I_qn_a) + l * 64, KIN(I_kn_a) + l * 64, KIN(I_b_gate) + (size_t)l * 3 * D, WSP(float, WS_ROPE)};
            pg8::gemm_phase<pg8::EpiInProj, SchedPlain, true>(lds, fresh_tid(wave_s), D, D, D, S, E);
        }
#endif
        GRID_BAR();
#ifndef SKIP_A1
        {
            unsigned char* ws = KWS(); const float* rc = WSP(float, WS_RETC) + l * 16;
            for (int u = bx; u < NB * 4 * ret::NCH; u += G) {
                const int b = u / (4 * ret::NCH), hd = (u / ret::NCH) & 3, cidx = u % ret::NCH;
                const float lgf2 = rc[2 * hd], lgb2 = rc[8 + 2 * hd];
                ret::kvinc_unit(WSP(bf16_t, WS_P), WSP(float, WS_KVS), b, hd, cidx, lgf2, lgb2, (LAS char*)lds, fresh_tid(wave_s));
            }
        }
#endif
        GRID_BAR();
#ifndef SKIP_A2
        { PHASE_IDS(); unsigned char* ws = KWS(); ret::scan_phase(WSP(float, WS_KVS), WSP(float, WS_RETC) + l * 16, bx * NTHR + tid, G * NTHR); }
#endif
        GRID_BAR();
#ifndef SKIP_RO
        {
            unsigned char* ws = KWS(); const float* rc = WSP(float, WS_RETC) + l * 16; const float* rg = KIN(I_ret_g) + (size_t)l * 512;
            for (int u = bx; u < NB * 4 * ret::NCH; u += G) {
                const int b = u / (4 * ret::NCH), hd = (u / ret::NCH) & 3, cidx = u % ret::NCH;
                if (!need_ctx && cidx < 2) continue;
                const float lgf2 = rc[2 * hd], lgb2 = rc[8 + 2 * hd];
                ret::retout_unit(WSP(bf16_t, WS_P), WSP(float, WS_KVS), WSP(bf16_t, WS_Y3), rg, b, hd, cidx, lgf2, lgb2, (LAS char*)lds, fresh_tid(wave_s));
            }
        }
#endif
#ifndef SKIP_AT0
        {
            unsigned char* ws = KWS(); const bf16_t* P = WSP(bf16_t, WS_P); bf16_t* Y3 = WSP(bf16_t, WS_Y3); const float* snk = KIN(I_sink_c) + l * 8;
            const int nU0 = 512 + (need_ctx ? 64 : 0);
#pragma unroll 1
            for (int k = 0;; ++k) {
                int uu;
                if (G == 256) { if (k < 2) uu = (vcu >> 5) * 64 + (vcu & 31) * 2 + k; else if (k == 2 && vcu < 64 && need_ctx) uu = 512 + vcu; else break; }
                else { uu = bx + k * G; if (uu >= nU0) break; }
                const bf16_t *Qu, *Kh, *Vh; bf16_t* Ou; int NT; float sk = -INFINITY;
                if (uu < 512) {
                    const int xs = uu >> 6, b = xs >> 1, kvh = xs & 1, h = 4 * kvh + ((uu >> 4) & 3), qb = uu & 15;
                    const size_t rb = (size_t)b * TPB, rq = rb + 256 + 256 * qb;
                    Qu = P + rq * PC + 64 * h; Kh = P + rb * PC + 512 + 64 * kvh; Vh = P + rb * PC + 640 + 64 * kvh; Ou = Y3 + rq * 1536 + 64 * h; NT = 68;
                } else {
                    const int v = uu - 512, type = v >> 5, b = (v >> 3) & 3, h = v & 7, kvh = h >> 2; const size_t rb = (size_t)b * TPB;
                    if (type) sk = snk[h] * LOG2E;
                    Qu = P + rb * PC + (type ? 2304 : 0) + 64 * h; Kh = P + rb * PC + (type ? 2816 : 512) + 64 * kvh; Vh = P + rb * PC + (type ? 2944 : 640) + 64 * kvh; Ou = Y3 + rb * 1536 + (type ? 1024 : 0) + 64 * h; NT = 4;
                }
                attn_body::attn_unit<8, 0>(Qu, Kh, Vh, Ou, NT, 0, 0, sk, (char*)lds_raw, fresh_tid(wave_s));
            }
        }
#endif
#ifndef SKIP_AT1
        {
            unsigned char* ws = KWS(); const bf16_t* P = WSP(bf16_t, WS_P); bf16_t* Y3 = WSP(bf16_t, WS_Y3); const float* snk = KIN(I_sink_c) + l * 8;
#pragma unroll 1
            for (int k = 0;; ++k) {
                int uu;
                if (G == 256) { if (k < 2) uu = (vcu >> 5) * 64 + (vcu & 31) * 2 + k; else break; }
                else { uu = bx + k * G; if (uu >= 512) break; }
                const int xs = uu >> 6, b = xs >> 1, kvh = xs & 1, h = 4 * kvh + ((uu >> 4) & 3), qb = uu & 15;
                const size_t rb = (size_t)b * TPB, rq = rb + 256 + 256 * qb;
                const int q0 = 256 * qb, kstart = q0 >= 128 ? q0 - 128 : 0, kend = q0 + 384 <= SEQ ? q0 + 384 : SEQ;
                attn_body::attn_unit<8, 1>(P + rq * PC + 2304 + 64 * h, P + rb * PC + 2816 + 64 * kvh, P + rb * PC + 2944 + 64 * kvh, Y3 + rq * 1536 + 1024 + 64 * h, 4 + (kend - kstart) / 64, kstart, q0 - kstart, snk[h] * LOG2E, (char*)lds_raw, fresh_tid(wave_s));
            }
        }
#endif
        GRID_BAR();
#ifndef SKIP_M1
        {
            unsigned char* ws = KWS();
            SchedBranch S{(const char*)WSP(bf16_t, WS_Y3), (const char*)(WSP(bf16_t, WS_WBR) + (size_t)l * 3 * D * 512), need_ctx ? NMT : 64, G, bx, !need_ctx};
            pg8::EpiBranch E{WSP(bf16_t, WS_G), WSP(bf16_t, WS_MB)};
            pg8::gemm_phase<pg8::EpiBranch, SchedBranch, true>(lds, fresh_tid(wave_s), 512, 1536, 512, S, E);
        }
#endif
        GRID_BAR();
#ifndef SKIP_M2
        {
            unsigned char* ws = KWS();
            SchedPlain S{(const char*)WSP(bf16_t, WS_MB), (const char*)(WSP(bf16_t, WS_WOUT) + (size_t)l * D * D), (size_t)256 * D * 2, (size_t)256 * D * 2, need_ctx ? NMT : 64, 4, G, bx, !need_ctx};
            pg8::EpiResid E{WSP(float, WS_XS), WSP(float, WS_MODS) + (size_t)l * 5 * INC + 2 * D};
            pg8::gemm_phase<pg8::EpiResid, SchedPlain, true>(lds, fresh_tid(wave_s), D, D, D, S, E);
        }
#endif
        GRID_BAR();
#ifndef SKIP_N2
        {
            PHASE_IDS(); unsigned char* ws = KWS(); const float* XS = WSP(float, WS_XS); bf16_t* HN = WSP(bf16_t, WS_HN); const float* modl = WSP(float, WS_MODS) + (size_t)l * 5 * INC;
            const float* g2 = KIN(I_norm2_g) + (size_t)l * D;
            const int nrows = need_ctx ? M : NB * SEQ;
            for (int rr = gw; rr < nrows; rr += NGW) {
                const int row = need_ctx ? rr : (rr / SEQ) * TPB + CTXL + (rr % SEQ);
                const int b = row / TPB, tq = row - b * TPB, who = tq < CTXL ? 4 : b;
                NormArgs A{}; A.g = g2; A.shift = modl + (size_t)who * INC + 3 * D; A.scale = modl + (size_t)who * INC + 4 * D;
                if (moe) { A.rw = KIN(I_router_w) + (size_t)jf * D * NEXP; A.rb = KIN(I_router_b) + jf * NEXP; A.cnt = WSP(unsigned, WS_CTL) + CW_CNT + 1024 * jf;
                    A.PE = (int*)(ws + WS_META + MT_PE); A.PPOS = (int*)(ws + WS_META + MT_PPOS); A.PW = (float*)(ws + WS_META + MT_PW); }
                norm_row(XS + (size_t)row * D, nullptr, HN + (size_t)row * D, row, A, lane);
            }
        }
#endif
        GRID_BAR();
        if (!moe) {
#ifndef SKIP_F1
            {
                unsigned char* ws = KWS();
                SchedPlain S{(const char*)WSP(bf16_t, WS_HN), (const char*)(WSP(bf16_t, WS_W13) + (size_t)jf * 2 * DFF * D), (size_t)256 * D * 2, (size_t)256 * D * 2, need_ctx ? NMT : 64, 2 * DFF / 256, G, bx, !need_ctx};
                pg8::EpiSwiGLU E{WSP(bf16_t, WS_H), DFF};
                pg8::gemm_phase<pg8::EpiSwiGLU, SchedPlain, true>(lds, fresh_tid(wave_s), D, D, D, S, E);
            }
#endif
            GRID_BAR();
#ifndef SKIP_F2
            {
                unsigned char* ws = KWS();
                SchedPlain S{(const char*)WSP(bf16_t, WS_H), (const char*)(WSP(bf16_t, WS_W2) + (size_t)jf * D * DFF), (size_t)256 * DFF * 2, (size_t)256 * DFF * 2, need_ctx ? NMT : 64, 4, G, bx, !need_ctx};
                pg8::EpiResid E{WSP(float, WS_XS), WSP(float, WS_MODS) + (size_t)l * 5 * INC + 5 * D};
                pg8::gemm_phase<pg8::EpiResid, SchedPlain, true>(lds, fresh_tid(wave_s), DFF, DFF, DFF, S, E);
            }
#endif
            GRID_BAR();
        } else {
#ifndef SKIP_GA
            {
                PHASE_IDS(); unsigned char* ws = KWS(); const bf16_t* HN = WSP(bf16_t, WS_HN); bf16_t* HS = WSP(bf16_t, WS_R2);
                const int* PE = (const int*)(ws + WS_META + MT_PE); const int* PPOS = (const int*)(ws + WS_META + MT_PPOS); const float* PW = (const float*)(ws + WS_META + MT_PW);
                int* DST = (int*)(ws + WS_META + MT_DST); float* CW = (float*)(ws + WS_META + MT_CW);
                int ts[9]; ts[0] = 0;
#pragma unroll
                for (int e = 0; e < 8; ++e) { const unsigned c = __hip_atomic_load(WSP(unsigned, WS_CTL) + CW_CNT + 1024 * jf + 64 * e, RLX_AGENT); ts[e + 1] = ts[e] + (int)((c + 255u) >> 8); }
                const int nrows = need_ctx ? M : NB * SEQ;
                for (int rr = gw; rr < nrows; rr += NGW) {
                    const int row = need_ctx ? rr : (rr / SEQ) * TPB + CTXL + (rr % SEQ);
                    const u32x4 h0 = *(const u32x4*)(HN + (size_t)row * D + 8 * lane), h1 = *(const u32x4*)(HN + (size_t)row * D + 512 + 8 * lane);
#pragma unroll
                    for (int s = 0; s < 2; ++s) { const int e = PE[2 * row + s], pos = PPOS[2 * row + s];
                        int t0 = 0;
#pragma unroll
                        for (int k = 1; k < 8; ++k) t0 = (e == k) ? ts[k] : t0;
                        const int d = 256 * t0 + pos;
                        *(u32x4*)(HS + (size_t)d * D + 8 * lane) = h0; *(u32x4*)(HS + (size_t)d * D + 512 + 8 * lane) = h1;
                        if (lane == 0) { CW[d] = PW[2 * row + s]; DST[2 * row + s] = d; } }
                }
            }
#endif
            GRID_BAR();
#ifndef SKIP_E1
            {
                unsigned char* ws = KWS();
                int ts[9]; ts[0] = 0;
#pragma unroll
                for (int e = 0; e < 8; ++e) { const unsigned c = __hip_atomic_load(WSP(unsigned, WS_CTL) + CW_CNT + 1024 * jf + 64 * e, RLX_AGENT); ts[e + 1] = ts[e] + (int)((c + 255u) >> 8); }
                SchedMoE S{(const char*)WSP(bf16_t, WS_R2), (const char*)(WSP(bf16_t, WS_E13) + (size_t)jf * 8 * 2 * DFE * D), (size_t)256 * D * 2, (size_t)256 * D * 2, (size_t)2 * DFE * D * 2, ts[8], 2 * DFE / 256, G, bx, ts[1], ts[2], ts[3], ts[4], ts[5], ts[6], ts[7]};
                pg8::EpiSwiGLU E{WSP(bf16_t, WS_H), DFE};
                pg8::gemm_phase<pg8::EpiSwiGLU, SchedMoE, true>(lds, fresh_tid(wave_s), D, D, D, S, E);
            }
#endif
            GRID_BAR();
#ifndef SKIP_E2
            {
                unsigned char* ws = KWS();
                int ts[9]; ts[0] = 0;
#pragma unroll
                for (int e = 0; e < 8; ++e) { const unsigned c = __hip_atomic_load(WSP(unsigned, WS_CTL) + CW_CNT + 1024 * jf + 64 * e, RLX_AGENT); ts[e + 1] = ts[e] + (int)((c + 255u) >> 8); }
                SchedMoE S{(const char*)WSP(bf16_t, WS_H), (const char*)(WSP(bf16_t, WS_E2) + (size_t)jf * 8 * D * DFE), (size_t)256 * DFE * 2, (size_t)256 * DFE * 2, (size_t)D * DFE * 2, ts[8], 4, G, bx, ts[1], ts[2], ts[3], ts[4], ts[5], ts[6], ts[7]};
                pg8::EpiMoEDown E{WSP(bf16_t, WS_R2), (const float*)(ws + WS_META + MT_CW)};
                pg8::gemm_phase<pg8::EpiMoEDown, SchedMoE, true>(lds, fresh_tid(wave_s), DFE, DFE, DFE, S, E);
            }
#endif
            GRID_BAR();
        }
    }
    {
        PHASE_IDS(); unsigned char* ws = KWS(); const float* XS = WSP(float, WS_XS); const float* MODS = WSP(float, WS_MODS); const bf16_t* YY = WSP(bf16_t, WS_R2); const int* DST = (const int*)(ws + WS_META + MT_DST);
        const float* fgp = KIN(I_final_g); float* outp = KOUT();
        const unsigned tmo = __hip_atomic_load(WSP(unsigned, WS_CTL) + CW_BAR + XB_TMO, RLX_AGENT);
        for (int rr = gw; rr < NB * SEQ; rr += NGW) {
            const int b = rr / SEQ, row = b * TPB + CTXL + (rr % SEQ);
            const float* src = XS + (size_t)row * D; const float* gt = MODS + ((size_t)3 * 5 + b) * INC + 5 * D;
            const int d0 = DST[2 * row], d1 = DST[2 * row + 1];
            f32x4 v[4]; float ss = 0.f;
#pragma unroll
            for (int j = 0; j < 4; ++j) { const int c = 4 * lane + 256 * j; v[j] = *(const f32x4*)(src + c);
                const u32x2 y0 = *(const u32x2*)(YY + (size_t)d0 * D + c), y1 = *(const u32x2*)(YY + (size_t)d1 * D + c); const f32x4 g4 = *(const f32x4*)(gt + c);
                v[j][0] += g4[0] * (bflo(y0.x) + bflo(y1.x)); v[j][1] += g4[1] * (bfhi(y0.x) + bfhi(y1.x)); v[j][2] += g4[2] * (bflo(y0.y) + bflo(y1.y)); v[j][3] += g4[3] * (bfhi(y0.y) + bfhi(y1.y));
                ss += (v[j][0] * v[j][0] + v[j][1] * v[j][1]) + (v[j][2] * v[j][2] + v[j][3] * v[j][3]); }
            float rs = rsqrtf(wave_sum(ss) * (1.0f / D) + EPS);
            if (tmo) rs = __builtin_nanf("");
#pragma unroll
            for (int j = 0; j < 4; ++j) { const int c = 4 * lane + 256 * j; const f32x4 fg = *(const f32x4*)(fgp + c); *(f32x4*)(outp + (size_t)rr * D + c) = v[j] * rs * fg; }
        }
    }
#undef GRID_BAR
}

extern "C" void kernel_launch(void* const* d_in, const int* in_sizes, int n_in, void* d_out, int out_size, void* d_ws, size_t ws_size, hipStream_t stream) {
    static int grid = 0;
    if (grid == 0) {
        if (n_in != 28 || out_size != NB * SEQ * D || ws_size < WS_END) { fprintf(stderr, "kernel_launch: unexpected shapes: n_in %d out %d ws %zu (need %zu)\n", n_in, out_size, ws_size, (size_t)WS_END); grid = -1; return; }
        int dev = 0, cus = 0, per_cu = 0;
        if (hipGetDevice(&dev) != hipSuccess || hipDeviceGetAttribute(&cus, hipDeviceAttributeMultiprocessorCount, dev) != hipSuccess) { grid = -1; return; }
        if (hipFuncSetAttribute((const void*)fwd_kernel, hipFuncAttributeMaxDynamicSharedMemorySize, LDS_BYTES) != hipSuccess) { fprintf(stderr, "kernel_launch: hipFuncSetAttribute failed\n"); grid = -1; return; }
        if (hipOccupancyMaxActiveBlocksPerMultiprocessor(&per_cu, (const void*)fwd_kernel, NTHR, LDS_BYTES) != hipSuccess || per_cu < 1) fprintf(stderr, "kernel_launch: occupancy query reports %d\n", per_cu);
        (void)hipGetLastError();
        grid = cus;
    }
    if (grid < 0) return;
    if (hipMemsetAsync((char*)d_ws + WS_CTL, 0, CTL_ZERO_BYTES, stream) != hipSuccess) return;
    Args a{};
    const float** pp = (const float**)&a.in;
    for (int i = 0; i < 28; ++i) pp[i] = (const float*)d_in[i];
    a.out = (float*)d_out; a.ws = (unsigned char*)d_ws;
    hipLaunchKernelGGL(fwd_kernel, dim3(grid), dim3(NTHR), LDS_BYTES, stream, a);
}
```

```cpp
#include <hip/hip_runtime.h>
#include <cstdio>
#include <cstdint>
#include <cmath>

constexpr int NB = 4, SEQ = 4096, CTXL = 256, TPB = SEQ + CTXL, M = NB * TPB, D = 1024, DEPTH = 4;
constexpr int INC = 6144, PC = 3072, DFF = 2816, DFE = 3584, NEXP = 8;
constexpr int NMT = M / 256;
constexpr int MOE_ROWS = 2 * M + NEXP * 256;
constexpr float EPS = 1e-6f;
constexpr float LOG2E = 1.4426950408889634f;
constexpr float C2 = 0.125f * LOG2E;

constexpr size_t MiB = 1u << 20;
constexpr size_t WS_CTL = 0, CTL_ZERO_BYTES = 1 * MiB;
constexpr size_t WS_MODS = 1 * MiB;
constexpr size_t WS_ROPE = WS_MODS + 512 * 1024;
constexpr size_t WS_RETC = WS_ROPE + 16 * 1024;
constexpr size_t WS_META = 2 * MiB;
constexpr size_t WS_WIN = 3 * MiB;
constexpr size_t WS_WBR = WS_WIN + 48 * MiB;
constexpr size_t WS_WOUT = WS_WBR + 12 * MiB;
constexpr size_t WS_W13 = WS_WOUT + 8 * MiB;
constexpr size_t WS_W2 = WS_W13 + 22 * MiB;
constexpr size_t WS_E13 = WS_W2 + 11 * MiB;
constexpr size_t WS_E2 = WS_E13 + 224 * MiB;
constexpr size_t WS_XS = WS_E2 + 112 * MiB;
constexpr size_t WS_HN = WS_XS + 68 * MiB;
constexpr size_t WS_P = WS_HN + 34 * MiB;
constexpr size_t WS_G = WS_P + 102 * MiB;
constexpr size_t WS_Y3 = WS_G + 102 * MiB;
constexpr size_t WS_R2 = WS_Y3 + 51 * MiB;
constexpr size_t WS_MB = WS_R2, WS_KVS = WS_R2 + 34 * MiB;
constexpr size_t WS_KVB = WS_HN;
constexpr size_t WS_HN8 = WS_Y3;
#ifndef G1M0
#define G1M0 0xFFF000u
#define G1M1 0xFFF000u
#define G1M2 0xFFFFFFu
#define G1M3 0xFFFFFFu
#endif
__device__ __forceinline__ unsigned g1_mask(int l) { return (l == 0 ? G1M0 : l == 1 ? G1M1 : l == 2 ? G1M2 : G1M3) | 0xFFF000u; }
__device__ __forceinline__ int nth_bit(unsigned m, int j) { for (int t = 0; t < j; ++t) m &= m - 1u; return __builtin_ctz(m); }
constexpr size_t WG8_OFF = (size_t)3072 * D * 2;
constexpr size_t WS_PART = WS_R2 + 72 * MiB;
constexpr size_t WS_END = WS_PART + 64 * MiB;
constexpr size_t WS_H = WS_P;
static_assert((size_t)MOE_ROWS * DFE * 2 <= WS_R2 - WS_P, "HM overlay");
static_assert((size_t)MOE_ROWS * D * 2 <= 72 * MiB, "HS overlay");
constexpr size_t MT_PE = 0, MT_PPOS = MT_PE + (size_t)M * 8, MT_PW = MT_PPOS + (size_t)M * 8, MT_DST = MT_PW + (size_t)M * 8, MT_CW = MT_DST + (size_t)M * 8, MT_BC = MT_CW + (size_t)MOE_ROWS * 4, MT_END = MT_BC + 256 * 8 * 4;
static_assert(MT_END <= 1 * MiB, "meta");
constexpr int CW_TMO = 0, CW_CODE = 1, CW_BAR = 4096, CW_CNT = 8192, CW_FLG = 65536, CW_PAN = 200000;

constexpr int RING_BYTES = 131072, LDSCTL_OFF = RING_BYTES, MISC_OFF = LDSCTL_OFF + 320, LDS_BYTES = 147456;
constexpr int NWAVES = 8, NTHR = 512;

#define GAS __attribute__((address_space(1)))
#define LAS __attribute__((address_space(3)))
typedef unsigned short bf16_t;
typedef unsigned u32x4 __attribute__((ext_vector_type(4)));
typedef unsigned u32x2 __attribute__((ext_vector_type(2)));
typedef float f32x4 __attribute__((ext_vector_type(4)));
typedef float f32x2 __attribute__((ext_vector_type(2)));
typedef float f32x16 __attribute__((ext_vector_type(16)));
typedef short bf16x8 __attribute__((ext_vector_type(8)));
typedef short s16x4 __attribute__((ext_vector_type(4)));
#define RLX_AGENT __ATOMIC_RELAXED, __HIP_MEMORY_SCOPE_AGENT
#define LDS_WAIT() asm volatile("s_waitcnt lgkmcnt(0)" ::: "memory")
#define VM_WAIT() asm volatile("s_waitcnt vmcnt(0)" ::: "memory")
typedef float f32x2v_t __attribute__((ext_vector_type(2))); typedef __bf16 bf16x2v_t __attribute__((ext_vector_type(2)));
__device__ __forceinline__ unsigned pk2(float lo, float hi) { const f32x2v_t v = {lo, hi}; return __builtin_bit_cast(unsigned, __builtin_convertvector(v, bf16x2v_t)); }
__device__ __forceinline__ unsigned f2bf(float f) { return pk2(f, f) & 0xffffu; }
__device__ __forceinline__ float bflo(unsigned w) { return __builtin_bit_cast(float, w << 16); }
__device__ __forceinline__ float bfhi(unsigned w) { return __builtin_bit_cast(float, w & 0xffff0000u); }
typedef int i32x8 __attribute__((ext_vector_type(8)));
typedef int i32x4 __attribute__((ext_vector_type(4)));
__device__ __forceinline__ unsigned pk4_fp8(float a, float b, float c, float d) { int p = __builtin_amdgcn_cvt_pk_fp8_f32(a, b, 0, false); p = __builtin_amdgcn_cvt_pk_fp8_f32(c, d, p, true); return (unsigned)p; }
constexpr float FP8_SC_X = 4.0f, FP8_SC_H = 2.0f, FP8_SC_W13 = 32.0f, FP8_SC_W2 = 64.0f, FP8_SC_WG = 32.0f;
__device__ __forceinline__ float sigmoidf_(float x) { return __builtin_amdgcn_rcpf(1.0f + __builtin_amdgcn_exp2f(x * -LOG2E)); }
__device__ __forceinline__ float siluf_(float x) { return x * sigmoidf_(x); }
__device__ __forceinline__ int fresh_lane() { int l; asm volatile("v_mbcnt_lo_u32_b32 %0, -1, 0\n\tv_mbcnt_hi_u32_b32 %0, -1, %0" : "=v"(l)); return l; }
__device__ __forceinline__ int fresh_tid(int wave_s) { int l; asm volatile("v_mbcnt_lo_u32_b32 %0, -1, 0\n\tv_mbcnt_hi_u32_b32 %0, -1, %0" : "=v"(l)); return wave_s * 64 + l; }
template <int MSK> __device__ __forceinline__ float swz_xor(float v) { return __builtin_bit_cast(float, __builtin_amdgcn_ds_swizzle(__builtin_bit_cast(int, v), (MSK << 10) | 0x1f)); }
__device__ __forceinline__ float xor32_sum(float v) { const unsigned u = __builtin_bit_cast(unsigned, v); auto rr = __builtin_amdgcn_permlane32_swap(u, u, false, false); return __builtin_bit_cast(float, (unsigned)rr[0]) + __builtin_bit_cast(float, (unsigned)rr[1]); }
template <int CTRL> __device__ __forceinline__ float dpp_f(float v) { return __builtin_bit_cast(float, __builtin_amdgcn_update_dpp(0, __builtin_bit_cast(int, v), CTRL, 0xf, 0xf, true)); }
__device__ __forceinline__ float half_sum(float v) { v += dpp_f<0xB1>(v); v += dpp_f<0x4E>(v); v += dpp_f<0x141>(v); v += dpp_f<0x140>(v); v += swz_xor<16>(v); return v; }
__device__ __forceinline__ float wave_sum(float v) { return xor32_sum(half_sum(v)); }

typedef const __attribute__((address_space(4))) unsigned char* kargp_t;
__device__ __forceinline__ kargp_t kfresh() { kargp_t p = (kargp_t)__builtin_amdgcn_kernarg_segment_ptr(); asm volatile("" : "+s"(p)); return p; }
#define KIN(idx) (((const float* const __attribute__((address_space(4)))*)kfresh())[idx])
#define KOUT() (((float* const __attribute__((address_space(4)))*)kfresh())[28])
#define KWS() (((unsigned char* const __attribute__((address_space(4)))*)kfresh())[29])
enum { I_x, I_c, I_ctx, I_c_ctx, I_w_ada, I_b_ada, I_norm1_g, I_norm2_g, I_final_g, I_w_in, I_b_gate, I_qn_a, I_kn_a, I_ret_a, I_ret_g, I_sink_c, I_w_br_a, I_w_br_b, I_w_br_c, I_w_out, I_ffn_w1, I_ffn_w3, I_ffn_w2, I_router_w, I_router_b, I_exp_w1, I_exp_w3, I_exp_w2 };
#define WSP(T, off) ((T*)(ws + (off)))

#define XB_TMO      128
#define XB_XCNT(j)  (256  + 64 * (j))
#define XB_XSUB(j)  (1280 + 64 * (j))
#define XB_XGEN(j)  (2304 + 64 * (j))
#define XB_TOP      3328
#define XB_TOPGEN   3392
#define XCD_BAR_WORDS 3456
#define XB_SPIN_CAP (1u << 20)
__device__ __forceinline__ unsigned xb_ld(unsigned* p)              { return __hip_atomic_load(p, __ATOMIC_RELAXED, __HIP_MEMORY_SCOPE_AGENT); }
__device__ __forceinline__ unsigned xb_add(unsigned* p, unsigned v) { return __hip_atomic_fetch_add(p, v, __ATOMIC_RELAXED, __HIP_MEMORY_SCOPE_AGENT); }
__device__ __forceinline__ unsigned xb_xcc_id() { return (unsigned)__builtin_amdgcn_s_getreg((3 << 11) | 20) & 0xFu; }
#define XB_SPIN(cond, bar) do { unsigned _sp = 0; while (cond) { __builtin_amdgcn_s_sleep(1); \
    if ((++_sp & 255u) == 0u) { if (xb_ld(&(bar)[XB_TMO])) break; if (_sp > XB_SPIN_CAP) { atomicAdd(&(bar)[XB_TMO], 1u); break; } } } } while (0)
struct XcdBarrier { unsigned* bar; unsigned x; volatile LAS unsigned* st; };
__device__ __forceinline__ XcdBarrier xcd_barrier_post(unsigned* bar, volatile LAS unsigned* st) {
    XcdBarrier b; b.bar = bar; b.x = xb_xcc_id(); b.st = st;
    if (threadIdx.x == 0) (void)xb_add(&bar[XB_XCNT(b.x)], 1u);
    return b;
}
__device__ __forceinline__ void xcd_barrier_complete(unsigned* bar, unsigned x, unsigned& nloc, unsigned& nx) {
    const unsigned G = gridDim.x * gridDim.y * gridDim.z;
    unsigned sum, cnt, mine, sp = 0u;
    for (;;) {
        sum = 0u; cnt = 0u; mine = 0u;
#pragma unroll
        for (unsigned j = 0; j < 16; ++j) { const unsigned c = xb_ld(&bar[XB_XCNT(j)]); sum += c; cnt += (c > 0u) ? 1u : 0u; mine = (j == x) ? c : mine; }
        if (sum == G) break;
        __builtin_amdgcn_s_sleep(1);
        if ((++sp & 255u) == 0u) { if (xb_ld(&bar[XB_TMO])) break; if (sp > XB_SPIN_CAP) { atomicAdd(&bar[XB_TMO], 1u); break; } }
    }
    nloc = mine > 0u ? mine : 1u; nx = cnt > 0u ? cnt : 1u;
}
__device__ __forceinline__ void xcd_barrier(const XcdBarrier& b) {
    asm volatile("s_waitcnt vmcnt(0)" ::: "memory");
    __syncthreads();
    if (threadIdx.x == 0) {
        unsigned* bar = b.bar;
        __builtin_amdgcn_s_waitcnt(0);
        unsigned nloc = b.st[0], nx = b.st[1];
        if (nloc == 0u) { xcd_barrier_complete(bar, b.x, nloc, nx); b.st[0] = nloc; b.st[1] = nx; }
        const unsigned old = xb_add(&bar[XB_XSUB(b.x)], 1u);
        const unsigned gen = old / nloc;
        if (old + 1u == (gen + 1u) * nloc) {
            __builtin_amdgcn_fence(__ATOMIC_RELEASE, "agent");
            asm volatile("s_waitcnt vmcnt(0)" ::: "memory");
            const unsigned og = xb_add(&bar[XB_TOP], 1u);
            const unsigned tg = og / nx;
            if (og + 1u == (tg + 1u) * nx) xb_add(&bar[XB_TOPGEN], 1u);
            else XB_SPIN(xb_ld(&bar[XB_TOPGEN]) == tg, bar);
            __builtin_amdgcn_fence(__ATOMIC_ACQUIRE, "agent");
            xb_add(&bar[XB_XGEN(b.x)], 1u);
            asm volatile("s_waitcnt vmcnt(0)" ::: "memory");
        } else {
            XB_SPIN(xb_ld(&bar[XB_XGEN(b.x)]) == gen, bar);
            __builtin_amdgcn_fence(__ATOMIC_ACQUIRE, "agent");
            asm volatile("s_waitcnt vmcnt(0)" ::: "memory");
        }
    }
    __syncthreads();
}
namespace pg8 {
constexpr int BM = 256, BK = 64, HALF = 128, HTB = HALF * BK * 2, STAGE_BYTES = 8 * HTB;
__device__ __forceinline__ int lds_byte(int r, int c) { const int st = (r >> 4) * 2 + (c >> 5), rr = r & 15, cc = c & 31, ob = rr * 64 + cc * 2; return st * 1024 + (ob ^ (((ob >> 9) & 1) << 5)); }
__device__ __forceinline__ void stage_rc(int b, int& R, int& C) { const int st = b / 1024, sb = b % 1024, swz = sb ^ (((sb >> 9) & 1) << 5); R = (st >> 1) * 16 + swz / 64; C = (st & 1) * 32 + (swz % 64) / 2; }
__device__ __forceinline__ int perm32(int rho) { const int n = rho >> 4, i = rho & 15; return 8 * (i >> 2) + 4 * n + (i & 3); }

struct Unit { int pm, pn, aux, ntk, mode, peer, kt0, kind, lda, ldb; const char* A; const char* B; };
struct SKCtx { unsigned char* part; unsigned* flags; unsigned* tmo; int self; };
constexpr unsigned SK_SLOT = 262144u, SK_SPIN_CAP = 1u << 20;
#ifndef SKB
#define SKB 16
#endif
__device__ __forceinline__ void sk_store_partial(const f32x4 (&acc)[2][2][4][2], const SKCtx& X, int wid) {
    const int tid = wid * 64 + fresh_lane();
    const __amdgpu_buffer_rsrc_t rs = __builtin_amdgcn_make_buffer_rsrc(X.part + (size_t)X.self * SK_SLOT, 0, SK_SLOT, 0x00020000);
#pragma unroll
    for (int r = 0; r < 32; ++r) __builtin_amdgcn_raw_buffer_store_b128(__builtin_bit_cast(u32x4, acc[r >> 4][(r >> 3) & 1][(r >> 1) & 3][r & 1]), rs, (unsigned)((r * 512 + tid) * 16), 0, 16);
    asm volatile("s_waitcnt vmcnt(0)" ::: "memory");
    if ((tid & 63) == 0) __hip_atomic_fetch_add(X.flags + 32 * X.self, 1u, __ATOMIC_RELAXED, __HIP_MEMORY_SCOPE_AGENT);
}
__device__ __forceinline__ void sk_add_partial(f32x4 (&acc)[2][2][4][2], const SKCtx& X, int peer, int wid) {
    const int tid = wid * 64 + fresh_lane();
    unsigned spins = 0;
    while ((unsigned)__builtin_amdgcn_readfirstlane(__hip_atomic_load(X.flags + 32 * peer, __ATOMIC_RELAXED, __HIP_MEMORY_SCOPE_AGENT)) < 8u) {
        __builtin_amdgcn_s_sleep(1);
        if (++spins > SK_SPIN_CAP) { if ((tid & 63) == 0) __hip_atomic_store(X.tmo, 1u, __ATOMIC_RELAXED, __HIP_MEMORY_SCOPE_AGENT); break; } }
    __builtin_amdgcn_fence(__ATOMIC_ACQUIRE, "agent");
    asm volatile("s_waitcnt vmcnt(0)" ::: "memory");
    const int t2 = tid;
    const f32x4* p = (const f32x4*)(X.part + (size_t)peer * SK_SLOT) + t2;
#pragma unroll
    for (int r0 = 0; r0 < 32; r0 += SKB) {
        f32x4 v[SKB];
#pragma unroll
        for (int k = 0; k < SKB; ++k) asm volatile("global_load_dwordx4 %0, %1, off sc1" : "=v"(v[k]) : "v"(p + (r0 + k) * 512) : "memory");
        asm volatile("s_waitcnt vmcnt(0)" ::: "memory");
#pragma unroll
        for (int k = 0; k < SKB; ++k) asm volatile("" : "+v"(v[k]));
#pragma unroll
        for (int k = 0; k < SKB; ++k) { const int r = r0 + k; acc[r >> 4][(r >> 3) & 1][(r >> 1) & 3][r & 1] += v[k]; }
    }
}

__device__ __forceinline__ bool tile_of(long L, int nM, int nN, int& pm, int& pn) {
    const int nwg = nM * nN; if (L >= nwg) return false;
    int wgid = (int)L; { const int q = nwg / 8, r = nwg % 8, xcd = wgid % 8, off = wgid / 8; wgid = (xcd < r ? xcd * (q + 1) : r * (q + 1) + (xcd - r) * q) + off; }
    const int nig = 8 * nN, gid = wgid / nig, fm = gid * 8, gsz = (nM - fm) < 8 ? (nM - fm) : 8;
    pm = fm + ((wgid % nig) % gsz); pn = (wgid % nig) / gsz; return true;
}
__device__ __forceinline__ unsigned cvt_pk_bf16(float lo, float hi) { return pk2(lo, hi); }

template <class Epi, class Sched, bool ALIGN_EPI, bool FP8 = false>
__device__ __forceinline__ void gemm_phase(LAS unsigned char* lds, const int tid, const Sched& S, const Epi& E, const SKCtx X = SKCtx{nullptr, nullptr, nullptr, 0}) {
    const int wid = __builtin_amdgcn_readfirstlane(tid >> 6), lane = tid & 63, wr = wid >> 2, wc = wid & 3, fr = lane & 15, fq = lane >> 4;
    unsigned RA2[2], RB2[2], C2[2];
#pragma unroll
    for (int i = 0; i < 2; ++i) { int R, C; stage_rc(tid * 16 + i * 8192, R, C); const int Rb = Epi::PERM ? ((R & ~31) + perm32(R & 31)) : R;
        RA2[i] = (unsigned)R * 2u; RB2[i] = (unsigned)Rb * 2u; C2[i] = (unsigned)C * 2u; }
    const size_t kstep = (size_t)(BK * 2);
    const unsigned ldsw = (unsigned)wid * 1024u;
    const int aoff = lds_byte(wr * 64 + fr, fq * 8), boff = lds_byte(wc * 32 + fr, fq * 8);
#define PG8_SA(b, h) (((b) * 2 + (h)) * HTB)
#define PG8_SB(b, h) ((4 + (b) * 2 + (h)) * HTB)
#define PG8_STAGE(bufoff, gbase, R2, ld) do { _Pragma("unroll") for (int _i = 0; _i < 2; ++_i) \
        __builtin_amdgcn_global_load_lds((const unsigned*)((const char*)(gbase) + ((R2)[_i] * (unsigned)(ld) + C2[_i])), (LAS unsigned*)(lds + (bufoff) + ldsw + _i * 8192), 16, 0, 0); } while (0)
#define PG8_HS(ld) ((size_t)HALF * (size_t)(ld) * 2)
#define PG8_STAGE_A(bufoff, gbase, ld, kd) do { if ((kd) == 1) { _Pragma("unroll") for (int _i = 0; _i < 2; ++_i) \
        __builtin_amdgcn_global_load_lds((const unsigned*)((const char*)(gbase) + (RA2[_i] * (unsigned)(ld) + C2[_i])), (LAS unsigned*)(lds + (bufoff) + ldsw + _i * 8192), 16, 0, 16); } \
    else { PG8_STAGE(bufoff, gbase, RA2, ld); } } while (0)
#define PG8_LDA(dst, b, h) do { if constexpr (FP8) { _Pragma("unroll") for (int m = 0; m < 4; ++m) dst##8[m] = __builtin_shufflevector(*(const LAS i32x4*)(lds + PG8_SA(b, h) + aoff + m * 2048), *(const LAS i32x4*)(lds + PG8_SA(b, h) + aoff + m * 2048 + 1024), 0, 1, 2, 3, 4, 5, 6, 7); } \
    else { _Pragma("unroll") for (int m = 0; m < 4; ++m) _Pragma("unroll") for (int k = 0; k < 2; ++k) dst[m][k] = *(const LAS bf16x8*)(lds + PG8_SA(b, h) + aoff + m * 2048 + k * 1024); } } while (0)
#define PG8_LDB(dst, b, h) do { if constexpr (FP8) { _Pragma("unroll") for (int n = 0; n < 2; ++n) dst##8[n] = __builtin_shufflevector(*(const LAS i32x4*)(lds + PG8_SB(b, h) + boff + n * 2048), *(const LAS i32x4*)(lds + PG8_SB(b, h) + boff + n * 2048 + 1024), 0, 1, 2, 3, 4, 5, 6, 7); } \
    else { _Pragma("unroll") for (int n = 0; n < 2; ++n) _Pragma("unroll") for (int k = 0; k < 2; ++k) dst[n][k] = *(const LAS bf16x8*)(lds + PG8_SB(b, h) + boff + n * 2048 + k * 1024); } } while (0)
#define PG8_MMA(ai, bj, At, Bt) do { __builtin_amdgcn_s_setprio(1); _Pragma("unroll") for (int m = 0; m < 4; ++m) _Pragma("unroll") for (int n = 0; n < 2; ++n) { \
        if constexpr (FP8) asm volatile("v_mfma_scale_f32_16x16x128_f8f6f4 %0, %1, %2, %0, %3, %3 op_sel_hi:[0,0,0]" : "+v"(acc[ai][bj][m][n]) : "v"(Bt##8[n]), "v"(At##8[m]), "v"(one8));   \
        else { _Pragma("unroll") for (int k = 0; k < 2; ++k) acc[ai][bj][m][n] = __builtin_amdgcn_mfma_f32_16x16x32_bf16(Bt[n][k], At[m][k], acc[ai][bj][m][n], 0, 0, 0); } } \
        __builtin_amdgcn_s_setprio(0); } while (0)
#define PG8_WAIT_V(n) asm volatile("s_waitcnt vmcnt(" #n ")" ::: "memory")
#define PG8_WAIT_L(n) asm volatile("s_waitcnt lgkmcnt(" #n ")" ::: "memory")
#define PG8_BAR __builtin_amdgcn_s_barrier()
#define PG8_SCHED __builtin_amdgcn_sched_barrier(0)
    Unit cur, nxt; int ui = 0;
    if (!S.next(0, cur)) return;
    f32x4 acc[2][2][4][2];
#pragma unroll
    for (int a = 0; a < 2; ++a)
#pragma unroll
        for (int b = 0; b < 2; ++b)
#pragma unroll
            for (int m = 0; m < 4; ++m)
#pragma unroll
                for (int n = 0; n < 2; ++n) acc[a][b][m][n] = (f32x4){0.f, 0.f, 0.f, 0.f};
    const int one8 = 0x7f7f7f7f;
    bf16x8 At[4][2], B0[2][2], B1[2][2]; i32x8 At8[4], B08[2], B18[2];
    const char* cA = cur.A; const char* cB = cur.B;
    S.a_ready(cur);
    PG8_STAGE(PG8_SB(0, 0), cB, RB2, cur.ldb); PG8_STAGE(PG8_SB(0, 1), cB + PG8_HS(cur.ldb), RB2, cur.ldb); PG8_STAGE(PG8_SA(0, 0), cA, RA2, cur.lda); PG8_STAGE(PG8_SA(0, 1), cA + PG8_HS(cur.lda), RA2, cur.lda);
    if (wr == 1) PG8_BAR;
    PG8_WAIT_V(2); PG8_BAR;
    PG8_STAGE(PG8_SB(1, 0), cB + kstep, RB2, cur.ldb); PG8_STAGE(PG8_SA(1, 0), cA + kstep, RA2, cur.lda); PG8_STAGE(PG8_SB(1, 1), cB + PG8_HS(cur.ldb) + kstep, RB2, cur.ldb);
    PG8_WAIT_V(6); PG8_BAR;
    for (;;) {
        const bool has_next = S.next(ui + 1, nxt);
        const char* nA = has_next ? nxt.A : cA; const char* nB = has_next ? nxt.B : cB;
        const int nt = cur.ntk;
        for (int t = 0; t < nt; t += 2) {
            const bool last = (t == nt - 2);
            const char* a1 = cA + (size_t)(t + 1) * kstep;
            const char* a2 = last ? nA : cA + (size_t)(t + 2) * kstep; const char* b2 = last ? nB : cB + (size_t)(t + 2) * kstep;
            const char* a3 = a2 + kstep; const char* b3 = b2 + kstep;
            const int lda1 = cur.lda, lda2 = (last && has_next) ? nxt.lda : cur.lda, ldb2 = (last && has_next) ? nxt.ldb : cur.ldb, kd1 = cur.kind, kd2 = (last && has_next) ? nxt.kind : cur.kind;
            if (last && has_next) S.a_ready(nxt);
            if constexpr (Epi::RESCALE) { const int ka = cur.kt0 + t; if (cur.kind == 0 && t > 0 && (ka == 8 || ka == 16)) { const int l2 = fresh_lane(); E.rescale(acc, cur, ka >> 3, wr, wc, l2 & 15, l2 >> 4); asm volatile("s_waitcnt vmcnt(0)" ::: "memory"); } }
            PG8_LDB(B0, 0, 0); PG8_LDB(B1, 0, 1); PG8_SCHED; PG8_LDA(At, 0, 0); PG8_STAGE_A(PG8_SA(1, 1), a1 + PG8_HS(lda1), lda1, kd1);
            PG8_WAIT_V(8); PG8_WAIT_L(0); PG8_BAR; PG8_MMA(0, 0, At, B0); PG8_MMA(0, 1, At, B1); PG8_BAR; PG8_SCHED;
            PG8_LDA(At, 0, 1); PG8_STAGE(PG8_SB(0, 0), b2, RB2, ldb2); PG8_STAGE(PG8_SB(0, 1), b2 + PG8_HS(ldb2), RB2, ldb2); PG8_STAGE_A(PG8_SA(0, 0), a2, lda2, kd2);
            PG8_WAIT_V(8); PG8_WAIT_L(0); PG8_BAR; PG8_MMA(1, 0, At, B0); PG8_MMA(1, 1, At, B1); PG8_BAR; PG8_SCHED;
            PG8_LDB(B0, 1, 0); PG8_LDB(B1, 1, 1); PG8_SCHED; PG8_LDA(At, 1, 0); PG8_STAGE_A(PG8_SA(0, 1), a2 + PG8_HS(lda2), lda2, kd2);
            PG8_WAIT_V(8); PG8_WAIT_L(0); PG8_BAR; PG8_MMA(0, 0, At, B0); PG8_MMA(0, 1, At, B1); PG8_BAR; PG8_SCHED;
            PG8_LDA(At, 1, 1); PG8_STAGE(PG8_SB(1, 0), b3, RB2, ldb2); PG8_STAGE(PG8_SB(1, 1), b3 + PG8_HS(ldb2), RB2, ldb2); PG8_STAGE_A(PG8_SA(1, 0), a3, lda2, kd2);
            PG8_WAIT_V(8); PG8_WAIT_L(0); PG8_BAR; PG8_MMA(1, 0, At, B0); PG8_MMA(1, 1, At, B1); PG8_BAR; PG8_SCHED;
        }
        if constexpr (ALIGN_EPI) { if (wr == 0) PG8_BAR; }
        if constexpr (FP8) asm volatile("s_nop 15\n\ts_nop 15" ::: "memory");
        if constexpr (Epi::RESCALE) { if (cur.kind == 0) { const int l2 = fresh_lane(); E.finalize(acc, cur, (cur.kt0 + nt - 1) >> 3, wr, wc, l2 & 15, l2 >> 4); } }
        if (cur.mode == 2) sk_store_partial(acc, X, wid);
        else { if (cur.mode != 0) {
#pragma unroll 1
                for (int pq = cur.peer, pe = cur.peer + (cur.mode == 1 ? 1 : cur.mode - 1); pq < pe; ++pq) sk_add_partial(acc, X, pq, wid); }
            const int l2 = fresh_lane(); E(acc, cur, wr, wc, l2 & 15, l2 >> 4); S.done(cur, l2); }
        if (!has_next) break;
#pragma unroll
        for (int a = 0; a < 2; ++a)
#pragma unroll
            for (int b = 0; b < 2; ++b)
#pragma unroll
                for (int m = 0; m < 4; ++m)
#pragma unroll
                    for (int n = 0; n < 2; ++n) acc[a][b][m][n] = (f32x4){0.f, 0.f, 0.f, 0.f};
        cur = nxt; cA = nA; cB = nB; ++ui;
        if constexpr (ALIGN_EPI) { if (wr == 1) PG8_BAR; }
    }
    PG8_WAIT_V(0);
    if constexpr (!ALIGN_EPI) { if (wr == 0) PG8_BAR; }
    PG8_BAR;
#undef PG8_SA
#undef PG8_SB
#undef PG8_STAGE
#undef PG8_HS
#undef PG8_STAGE_A
#undef PG8_LDA
#undef PG8_LDB
#undef PG8_MMA
#undef PG8_WAIT_V
#undef PG8_WAIT_L
#undef PG8_BAR
#undef PG8_SCHED
}

__device__ __forceinline__ u32x4 pack8(const f32x4& a, const f32x4& b) { u32x4 w; w.x = cvt_pk_bf16(a[0], a[1]); w.y = cvt_pk_bf16(a[2], a[3]); w.z = cvt_pk_bf16(b[0], b[1]); w.w = cvt_pk_bf16(b[2], b[3]); return w; }
__device__ __forceinline__ void unpack8(const u32x4& w, f32x4& a, f32x4& b) { a = (f32x4){bflo(w.x), bfhi(w.x), bflo(w.y), bfhi(w.y)}; b = (f32x4){bflo(w.z), bfhi(w.z), bflo(w.w), bfhi(w.w)}; }

struct EpiInProj {
    static constexpr bool PERM = true, RESCALE = false;
    bf16_t* P; bf16_t* G; const float* qn; const float* kn; const float* bgate; const float* rope; float isc;
    __device__ __forceinline__ void operator()(const f32x4 (&acc)[2][2][4][2], const Unit& u, int wr, int wc, int fr, int fq) const {
        const int T = u.pn, jt = u.pm % 17; const bool lat = (jt != 0);
        const int row0 = u.pm * BM + wr * 64 + fr;
        if (T >= 12) {
            const int c0 = (T - 12) * 256 + wc * 32 + 8 * fq;
            f32x4 bv[2][2];
#pragma unroll
            for (int bj = 0; bj < 2; ++bj)
#pragma unroll
                for (int n = 0; n < 2; ++n) bv[bj][n] = *(const f32x4*)(bgate + c0 + bj * HALF + 4 * n) * -LOG2E;
            const float ke = -isc * LOG2E;
            unsigned char* G8 = (unsigned char*)G + (T - 12) * 256 + wc * 64 + fq * 16;
#pragma unroll
            for (int ai = 0; ai < 2; ++ai)
#pragma unroll
                for (int m = 0; m < 4; ++m) { u32x4 w;
#pragma unroll
                    for (int bj = 0; bj < 2; ++bj)
#pragma unroll
                        for (int n = 0; n < 2; ++n) { const f32x4 z = acc[ai][bj][m][n] * ke + bv[bj][n]; unsigned d = 0;
#pragma unroll
                            for (int x = 0; x < 4; ++x) d |= (unsigned)(255.999f * __builtin_amdgcn_rcpf(1.0f + __builtin_amdgcn_exp2f(z[x]))) << (8 * x);
                            w[2 * bj + n] = d; }
                    *(u32x4*)(G8 + (size_t)(row0 + ai * HALF + m * 16) * PC) = w; }
            return;
        }
        if (T >= 5 && T <= 8) {
            const int c0 = T * 256 + wc * 32 + 8 * fq; const bool sl = (T >= 7);
#pragma unroll
            for (int ai = 0; ai < 2; ++ai)
#pragma unroll
                for (int m = 0; m < 4; ++m) { bf16_t* rowp = P + (size_t)(row0 + ai * HALF + m * 16) * PC + c0;
#pragma unroll
                    for (int bj = 0; bj < 2; ++bj) { f32x4 v0 = acc[ai][bj][m][0] * isc, v1 = acc[ai][bj][m][1] * isc;
                        if (sl) {
#pragma unroll
                            for (int x = 0; x < 4; ++x) { v0[x] = siluf_(v0[x]); v1[x] = siluf_(v1[x]); } }
                        const u32x4 w = pack8(v0, v1);
                        if (T <= 6) asm volatile("global_store_dwordx4 %0, %1, off sc1\n\ts_nop 1" :: "v"(rowp + bj * HALF), "v"(w) : "memory");
                        else *(u32x4*)(rowp + bj * HALF) = w; } }
            return;
        }
        const bool isv = ((T == 2 || T == 11) && wc >= 2);
        const bool donorm = (T <= 1) || (T == 2 && wc < 2);
        const bool dorope = lat && !isv;
        const float scale = (T <= 1 || T == 9 || T == 10) ? C2 : (T == 3 ? 0.125f : 1.0f);
        const float* gain = (T <= 1) ? qn : kn;
        f32x4 g1[2], g2[2];
        if (donorm) {
#pragma unroll
            for (int n = 0; n < 2; ++n) { g1[n] = *(const f32x4*)(gain + 8 * fq + 4 * n); g2[n] = *(const f32x4*)(gain + 32 + 8 * fq + 4 * n); }
        }
        const int cbase = T * 256 + 64 * wc + 8 * fq;
#pragma unroll
        for (int ai = 0; ai < 2; ++ai)
#pragma unroll
            for (int m = 0; m < 4; ++m) {
                f32x4 t1[2], t2[2];
#pragma unroll
                for (int n = 0; n < 2; ++n) { t1[n] = acc[ai][0][m][n] * isc; t2[n] = acc[ai][1][m][n] * isc; }
                if (donorm) {
                    float ss = 0.f;
#pragma unroll
                    for (int n = 0; n < 2; ++n)
#pragma unroll
                        for (int x = 0; x < 4; ++x) ss += t1[n][x] * t1[n][x] + t2[n][x] * t2[n][x];
                    ss += swz_xor<16>(ss); ss = xor32_sum(ss);
                    const float inv = rsqrtf(ss * (1.0f / 64.0f) + EPS);
#pragma unroll
                    for (int n = 0; n < 2; ++n) { t1[n] = t1[n] * inv * g1[n]; t2[n] = t2[n] * inv * g2[n]; }
                }
                if (dorope) {
                    const int grow = 4 * (jt - 1) + 2 * ai + wr, gcol = 16 * m + fr;
                    const int pos = (fq < 2) ? grow : gcol;
                    const float* rp = rope + ((size_t)pos * 16 + 8 * (fq & 1)) * 2;
#pragma unroll
                    for (int n = 0; n < 2; ++n) {
                        const f32x4 cs0 = *(const f32x4*)(rp + 8 * n), cs1 = *(const f32x4*)(rp + 8 * n + 4);
                        const f32x4 c = (f32x4){cs0[0], cs0[2], cs1[0], cs1[2]}, s = (f32x4){cs0[1], cs0[3], cs1[1], cs1[3]};
                        const f32x4 a = t1[n], b = t2[n];
                        t1[n] = a * c - b * s; t2[n] = a * s + b * c;
                    }
                }
#pragma unroll
                for (int n = 0; n < 2; ++n) { t1[n] = t1[n] * scale; t2[n] = t2[n] * scale; }
                bf16_t* rowp = P + (size_t)(row0 + ai * HALF + m * 16) * PC + cbase;
                const u32x4 w1 = pack8(t1[0], t1[1]), w2 = pack8(t2[0], t2[1]);
                if (T == 4) { asm volatile("global_store_dwordx4 %0, %1, off sc1\n\ts_nop 1" :: "v"(rowp), "v"(w1) : "memory"); asm volatile("global_store_dwordx4 %0, %1, off sc1\n\ts_nop 1" :: "v"(rowp + 32), "v"(w2) : "memory"); }
                else { *(u32x4*)(rowp) = w1; *(u32x4*)(rowp + 32) = w2; }
            }
    }
};

struct EpiBranch {
    static constexpr bool PERM = true, RESCALE = true;
    const bf16_t* G; bf16_t* MB;
    static __device__ __forceinline__ f32x4 dec4(unsigned w) { return (f32x4){(float)(w & 0xffu) + 0.5f, (float)((w >> 8) & 0xffu) + 0.5f, (float)((w >> 16) & 0xffu) + 0.5f, (float)(w >> 24) + 0.5f}; }
    __device__ __forceinline__ void rescale(f32x4 (&acc)[2][2][4][2], const Unit& u, int bnd, int wr, int wc, int fr, int fq) const {
        const int row0 = u.pm * BM + wr * 64 + fr; const unsigned char* gb = (const unsigned char*)G + (4 * (bnd - 1) + u.pn) * 256 + wc * 64 + fq * 16;
#pragma unroll
        for (int ai = 0; ai < 2; ++ai) {
            u32x4 gp[4], gc[4];
#pragma unroll
            for (int m = 0; m < 4; ++m) { const unsigned char* p = gb + (size_t)(row0 + ai * HALF + m * 16) * PC; gp[m] = *(const u32x4*)p; gc[m] = *(const u32x4*)(p + 1024); }
#pragma unroll
            for (int m = 0; m < 4; ++m)
#pragma unroll
                for (int bj = 0; bj < 2; ++bj)
#pragma unroll
                    for (int n = 0; n < 2; ++n) { const f32x4 a = dec4(gp[m][2 * bj + n]), b = dec4(gc[m][2 * bj + n]);
#pragma unroll
                        for (int x = 0; x < 4; ++x) acc[ai][bj][m][n][x] *= a[x] * __builtin_amdgcn_rcpf(b[x]); }
        }
    }
    __device__ __forceinline__ void finalize(f32x4 (&acc)[2][2][4][2], const Unit& u, int br, int wr, int wc, int fr, int fq) const {
        const int row0 = u.pm * BM + wr * 64 + fr; const unsigned char* gb = (const unsigned char*)G + (4 * br + u.pn) * 256 + wc * 64 + fq * 16;
#pragma unroll
        for (int ai = 0; ai < 2; ++ai) {
            u32x4 g2[4];
#pragma unroll
            for (int m = 0; m < 4; ++m) g2[m] = *(const u32x4*)(gb + (size_t)(row0 + ai * HALF + m * 16) * PC);
#pragma unroll
            for (int m = 0; m < 4; ++m)
#pragma unroll
                for (int bj = 0; bj < 2; ++bj)
#pragma unroll
                    for (int n = 0; n < 2; ++n) acc[ai][bj][m][n] = acc[ai][bj][m][n] * (dec4(g2[m][2 * bj + n]) * (1.0f / 256.0f));
        }
    }
    __device__ __forceinline__ void operator()(const f32x4 (&acc)[2][2][4][2], const Unit& u, int wr, int wc, int fr, int fq) const {
        const int row0 = u.pm * BM + wr * 64 + fr, c0 = u.pn * BM + wc * 32 + 8 * fq;
#pragma unroll
        for (int ai = 0; ai < 2; ++ai)
#pragma unroll
            for (int m = 0; m < 4; ++m)
#pragma unroll
                for (int bj = 0; bj < 2; ++bj) { const u32x4 w = pack8(acc[ai][bj][m][0], acc[ai][bj][m][1]); asm volatile("global_store_dwordx4 %0, %1, off sc1\n\ts_nop 1" :: "v"(MB + (size_t)(row0 + ai * HALF + m * 16) * D + c0 + bj * HALF), "v"(w) : "memory"); }
    }
};

struct EpiResid {
    static constexpr bool PERM = true, RESCALE = false;
    bf16_t* XS; const float* gate;
    __device__ __forceinline__ void operator()(const f32x4 (&acc)[2][2][4][2], const Unit& u, int wr, int wc, int fr, int fq) const {
        const int who = (u.pm % 17 == 0) ? 4 : (u.pm / 17);
        const float* gp = gate + (size_t)who * INC;
        const int row0 = u.pm * BM + wr * 64 + fr, c0 = u.pn * BM + wc * 32 + 8 * fq;
        f32x4 gv[2][2];
#pragma unroll
        for (int bj = 0; bj < 2; ++bj)
#pragma unroll
            for (int n = 0; n < 2; ++n) gv[bj][n] = *(const f32x4*)(gp + c0 + bj * HALF + n * 4);
        u32x4 old[2][4][2];
#pragma unroll
        for (int ai = 0; ai < 2; ++ai)
#pragma unroll
            for (int m = 0; m < 4; ++m)
#pragma unroll
                for (int bj = 0; bj < 2; ++bj) old[ai][m][bj] = *(const u32x4*)(XS + (size_t)(row0 + ai * HALF + m * 16) * D + c0 + bj * HALF);
#pragma unroll
        for (int ai = 0; ai < 2; ++ai)
#pragma unroll
            for (int m = 0; m < 4; ++m)
#pragma unroll
                for (int bj = 0; bj < 2; ++bj) { f32x4 oa, ob; unpack8(old[ai][m][bj], oa, ob);
                    *(u32x4*)(XS + (size_t)(row0 + ai * HALF + m * 16) * D + c0 + bj * HALF) = pack8(oa + gv[bj][0] * acc[ai][bj][m][0], ob + gv[bj][1] * acc[ai][bj][m][1]); }
    }
};

struct EpiSwiGLU {
    static constexpr bool PERM = true, RESCALE = false;
    bf16_t* H; int ldh;
    __device__ __forceinline__ void operator()(const f32x4 (&acc)[2][2][4][2], const Unit& u, int wr, int wc, int fr, int fq) const {
        const int row0 = u.pm * BM + wr * 64 + fr, c0 = u.pn * HALF + wc * 32 + 8 * fq;
#pragma unroll
        for (int ai = 0; ai < 2; ++ai)
#pragma unroll
            for (int m = 0; m < 4; ++m) { f32x4 v[2];
#pragma unroll
                for (int n = 0; n < 2; ++n)
#pragma unroll
                    for (int x = 0; x < 4; ++x) v[n][x] = siluf_(acc[ai][0][m][n][x]) * acc[ai][1][m][n][x];
                *(u32x4*)(H + (size_t)(row0 + ai * HALF + m * 16) * ldh + c0) = pack8(v[0], v[1]); }
    }
};

struct EpiSwiGLU8 {
    static constexpr bool PERM = true, RESCALE = false;
    unsigned char* H; int ldh; float isc, osc;
    __device__ __forceinline__ void operator()(const f32x4 (&acc)[2][2][4][2], const Unit& u, int wr, int wc, int fr, int fq) const {
        const int row0 = u.pm * BM + wr * 64 + fr, c0 = u.pn * HALF + wc * 32 + 8 * fq;
        const float ke = -isc * LOG2E, kk = isc * isc * osc;
#pragma unroll
        for (int ai = 0; ai < 2; ++ai)
#pragma unroll
            for (int m = 0; m < 4; ++m) { f32x4 v[2];
#pragma unroll
                for (int n = 0; n < 2; ++n)
#pragma unroll
                    for (int x = 0; x < 4; ++x) { const float a = acc[ai][0][m][n][x];
                        v[n][x] = (a * acc[ai][1][m][n][x]) * (kk * __builtin_amdgcn_rcpf(1.0f + __builtin_amdgcn_exp2f(a * ke))); }
                u32x2 w; w.x = pk4_fp8(v[0][0], v[0][1], v[0][2], v[0][3]); w.y = pk4_fp8(v[1][0], v[1][1], v[1][2], v[1][3]);
                *(u32x2*)(H + (size_t)(row0 + ai * HALF + m * 16) * ldh + c0) = w; }
    }
};

struct EpiMoEDown {
    static constexpr bool PERM = true, RESCALE = false;
    bf16_t* Y; const float* cw; float sc;
    __device__ __forceinline__ void operator()(const f32x4 (&acc)[2][2][4][2], const Unit& u, int wr, int wc, int fr, int fq) const {
        const int row0 = u.pm * BM + wr * 64 + fr, c0 = u.pn * BM + wc * 32 + 8 * fq;
#pragma unroll
        for (int ai = 0; ai < 2; ++ai)
#pragma unroll
            for (int m = 0; m < 4; ++m) { const int row = row0 + ai * HALF + m * 16; const float w = cw[row] * sc;
#pragma unroll
                for (int bj = 0; bj < 2; ++bj) *(u32x4*)(Y + (size_t)row * D + c0 + bj * HALF) = pack8(acc[ai][bj][m][0] * w, acc[ai][bj][m][1] * w); }
    }
};
template <class E0, class E1> struct EpiDual {
    static constexpr bool PERM = true, RESCALE = E0::RESCALE; static_assert(E0::PERM && E1::PERM, "dual phases stage B rows permuted for both kinds");
    E0 e0; E1 e1;
    __device__ __forceinline__ void rescale(f32x4 (&acc)[2][2][4][2], const Unit& u, int bnd, int wr, int wc, int fr, int fq) const { e0.rescale(acc, u, bnd, wr, wc, fr, fq); }
    __device__ __forceinline__ void finalize(f32x4 (&acc)[2][2][4][2], const Unit& u, int br, int wr, int wc, int fr, int fq) const { e0.finalize(acc, u, br, wr, wc, fr, fq); }
    __device__ __forceinline__ void operator()(const f32x4 (&acc)[2][2][4][2], const Unit& u, int wr, int wc, int fr, int fq) const { if (u.kind == 0) e0(acc, u, wr, wc, fr, fq); else e1(acc, u, wr, wc, fr, fq); }
};
}
namespace attn_body {
using bf16=unsigned short;
constexpr int D=64, QKP=3072  , OPITCH=1536  ;
constexpr int NW=8,QBLK=32,QB=QBLK*NW,KVBLK=64;
__device__ __forceinline__ int crow(int r,int hi){return (r&3)+8*(r>>2)+4*hi;}
#define SBAR() __builtin_amdgcn_sched_barrier(0)
__device__ __forceinline__ void wmask(f32x16&p0,f32x16&p1,int t,int qrel,int hi,int qoff){
  const float NEG=-INFINITY; const int base=64*(t-4)+4*hi-qrel-qoff;
  #pragma unroll
  for(int r=0;r<16;++r){const int d=base+(r&3)+8*(r>>2); if(d>128||d<-128)p0[r]=NEG; const int d1=d+32; if(d1>128||d1<-128)p1[r]=NEG;}
}

constexpr int NSLOT=3, SLOTB=8192;
constexpr int LDS_K=0, LDS_V=NSLOT*SLOTB, LDS_WS=2*NSLOT*SLOTB, LDS_OST=LDS_WS+NW*64*4, LDS_BYTES=LDS_OST+NW*4096;
__device__ __forceinline__ void glds16(const void*gsrc,unsigned lds_dst){unsigned keep;
  asm volatile("s_mov_b32 %0, m0\n\ts_mov_b32 m0, %2\n\ts_nop 0\n\tglobal_load_lds_dwordx4 %1, off\n\ts_mov_b32 m0, %0":"=&s"(keep):"v"(gsrc),"s"(lds_dst):"memory");}
__device__ __forceinline__ float max3f(float a,float b,float c){float r;asm("v_max3_f32 %0, %1, %2, %3":"=v"(r):"v"(a),"v"(b),"v"(c));return r;}
__device__ __forceinline__ float max2f(float a,float b){float r;asm("v_max_f32_e32 %0, %1, %2":"=v"(r):"v"(a),"v"(b));return r;}
__device__ __forceinline__ float fadd_s(float a,float b){float r;asm("v_add_f32_e32 %0, %1, %2":"=v"(r):"v"(a),"v"(b));return r;}
__device__ __forceinline__ float fsub_s(float a,float b){float r;asm("v_sub_f32_e32 %0, %1, %2":"=v"(r):"v"(a),"v"(b));return r;}
typedef float f32x2_t __attribute__((ext_vector_type(2))); typedef __bf16 bf16x2_t __attribute__((ext_vector_type(2)));
__device__ __forceinline__ unsigned cvtpk_s(float lo,float hi){f32x2_t v={lo,hi};bf16x2_t b=__builtin_convertvector(v,bf16x2_t);return __builtin_bit_cast(unsigned,b);}
#define WAIT_BAR(N) asm volatile("s_waitcnt vmcnt(" #N ") lgkmcnt(0)\n\ts_barrier":::"memory")

__device__ __forceinline__ void qkt(f32x16&p0,f32x16&p1,const char*Kslot,const bf16x8*qr,const f32x16&negm,int r32,int hi){
  const char*kb=Kslot+hi*1024+r32*16;
  #pragma unroll
  for(int d0=0;d0<4;++d0){
    const bf16x8 b0=*reinterpret_cast<const bf16x8*>(kb+d0*2048);
    const bf16x8 b1=*reinterpret_cast<const bf16x8*>(kb+d0*2048+512);
    if(d0==0){p0=__builtin_amdgcn_mfma_f32_32x32x16_bf16(b0,qr[0],negm,0,0,0);p1=__builtin_amdgcn_mfma_f32_32x32x16_bf16(b1,qr[0],negm,0,0,0);}
    else{p0=__builtin_amdgcn_mfma_f32_32x32x16_bf16(b0,qr[d0],p0,0,0,0);p1=__builtin_amdgcn_mfma_f32_32x32x16_bf16(b1,qr[d0],p1,0,0,0);}}
}
typedef __attribute__((address_space(3))) const char* lds_cptr;
typedef short v4i16_t __attribute__((ext_vector_type(4)));
__device__ __forceinline__ void kload8(bf16x8*kf,lds_cptr kp){
  kf[0]=*(const __attribute__((address_space(3))) bf16x8*)(kp);      kf[1]=*(const __attribute__((address_space(3))) bf16x8*)(kp+512);
  kf[2]=*(const __attribute__((address_space(3))) bf16x8*)(kp+2048); kf[3]=*(const __attribute__((address_space(3))) bf16x8*)(kp+2560);
  kf[4]=*(const __attribute__((address_space(3))) bf16x8*)(kp+4096); kf[5]=*(const __attribute__((address_space(3))) bf16x8*)(kp+4608);
  kf[6]=*(const __attribute__((address_space(3))) bf16x8*)(kp+6144); kf[7]=*(const __attribute__((address_space(3))) bf16x8*)(kp+6656);
}
__device__ __forceinline__ void kload2(bf16x8*kf,lds_cptr kp,int j){ kf[2*j]=*(const __attribute__((address_space(3))) bf16x8*)(kp+j*2048); kf[2*j+1]=*(const __attribute__((address_space(3))) bf16x8*)(kp+j*2048+512); }
__device__ __forceinline__ s16x4 vtr(lds_cptr p){ return __builtin_bit_cast(s16x4,__builtin_amdgcn_ds_read_tr16_b64_v4i16((__attribute__((address_space(3))) v4i16_t*)p)); }
__device__ __forceinline__ float rowmax(const f32x16&p0,const f32x16&p1){
  float a=max3f(p0[0],p0[1],p1[0]),b=max3f(p0[2],p0[3],p1[1]);a=max3f(a,p1[2],p1[3]);
  #pragma unroll
  for(int r=4;r<16;r+=4){a=max3f(a,p0[r],p0[r+1]);b=max3f(b,p0[r+2],p0[r+3]);a=max3f(a,p1[r],p1[r+1]);b=max3f(b,p1[r+2],p1[r+3]);}
  const float m=max2f(a,b);
  auto rr=__builtin_amdgcn_permlane32_swap(__float_as_uint(m),__float_as_uint(m),false,false);
  return max2f(__uint_as_float(rr[0]),__uint_as_float(rr[1]));
}
__device__ __forceinline__ void pv(f32x16*o,int vb,bf16x8 pa0,bf16x8 pa1,bf16x8 pa2,bf16x8 pa3){
  #pragma unroll
  for(int d0=0;d0<2;++d0){s16x4 lo[4],hi[4];
    #pragma unroll
    for(int ks=0;ks<4;++ks){
      asm volatile("ds_read_b64_tr_b16 %0,%1 offset:%c2":"=&v"(lo[ks]):"v"(vb),"i"(d0*4096+ks*1024):"memory");
      asm volatile("ds_read_b64_tr_b16 %0,%1 offset:%c2":"=&v"(hi[ks]):"v"(vb),"i"(d0*4096+ks*1024+512):"memory");}
    asm volatile("s_waitcnt lgkmcnt(0)":::"memory");SBAR();
    #define PK(k) (bf16x8){lo[k][0],lo[k][1],lo[k][2],lo[k][3],hi[k][0],hi[k][1],hi[k][2],hi[k][3]}
    o[d0]=__builtin_amdgcn_mfma_f32_32x32x16_bf16(pa0,PK(0),o[d0],0,0,0);
    o[d0]=__builtin_amdgcn_mfma_f32_32x32x16_bf16(pa1,PK(1),o[d0],0,0,0);
    o[d0]=__builtin_amdgcn_mfma_f32_32x32x16_bf16(pa2,PK(2),o[d0],0,0,0);
    o[d0]=__builtin_amdgcn_mfma_f32_32x32x16_bf16(pa3,PK(3),o[d0],0,0,0);
    #undef PK
  }
}

#ifndef ATTN_STORE16
#define ATTN_STORE16(p,v) (*(u32x4*)(p)=(v))
#endif
template<int THRL,int MODE> __device__ __forceinline__ void attn_unit(const bf16*Qu,const bf16*__restrict__ Kh,const bf16*__restrict__ Vh,bf16*Ou,const int NT,const int kgap,const int qoff,const float sink2,char*shm,const int tid){
  const int lane=tid&63,r32=lane&31,hi=lane>>5; const int wid=__builtin_amdgcn_readfirstlane(tid>>6);
  const bf16*Qw=Qu+(long)(wid*QBLK)*QKP;
  const unsigned lds0=(unsigned)(uintptr_t)shm;
  float*wsf=(float*)(shm+LDS_WS)+wid*64;
  const bf16*ksrc=Kh+(long)lane*QKP+wid*8;
  const bf16*vsrc=Vh+(long)(16*(wid&3)+(lane>>2))*QKP+(wid>>2)*32+(lane&3)*8;
  const unsigned kdst=lds0+LDS_K+wid*1024, vdst=lds0+LDS_V+wid*1024;
  #define ROWOFF(t) ((long)((t)*KVBLK+(((t)>=4)?kgap:0))*QKP)
  #define DMA_K(t,slot) glds16(ksrc+ROWOFF(t),(unsigned)__builtin_amdgcn_readfirstlane(kdst+(slot)))
  #define DMA_V(t,slot) glds16(vsrc+ROWOFF(t),(unsigned)__builtin_amdgcn_readfirstlane(vdst+(slot)))
  const int vb0=(int)(lds0+LDS_V)+((lane>>4)&1)*32+(lane&3)*8+(4*hi+((lane&15)>>2))*64;
  const char*Kbase=shm+LDS_K; bf16x8 kf[8];
  const lds_cptr shm3=(lds_cptr)shm; const lds_cptr kp0=shm3+LDS_K+hi*1024+r32*16; const lds_cptr vp0=shm3+LDS_V+((lane>>4)&1)*32+(lane&3)*8+(4*hi+((lane&15)>>2))*64;
  DMA_K(0,0);DMA_V(0,0);DMA_K(1,SLOTB);
  bf16x8 qr[4];
  #pragma unroll
  for(int d0=0;d0<4;++d0)qr[d0]=*reinterpret_cast<const bf16x8*>(&Qw[(long)r32*QKP+d0*16+hi*8]);
  float mhat=0.f,l_reg=0.f;f32x16 o[2];o[0]=f32x16{};o[1]=f32x16{};f32x16 negm=f32x16{};asm volatile("":"+v"(negm));
  const int qrel=wid*QBLK+r32;
  #define CMASK(P0,P1,t) do{ if(MODE==1&&(t)>=4)wmask(P0,P1,(t),qrel,hi,qoff); }while(0)
  bool resc=false;
  #define START(P0,P1) do{ const float rm=rowmax(P0,P1); resc=false; \
    { const float dl=rm; mhat=fadd_s(mhat,dl); \
      _Pragma("unroll") for(int r=0;r<16;++r){P0[r]=fsub_s(P0[r],dl);P1[r]=fsub_s(P1[r],dl);} \
      _Pragma("unroll") for(int r=0;r<16;++r)negm[r]=-mhat; asm volatile("":"+v"(negm)); } \
    _Pragma("unroll") for(int r=0;r<16;++r)P0[r]=__builtin_amdgcn_exp2f(P0[r]); }while(0)
  #define RESC() do{ if(resc){ asm volatile("s_waitcnt lgkmcnt(0)":::"memory"); \
      _Pragma("unroll") for(int d_=0;d_<2;++d_) _Pragma("unroll") for(int r=0;r<16;++r)o[d_][r]*=wsf[crow(r,hi)]; } }while(0)
  f32x16 pA0,pA1,pB0,pB1;
  int sl_prev=0,sl_cur=0,sl_next=SLOTB;
  #define ROT() do{sl_prev=sl_cur;sl_cur=sl_next;sl_next=(sl_next==(NSLOT-1)*SLOTB)?0:sl_next+SLOTB;}while(0)
  DMA_K(2,2*SLOTB);
  WAIT_BAR(3);
  qkt(pA0,pA1,Kbase,qr,negm,r32,hi);asm volatile("s_nop 15\n\ts_nop 7":"+v"(pA0),"+v"(pA1));CMASK(pA0,pA1,0);
  START(pA0,pA1);
  _Pragma("unroll") for(int r=0;r<16;++r)pA1[r]=__builtin_amdgcn_exp2f(pA1[r]);
  WAIT_BAR(0);
  DMA_K(3,0);DMA_V(1,SLOTB);
  ROT();
  kload8(kf,kp0+sl_cur);
  WAIT_BAR(2);
  s16x4 vlo[8],vhi[8]; u32x4 pw0,pw1,pw2,pw3;
  #define PKW(P,B) cvtpk_s(P[B],P[B+1])
  #define PAF(k) __builtin_bit_cast(bf16x8,pw##k)
  #define VFR(i) (bf16x8){vlo[i][0],vlo[i][1],vlo[i][2],vlo[i][3],vhi[i][0],vhi[i][1],vhi[i][2],vhi[i][3]}
  #define PIN(x) asm volatile("":"+v"(x))
  #define MX3(a,b,c) __builtin_fmaxf(__builtin_fmaxf((a),(b)),(c))
  #define GAPA(MF,A0,A1,A2,A3,W0,W1,PW) do{ MF; sacc+=A0; sacc+=A1; sacc+=A2; sacc+=A3; PIN(sacc); W0; W1; PIN(PW); SBAR(); }while(0)
  #define EX(v) __builtin_amdgcn_exp2f(v)
  #define GAPB(MF,X,B) do{ MF; X[B]=EX(X[B]); X[B+1]=EX(X[B+1]); X[B+2]=EX(X[B+2]); X[B+3]=EX(X[B+3]); PIN(X); SBAR(); }while(0)
  #define VRD(i) do{ vlo[i]=vtr(vp_+(((i)>>2)*4096+((i)&3)*1024)); vhi[i]=vtr(vp_+(((i)>>2)*4096+((i)&3)*1024+512)); }while(0)
  #define KRD(G,j) do{ if(G){ kload2(kf,kp0+sl_next,j); SBAR(); } }while(0)
  #define STEP(C0,C1,P0,P1,t,GK,GV,GL) do{ SBAR(); \
    const lds_cptr vp_=vp0+sl_prev; \
    VRD(0); SBAR(); float sacc=(P0[0]+P0[1]); \
    GAPA(C0=__builtin_amdgcn_mfma_f32_32x32x16_bf16(kf[0],qr[0],negm,0,0,0), P0[2],P0[3],P0[4],P0[5],     pw0[0]=PKW(P0,0), pw0[1]=PKW(P0,2), pw0); \
    VRD(4); SBAR(); GAPA(C1=__builtin_amdgcn_mfma_f32_32x32x16_bf16(kf[1],qr[0],negm,0,0,0), P0[6],P0[7],P0[8],P0[9],     pw0[2]=PKW(P0,4), pw0[3]=PKW(P0,6), pw0); \
    VRD(1); SBAR(); GAPA(C0=__builtin_amdgcn_mfma_f32_32x32x16_bf16(kf[2],qr[1],C0,0,0,0),   P0[10],P0[11],P0[12],P0[13], pw1[0]=PKW(P0,8), pw1[1]=PKW(P0,10), pw1); \
    VRD(5); SBAR(); GAPA(C1=__builtin_amdgcn_mfma_f32_32x32x16_bf16(kf[3],qr[1],C1,0,0,0),   P0[14],P0[15],P1[0],P1[1],   pw1[2]=PKW(P0,12),pw1[3]=PKW(P0,14), pw1); \
    VRD(2); SBAR(); GAPA(C0=__builtin_amdgcn_mfma_f32_32x32x16_bf16(kf[4],qr[2],C0,0,0,0),   P1[2],P1[3],P1[4],P1[5],     pw2[0]=PKW(P1,0), pw2[1]=PKW(P1,2), pw2); \
    VRD(6); SBAR(); GAPA(C1=__builtin_amdgcn_mfma_f32_32x32x16_bf16(kf[5],qr[2],C1,0,0,0),   P1[6],P1[7],P1[8],P1[9],     pw2[2]=PKW(P1,4), pw2[3]=PKW(P1,6), pw2); \
    VRD(3); SBAR(); GAPA(C0=__builtin_amdgcn_mfma_f32_32x32x16_bf16(kf[6],qr[3],C0,0,0,0),   P1[10],P1[11],P1[12],P1[13], pw3[0]=PKW(P1,8), pw3[1]=PKW(P1,10), pw3); \
    VRD(7); SBAR(); GAPA(C1=__builtin_amdgcn_mfma_f32_32x32x16_bf16(kf[7],qr[3],C1,0,0,0),   P1[14],P1[15],0.f,0.f,       pw3[2]=PKW(P1,12),pw3[3]=PKW(P1,14), pw3); \
    l_reg+=sacc; \
    if(GK){DMA_K((t)+3,sl_cur);} if(GV){DMA_V((t)+1,sl_next);} \
    CMASK(C0,C1,t); \
    { float a=MX3(C0[0],C0[1],C1[0]),b=MX3(C0[2],C0[3],C1[1]); a=MX3(a,C1[2],C1[3]); \
      _Pragma("unroll") for(int r=4;r<16;r+=4){a=MX3(a,C0[r],C0[r+1]);b=MX3(b,C0[r+2],C0[r+3]);a=MX3(a,C1[r],C1[r+1]);b=MX3(b,C1[r+2],C1[r+3]);} \
      float rm=__builtin_fmaxf(a,b); { auto rr=__builtin_amdgcn_permlane32_swap(__float_as_uint(rm),__float_as_uint(rm),false,false); rm=__builtin_fmaxf(__uint_as_float(rr[0]),__uint_as_float(rr[1])); } \
      resc=false; \
      if(__builtin_expect(__any(rm>(float)THRL),0)){ const float dl=__builtin_fmaxf(rm,0.f); mhat+=dl; \
        _Pragma("unroll") for(int r=0;r<16;++r){C0[r]-=dl;C1[r]-=dl;} \
        _Pragma("unroll") for(int r=0;r<16;++r)negm[r]=-mhat; asm volatile("":"+v"(negm)); \
        const float f=__builtin_amdgcn_exp2f(-dl); l_reg*=f; if(hi==0)wsf[r32]=f; resc=true; } } \
    SBAR(); \
    GAPB(o[0]=__builtin_amdgcn_mfma_f32_32x32x16_bf16(PAF(0),VFR(0),o[0],0,0,0), C0,0); \
    GAPB(o[1]=__builtin_amdgcn_mfma_f32_32x32x16_bf16(PAF(0),VFR(4),o[1],0,0,0), C0,4); \
    KRD(GL,0); GAPB(o[0]=__builtin_amdgcn_mfma_f32_32x32x16_bf16(PAF(1),VFR(1),o[0],0,0,0), C0,8); \
    KRD(GL,1); GAPB(o[1]=__builtin_amdgcn_mfma_f32_32x32x16_bf16(PAF(1),VFR(5),o[1],0,0,0), C0,12); \
    KRD(GL,2); GAPB(o[0]=__builtin_amdgcn_mfma_f32_32x32x16_bf16(PAF(2),VFR(2),o[0],0,0,0), C1,0); \
    KRD(GL,3); GAPB(o[1]=__builtin_amdgcn_mfma_f32_32x32x16_bf16(PAF(2),VFR(6),o[1],0,0,0), C1,4); \
    GAPB(o[0]=__builtin_amdgcn_mfma_f32_32x32x16_bf16(PAF(3),VFR(3),o[0],0,0,0), C1,8); \
    GAPB(o[1]=__builtin_amdgcn_mfma_f32_32x32x16_bf16(PAF(3),VFR(7),o[1],0,0,0), C1,12); \
    }while(0)
  int t=1;
  for(;t+5<NT;t+=2){
    STEP(pB0,pB1,pA0,pA1,t,true,true,true);     WAIT_BAR(2); RESC(); ROT();
    STEP(pA0,pA1,pB0,pB1,t+1,true,true,true);   WAIT_BAR(2); RESC(); ROT();
  }
  #define ENDW(tt) do{ if((tt)+3<NT){WAIT_BAR(2);} else if((tt)+2<NT){WAIT_BAR(1);} else {WAIT_BAR(0);} }while(0)
  for(;t+1<NT;t+=2){
    STEP(pB0,pB1,pA0,pA1,t,(t+3<NT),(t+1<NT),(t+1<NT));       ENDW(t);   RESC(); ROT();
    STEP(pA0,pA1,pB0,pB1,t+1,(t+4<NT),(t+2<NT),(t+2<NT));     ENDW(t+1); RESC(); ROT();
  }
  STEP(pB0,pB1,pA0,pA1,NT-1,false,false,false); RESC();
  { float sacc=pB0[0]+pB0[1]; _Pragma("unroll") for(int r=2;r<16;++r)sacc+=pB0[r]; _Pragma("unroll") for(int r=0;r<16;++r)sacc+=pB1[r]; l_reg+=sacc;
    pw0=(u32x4){PKW(pB0,0),PKW(pB0,2),PKW(pB0,4),PKW(pB0,6)};pw1=(u32x4){PKW(pB0,8),PKW(pB0,10),PKW(pB0,12),PKW(pB0,14)};pw2=(u32x4){PKW(pB1,0),PKW(pB1,2),PKW(pB1,4),PKW(pB1,6)};pw3=(u32x4){PKW(pB1,8),PKW(pB1,10),PKW(pB1,12),PKW(pB1,14)};
    SBAR(); pv(o,vb0+sl_cur,PAF(0),PAF(1),PAF(2),PAF(3)); }
  #undef PKW
  #undef PAF
  #undef VFR
  #undef PIN
  #undef MX3
  #undef GAPA
  #undef GAPB
  #undef EX
  #undef VRD
  #undef KRD
  #undef STEP
  #undef ENDW
  {auto rr=__builtin_amdgcn_permlane32_swap(__float_as_uint(l_reg),__float_as_uint(l_reg),false,false);l_reg=__uint_as_float(rr[0])+__uint_as_float(rr[1]);}
  l_reg+=__builtin_amdgcn_exp2f(sink2-mhat);
  if(hi==0)wsf[32+r32]=l_reg;asm volatile("s_waitcnt lgkmcnt(0)":::"memory");
  float rli[16];
  #pragma unroll
  for(int r=0;r<16;++r)rli[r]=__builtin_amdgcn_rcpf(wsf[32+crow(r,hi)]);
  bf16*Ow=Ou+(long)(wid*QBLK)*OPITCH;
  { bf16*stg=(bf16*)(shm+LDS_OST)+wid*2048;
    #pragma unroll
    for(int r=0;r<16;++r){const int orow=crow(r,hi);
      #pragma unroll
      for(int d0=0;d0<2;++d0)stg[orow*64+d0*32+r32]=(bf16)f2bf(o[d0][r]*rli[r]);}
    asm volatile("s_waitcnt lgkmcnt(0)":::"memory");
    #pragma unroll
    for(int i=0;i<4;++i){const int row=i*8+(lane>>3),ch=lane&7; const u32x4 v=*(const u32x4*)(stg+row*64+ch*8); ATTN_STORE16(Ow+(long)row*OPITCH+ch*8,v);} }
  asm volatile("s_waitcnt lgkmcnt(0)\n\ts_barrier":::"memory");
  #undef ROWOFF
  #undef DMA_K
  #undef DMA_V
  #undef CMASK
  #undef START
  #undef RESC
  #undef ROT
}
constexpr int ATTN_LDS_BYTES=LDS_BYTES;
#undef SBAR
#undef WAIT_BAR
}
__device__ __forceinline__ void wait_panel(unsigned* cnt, unsigned* tmo, int pm, int wave_s, unsigned need);
namespace ret {
constexpr int RSV = 136, RSK = 72;
constexpr int NCH = TPB / 128;
typedef short v4i16_t __attribute__((ext_vector_type(4)));
__device__ __forceinline__ s16x4 trd(const LAS char* p) { return __builtin_bit_cast(s16x4, __builtin_amdgcn_ds_read_tr16_b64_v4i16((LAS v4i16_t*)p)); }
#define RET_FRAG(lo, hi) (bf16x8){lo[0], lo[1], lo[2], lo[3], hi[0], hi[1], hi[2], hi[3]}
__device__ __forceinline__ size_t kvs_index(int dir, int b, int cidx, int hd) { return ((((size_t)dir * NB + b) * NCH + cidx) * 4 + hd) * 8192; }

__device__ __forceinline__ void stage_v(const bf16_t* P, int row0, int hd, LAS char* vimg, int tid) {
#pragma unroll
    for (int i = 0; i < 4; ++i) { const int c = tid + 512 * i, j = c >> 4, ch = c & 15;
        const u32x4 v = *(const u32x4*)(P + (size_t)(row0 + j) * PC + 1280 + 128 * hd + 8 * ch);
        *(LAS u32x4*)(vimg + (j * RSV + 8 * ch) * 2) = v; }
}

struct KvLoad { u32x4 kw[2], vv[4]; };
__device__ __forceinline__ void kvinc_load(const bf16_t* P, int u, const int tid, KvLoad& L) {
    const int b = u / (4 * NCH), hd = (u / NCH) & 3, cidx = u % NCH, row0 = b * TPB + 128 * cidx;
#pragma unroll
    for (int i = 0; i < 2; ++i) { const int c = tid + 512 * i, j = c >> 3, ch = c & 7; L.kw[i] = *(const u32x4*)(P + (size_t)(row0 + j) * PC + 1024 + 64 * hd + 8 * ch); }
#pragma unroll
    for (int i = 0; i < 4; ++i) { const int c = tid + 512 * i, j = c >> 4, ch = c & 15; L.vv[i] = *(const u32x4*)(P + (size_t)(row0 + j) * PC + 1280 + 128 * hd + 8 * ch); }
}
__device__ __forceinline__ void kvinc_units(const bf16_t* P, float* KVS, const float* rc, int u0, int ustep, int nU, unsigned* cnt, unsigned* tmo, int wave_s, LAS char* lds, const int tid) {
    const int lane = tid & 63, wid = __builtin_amdgcn_readfirstlane(tid >> 6), r = lane & 31, hh = lane >> 5;
    LAS char* kimg0 = lds; LAS char* kimg1 = lds + 128 * RSK * 2; LAS char* vimg = lds + 2 * 128 * RSK * 2;
    int u = u0; if (u >= nU) return;
    ::wait_panel(cnt, tmo, 17 * (u / (4 * NCH)) + ((u % NCH) >> 1), wave_s, 24u);
    KvLoad L; kvinc_load(P, u, tid, L);
#pragma unroll 1
    for (;;) {
        const int b = u / (4 * NCH), hd = (u / NCH) & 3, cidx = u % NCH;
        const float lgf2 = rc[2 * hd], lgb2 = rc[8 + 2 * hd];
#pragma unroll
        for (int i = 0; i < 2; ++i) { const int c = tid + 512 * i, j = c >> 3, ch = c & 7;
            const float wf = __builtin_amdgcn_exp2f((float)(127 - j) * lgf2), wb = __builtin_amdgcn_exp2f((float)j * lgb2);
            f32x4 a, bq; pg8::unpack8(L.kw[i], a, bq);
            *(LAS u32x4*)(kimg0 + (j * RSK + 8 * ch) * 2) = pg8::pack8(a * wf, bq * wf);
            *(LAS u32x4*)(kimg1 + (j * RSK + 8 * ch) * 2) = pg8::pack8(a * wb, bq * wb); }
#pragma unroll
        for (int i = 0; i < 4; ++i) { const int c = tid + 512 * i, j = c >> 4, ch = c & 15; *(LAS u32x4*)(vimg + (j * RSV + 8 * ch) * 2) = L.vv[i]; }
        LDS_WAIT(); __syncthreads();
        const int un = u + ustep;
        if (un < nU) { ::wait_panel(cnt, tmo, 17 * (un / (4 * NCH)) + ((un % NCH) >> 1), wave_s, 24u); kvinc_load(P, un, tid, L); }
        const int dir = wid >> 2, eb = wid & 3;
        const LAS char* kimg = dir ? kimg1 : kimg0;
        const int q = (lane & 15) >> 2, p = lane & 3, c16 = 16 * ((lane >> 4) & 1) + 4 * p;
        f32x16 acc[2]; acc[0] = f32x16{}; acc[1] = f32x16{};
#pragma unroll
        for (int ks = 0; ks < 8; ++ks) {
            const int j0 = 16 * ks + 8 * hh + q;
            const s16x4 vlo = trd(vimg + (j0 * RSV + 32 * eb + c16) * 2), vhi = trd(vimg + ((j0 + 4) * RSV + 32 * eb + c16) * 2);
            const bf16x8 vf = RET_FRAG(vlo, vhi);
#pragma unroll
            for (int db = 0; db < 2; ++db) {
                const s16x4 klo = trd(kimg + (j0 * RSK + 32 * db + c16) * 2), khi = trd(kimg + ((j0 + 4) * RSK + 32 * db + c16) * 2);
                acc[db] = __builtin_amdgcn_mfma_f32_32x32x16_bf16(RET_FRAG(klo, khi), vf, acc[db], 0, 0, 0);
            }
        }
        float* out = KVS + kvs_index(dir, b, cidx, hd);
#pragma unroll
        for (int db = 0; db < 2; ++db)
#pragma unroll
            for (int reg = 0; reg < 16; ++reg) { const int d = 32 * db + (reg & 3) + 8 * (reg >> 2) + 4 * hh; out[d * 128 + 32 * eb + r] = acc[db][reg]; }
        __syncthreads();
        if (un >= nU) break;
        u = un;
    }
}

__device__ __forceinline__ void scan_phase(const float* KVS, bf16_t* KVB, const float* retc_l, int gtid, int gthreads) {
    for (int idx = gtid; idx < 2 * NB * 4 * 4096; idx += gthreads) {
        const int el = (idx & 4095) * 2, seq = idx >> 12, hd = seq & 3, b = (seq >> 2) & 3, dir = seq >> 4;
        const float dec = retc_l[(dir * 4 + hd) * 2 + 1];
        const size_t off = kvs_index(dir, b, 0, hd) + el;
        f32x2 v[NCH];
#pragma unroll
        for (int n = 0; n < NCH; ++n) { const int cidx = dir == 0 ? n : (n < 2 ? 1 - n : 35 - n); v[n] = *(const f32x2*)(KVS + off + (size_t)cidx * 4 * 8192); }
        f32x2 st = (f32x2){0.f, 0.f};
#pragma unroll
        for (int n = 0; n < NCH; ++n) { const int cidx = dir == 0 ? n : (n < 2 ? 1 - n : 35 - n); *(unsigned*)(KVB + off + (size_t)cidx * 4 * 8192) = pk2(st[0], st[1]); st = st * dec + v[n]; }
    }
}

struct RetLoad { u32x4 vv[4], kk[2]; u32x2 hv[2][4]; bf16x8 qr[4]; };
__device__ __forceinline__ void retout_load(const bf16_t* P, const bf16_t* KVS, int u, const int tid, RetLoad& L) {
    const int b = u / (4 * NCH), hd = (u / NCH) & 3, cidx = u % NCH;
    const int lane = tid & 63, wid = __builtin_amdgcn_readfirstlane(tid >> 6), r = lane & 31, hh = lane >> 5;
    const int row0 = b * TPB + 128 * cidx, ib = wid & 3;
#pragma unroll
    for (int i = 0; i < 4; ++i) { const int c = tid + 512 * i, j = c >> 4, ch = c & 15; L.vv[i] = *(const u32x4*)(P + (size_t)(row0 + j) * PC + 1280 + 128 * hd + 8 * ch); }
#pragma unroll
    for (int i = 0; i < 2; ++i) { const int c = tid + 512 * i, j = c >> 3, ch = c & 7; L.kk[i] = *(const u32x4*)(P + (size_t)(row0 + j) * PC + 1024 + 64 * hd + 8 * ch); }
#pragma unroll
    for (int dir = 0; dir < 2; ++dir) { const bf16_t* H = KVS + kvs_index(dir, b, cidx, hd);
#pragma unroll
        for (int i = 0; i < 4; ++i) { const int c = tid + 512 * i; L.hv[dir][i] = *(const u32x2*)(H + (c >> 5) * 128 + (c & 31) * 4); } }
    const int iloc = 32 * ib + r;
#pragma unroll
    for (int d0 = 0; d0 < 4; ++d0) L.qr[d0] = *(const bf16x8*)(P + (size_t)(row0 + iloc) * PC + 768 + 64 * hd + 16 * d0 + 8 * hh);
}
__device__ __forceinline__ void retout_units(const bf16_t* P, const bf16_t* KVS, bf16_t* Y3, const float* gainl, const float* rc, int u0, int ustep, int nU, bool skip_ctx, LAS char* lds, const int tid) {
    const int lane = tid & 63, wid = __builtin_amdgcn_readfirstlane(tid >> 6), r = lane & 31, hh = lane >> 5;
    const int ib = wid & 3, eh = wid >> 2;
    LAS char* vimg = lds; LAS char* himg0 = lds + 128 * RSV * 2; LAS char* himg1 = himg0 + 64 * RSV * 2; LAS char* kimg = himg1 + 64 * RSV * 2;
    LAS float* part1 = (LAS float*)(kimg + 128 * RSK * 2); LAS float* part2 = part1 + 256;
    const int nV = skip_ctx ? (nU / NCH) * (NCH - 2) : nU;
#define RET_UNIT_OF(v) (skip_ctx ? ((v) / (NCH - 2)) * NCH + 2 + (v) % (NCH - 2) : (v))
    int vi = u0; if (vi >= nV) return;
    int u = RET_UNIT_OF(vi);
    RetLoad L; retout_load(P, KVS, u, tid, L);
#pragma unroll 1
    for (;;) {
    const int b = u / (4 * NCH), hd = (u / NCH) & 3, cidx = u % NCH;
    const float lgf2 = rc[2 * hd], lgb2 = rc[8 + 2 * hd];
    const int row0 = b * TPB + 128 * cidx;
    const int iloc = 32 * ib + r;
    bf16x8 qr[4];
#pragma unroll
    for (int d0 = 0; d0 < 4; ++d0) qr[d0] = L.qr[d0];
#pragma unroll
    for (int i = 0; i < 4; ++i) { const int c = tid + 512 * i, j = c >> 4, ch = c & 15; *(LAS u32x4*)(vimg + (j * RSV + 8 * ch) * 2) = L.vv[i]; }
#pragma unroll
    for (int i = 0; i < 2; ++i) { const int c = tid + 512 * i, j = c >> 3, ch = c & 7; *(LAS u32x4*)(kimg + (j * RSK + 8 * ch) * 2) = L.kk[i]; }
#pragma unroll
    for (int dir = 0; dir < 2; ++dir) { LAS char* himg = dir ? himg1 : himg0;
#pragma unroll
        for (int i = 0; i < 4; ++i) { const int c = tid + 512 * i, d = c >> 5, e4 = (c & 31) * 4; *(LAS u32x2*)(himg + (d * RSV + e4) * 2) = L.hv[dir][i]; } }
    LDS_WAIT(); __syncthreads();
    const int vn = vi + ustep, un = RET_UNIT_OF(vn);
    if (vn < nV) retout_load(P, KVS, un, tid, L);
    const int q = (lane & 15) >> 2, p = lane & 3, c16 = 16 * ((lane >> 4) & 1) + 4 * p;
    f32x16 O[2]; O[0] = f32x16{}; O[1] = f32x16{};
#pragma unroll 2
    for (int jb = 0; jb < 4; ++jb) {
        f32x16 X = f32x16{};
#pragma unroll
        for (int d0 = 0; d0 < 4; ++d0) { const bf16x8 kf = *(const LAS bf16x8*)(kimg + ((32 * jb + r) * RSK + 16 * d0 + 8 * hh) * 2);
            X = __builtin_amdgcn_mfma_f32_32x32x16_bf16(kf, qr[d0], X, 0, 0, 0); }
#pragma unroll
        for (int reg = 0; reg < 16; ++reg) { const int jloc = 32 * jb + (reg & 3) + 8 * (reg >> 2) + 4 * hh, dl = iloc - jloc;
            const float w0 = __builtin_amdgcn_exp2f((float)dl * (dl > 0 ? lgf2 : -lgb2));
            X[reg] *= (dl == 0) ? 2.0f : w0; }
        u32x4 pw[2];
        pw[0] = (u32x4){pk2(X[0], X[1]), pk2(X[2], X[3]), pk2(X[4], X[5]), pk2(X[6], X[7])};
        pw[1] = (u32x4){pk2(X[8], X[9]), pk2(X[10], X[11]), pk2(X[12], X[13]), pk2(X[14], X[15])};
#pragma unroll
        for (int s = 0; s < 2; ++s) { const int j0 = 32 * jb + 16 * s + 4 * hh + q;
#pragma unroll
            for (int eb = 0; eb < 2; ++eb) { const int ec = 32 * (2 * eh + eb) + c16;
                const s16x4 lo = trd(vimg + (j0 * RSV + ec) * 2), hi = trd(vimg + ((j0 + 8) * RSV + ec) * 2);
                O[eb] = __builtin_amdgcn_mfma_f32_32x32x16_bf16(__builtin_bit_cast(bf16x8, pw[s]), RET_FRAG(lo, hi), O[eb], 0, 0, 0); } }
    }
#pragma unroll
    for (int dir = 0; dir < 2; ++dir) {
        const float fac = dir == 0 ? __builtin_amdgcn_exp2f((float)(iloc + 1) * lgf2) : __builtin_amdgcn_exp2f((float)(128 - iloc) * lgb2);
        const LAS char* himg = dir ? himg1 : himg0;
#pragma unroll
        for (int d0 = 0; d0 < 4; ++d0) {
            f32x4 a, bq; pg8::unpack8(__builtin_bit_cast(u32x4, qr[d0]), a, bq);
            const u32x4 qs = (u32x4){pk2(a[0] * fac, a[1] * fac), pk2(a[2] * fac, a[3] * fac), pk2(bq[0] * fac, bq[1] * fac), pk2(bq[2] * fac, bq[3] * fac)};
            const int dd0 = 16 * d0 + 8 * hh + q;
#pragma unroll
            for (int eb = 0; eb < 2; ++eb) { const int ec = 32 * (2 * eh + eb) + c16;
                const s16x4 lo = trd(himg + (dd0 * RSV + ec) * 2), hi = trd(himg + ((dd0 + 4) * RSV + ec) * 2);
                O[eb] = __builtin_amdgcn_mfma_f32_32x32x16_bf16(__builtin_bit_cast(bf16x8, qs), RET_FRAG(lo, hi), O[eb], 0, 0, 0); } }
    }
    u32x4 sgv[4]; f32x4 gn0[4], gn1[4];
#pragma unroll
    for (int i = 0; i < 4; ++i) { const int c = tid + 512 * i, row = c >> 4, ch = c & 15;
        sgv[i] = *(const u32x4*)(P + (size_t)(row0 + row) * PC + 1792 + 128 * hd + 8 * ch);
        gn0[i] = *(const f32x4*)(gainl + 128 * hd + 8 * ch); gn1[i] = *(const f32x4*)(gainl + 128 * hd + 8 * ch + 4); }
    float mean[16], rstd[16];
#pragma unroll
    for (int reg = 0; reg < 16; ++reg) mean[reg] = half_sum(O[0][reg] + O[1][reg]);
    if (r == 0) {
#pragma unroll
        for (int reg = 0; reg < 16; ++reg) part1[eh * 128 + 32 * ib + (reg & 3) + 8 * (reg >> 2) + 4 * hh] = mean[reg]; }
    LDS_WAIT(); __syncthreads();
#pragma unroll
    for (int reg = 0; reg < 16; ++reg) { const int i = 32 * ib + (reg & 3) + 8 * (reg >> 2) + 4 * hh; mean[reg] = (part1[i] + part1[128 + i]) * (1.0f / 128.0f); }
#pragma unroll
    for (int reg = 0; reg < 16; ++reg) { const float d0 = O[0][reg] - mean[reg], d1 = O[1][reg] - mean[reg]; rstd[reg] = half_sum(d0 * d0 + d1 * d1); }
    if (r == 0) {
#pragma unroll
        for (int reg = 0; reg < 16; ++reg) part2[eh * 128 + 32 * ib + (reg & 3) + 8 * (reg >> 2) + 4 * hh] = rstd[reg]; }
    LDS_WAIT(); __syncthreads();
#pragma unroll
    for (int reg = 0; reg < 16; ++reg) { const int i = 32 * ib + (reg & 3) + 8 * (reg >> 2) + 4 * hh; rstd[reg] = rsqrtf((part2[i] + part2[128 + i]) * (1.0f / 128.0f) + EPS); }
    LAS bf16_t* yimg = (LAS bf16_t*)vimg;
#pragma unroll
    for (int eb = 0; eb < 2; ++eb) { const int e = 32 * (2 * eh + eb) + r;
#pragma unroll
        for (int reg = 0; reg < 16; ++reg) { const int i = 32 * ib + (reg & 3) + 8 * (reg >> 2) + 4 * hh; yimg[i * RSV + e] = (bf16_t)f2bf((O[eb][reg] - mean[reg]) * rstd[reg]); } }
    LDS_WAIT(); __syncthreads();
#pragma unroll
    for (int i = 0; i < 4; ++i) { const int c = tid + 512 * i, row = c >> 4, ch = c & 15;
        const u32x4 yv = *(const LAS u32x4*)(vimg + (row * RSV + 8 * ch) * 2);
        f32x4 ya, yb, sa, sb; pg8::unpack8(yv, ya, yb); pg8::unpack8(sgv[i], sa, sb);
        *(u32x4*)(Y3 + (size_t)(row0 + row) * 1536 + 512 + 128 * hd + 8 * ch) = pg8::pack8(ya * gn0[i] * sa, yb * gn1[i] * sb); }
    LDS_WAIT(); __syncthreads();
    if (vn >= nV) break;
    vi = vn; u = un;
    }
#undef RET_UNIT_OF
}
}
struct MatD { const float* src; bf16_t* dst; int K, N, mode, nitems, ldd; float q8; };
__device__ __forceinline__ MatD mat_desc(int id, unsigned char* ws) {
    MatD m;
    if (id < 4) { m.src = KIN(I_w_in) + (size_t)id * D * INC; m.K = D; m.N = INC; m.dst = WSP(bf16_t, WS_WIN) + (size_t)id * INC * D; m.mode = 1; }
    else if (id < 16) { const int q = id - 4, l = q / 3, br = q - 3 * l; m.src = KIN(I_w_br_a + br) + (size_t)l * 512 * D; m.K = 512; m.N = D; m.dst = WSP(bf16_t, WS_WBR) + (size_t)l * D * 1536 + br * 512; m.mode = 0; }
    else if (id < 20) { const int l = id - 16; m.src = KIN(I_w_out) + (size_t)l * D * D; m.K = D; m.N = D; m.dst = WSP(bf16_t, WS_WOUT) + (size_t)l * D * D; m.mode = 0; }
    else if (id < 24) { const int q = id - 20, j = q >> 1, wh = q & 1; m.src = KIN(wh ? I_ffn_w3 : I_ffn_w1) + (size_t)j * D * DFF; m.K = D; m.N = DFF; m.dst = WSP(bf16_t, WS_W13) + (size_t)j * 2 * DFF * D; m.mode = 2 + wh; }
    else if (id < 26) { const int j = id - 24; m.src = KIN(I_ffn_w2) + (size_t)j * DFF * D; m.K = DFF; m.N = D; m.dst = WSP(bf16_t, WS_W2) + (size_t)j * D * DFF; m.mode = 0; }
    else if (id < 58) { const int q = id - 26, je = q >> 1, wh = q & 1; m.src = KIN(wh ? I_exp_w3 : I_exp_w1) + (size_t)je * D * DFE; m.K = D; m.N = DFE; m.dst = (bf16_t*)(ws + WS_E13 + (size_t)je * 2 * DFE * D); m.mode = 2 + wh; }
    else { const int je = id - 58; m.src = KIN(I_exp_w2) + (size_t)je * DFE * D; m.K = DFE; m.N = D; m.dst = (bf16_t*)(ws + WS_E2 + (size_t)je * D * DFE); m.mode = 0; }
    m.nitems = (m.K / 64) * (m.N / 32); m.ldd = (id >= 4 && id < 16) ? 1536 : m.K; m.q8 = id >= 58 ? FP8_SC_W2 : (id >= 26 ? FP8_SC_W13 : 0.f);
    return m;
}
struct ItemRef { const float* src; bf16_t* dst; int K, N, ldd; float q8; };
struct ItemIt { int id, id_end, base, g, W; };
__device__ __forceinline__ bool item_next(ItemIt& it, unsigned char* ws, ItemRef& r) {
    while (it.id < it.id_end) { const MatD m = mat_desc(it.id, ws);
        if (it.g < it.base + m.nitems) { const int item = it.g - it.base; it.g += it.W;
            const int nblk = m.N / 32, kb = item / nblk, nb = item - kb * nblk, k0 = 64 * kb, n0 = 32 * nb;
            int drow0 = n0;
            if (m.mode == 1) { const int T = n0 >> 8, cl = n0 & 255; const bool head = (T <= 4) || (T >= 9 && T <= 11); if (head) drow0 = 256 * T + 128 * ((cl >> 5) & 1) + 32 * (cl >> 6); }
            else if (m.mode >= 2) { drow0 = 256 * (n0 >> 7) + 128 * (m.mode - 2) + (n0 & 127); }
            r.src = m.src + (size_t)k0 * m.N + n0; r.q8 = m.q8; r.dst = m.q8 > 0.f ? (bf16_t*)((unsigned char*)m.dst + (size_t)drow0 * m.ldd + k0) : m.dst + (size_t)drow0 * m.ldd + k0; r.K = m.K; r.N = m.N; r.ldd = m.ldd;
            if (m.mode == 1 && ((g1_mask(it.id) >> (n0 >> 8)) & 1u)) { r.q8 = FP8_SC_WG; r.dst = (bf16_t*)((unsigned char*)m.dst + WG8_OFF + (size_t)drow0 * D + k0); }
            return true; }
        it.base += m.nitems; ++it.id; }
    return false;
}
__device__ __forceinline__ void tr_load(const ItemRef& r, float (&v)[32], int lane) {
    const float* p = r.src + (size_t)(lane >> 5) * r.N + (lane & 31);
#pragma unroll
    for (int i = 0; i < 32; ++i) v[i] = __builtin_nontemporal_load(p + (size_t)(2 * i) * r.N);
}
__device__ __forceinline__ void tr_store(const ItemRef& r, const float (&v)[32], LAS float* scr, int lane) {
#pragma unroll
    for (int i = 0; i < 32; ++i) { const int kk = 2 * i + (lane >> 5); scr[kk * 33 + (lane & 31)] = v[i]; }
    LDS_WAIT(); asm volatile("" ::: "memory");
    if (r.q8 > 0.f) {
#pragma unroll
        for (int jj = 0; jj < 2; ++jj) { const int ch = lane + 64 * jj, n = ch >> 2, c4 = ch & 3; const LAS float* s = scr + (16 * c4) * 33 + n; float e[16];
#pragma unroll
            for (int x = 0; x < 16; ++x) e[x] = s[x * 33] * r.q8;
            u32x4 o; o.x = pk4_fp8(e[0], e[1], e[2], e[3]); o.y = pk4_fp8(e[4], e[5], e[6], e[7]); o.z = pk4_fp8(e[8], e[9], e[10], e[11]); o.w = pk4_fp8(e[12], e[13], e[14], e[15]);
            *(u32x4*)((unsigned char*)r.dst + (size_t)n * r.ldd + 16 * c4) = o; }
        LDS_WAIT(); asm volatile("" ::: "memory");
        return;
    }
    const int c = lane & 7;
#pragma unroll
    for (int j = 0; j < 4; ++j) { const int n = (lane >> 3) + 8 * j; const LAS float* s = scr + (8 * c) * 33 + n;
        u32x4 o; o.x = pg8::cvt_pk_bf16(s[0 * 33], s[1 * 33]); o.y = pg8::cvt_pk_bf16(s[2 * 33], s[3 * 33]); o.z = pg8::cvt_pk_bf16(s[4 * 33], s[5 * 33]); o.w = pg8::cvt_pk_bf16(s[6 * 33], s[7 * 33]);
        *(u32x4*)(r.dst + (size_t)n * r.ldd + 8 * c) = o; }
    LDS_WAIT(); asm volatile("" ::: "memory");
}
__device__ __forceinline__ void convert_mats(unsigned char* ws, LAS unsigned char* lds, int rank, int nrank, int wave, int lane, int id0, int id1) {
    LAS float* scr = (LAS float*)(lds + wave * 8704);
    ItemIt it{id0, id1, 0, rank * NWAVES + wave, nrank * NWAVES};
    ItemRef ra, rb; float va[32], vb[32];
    bool ha = item_next(it, ws, ra);
    if (ha) tr_load(ra, va, lane);
#pragma unroll 1
    while (ha) {
        const bool hb = item_next(it, ws, rb);
        if (hb) tr_load(rb, vb, lane);
        tr_store(ra, va, scr, lane);
        if (!hb) break;
        ha = item_next(it, ws, ra);
        if (ha) tr_load(ra, va, lane);
        tr_store(rb, vb, scr, lane);
    }
}

struct Ptrs {
    const float *x, *c, *ctx, *c_ctx, *w_ada, *b_ada, *norm1_g, *norm2_g, *final_g, *w_in, *b_gate, *qn_a, *kn_a, *ret_a, *ret_g, *sink_c,
                *w_br_a, *w_br_b, *w_br_c, *w_out, *ffn_w1, *ffn_w3, *ffn_w2, *router_w, *router_b, *exp_w1, *exp_w3, *exp_w2;
};

__device__ __forceinline__ void prologue_phase(const Ptrs& I, unsigned char* ws, LAS unsigned char* lds, int tid, int lane, int wave, int G) {
    LAS float* sv = (LAS float*)(lds + 69632);
    LAS float* part = (LAS float*)(lds + 69632 + 20480);
    for (int i = tid; i < 5 * 1024; i += NTHR) { const int who = i >> 10, k = i & 1023; const float cv = who < 4 ? I.c[who * 1024 + k] : I.c_ctx[k]; sv[i] = siluf_(cv); }
    LDS_WAIT(); __syncthreads();
    float* MODS = (float*)(ws + WS_MODS);
#ifdef DUP_MODS
    for (int rep = 0; rep < 2; ++rep)
#endif
    for (int it = blockIdx.x; it < DEPTH * 48; it += G) {
        const int l = it / 48, cg = it % 48, col = cg * 128 + 2 * lane;
        const float* wp = I.w_ada + ((size_t)l * 1024 + wave * 128) * INC + col;
        f32x2 a0 = {0.f, 0.f}, a1 = a0, a2 = a0, a3 = a0, a4 = a0;
#pragma unroll 16
        for (int k = 0; k < 128; ++k) { const f32x2 w = *(const f32x2*)(wp + (size_t)k * INC); const int kk = wave * 128 + k;
            a0 += sv[kk] * w; a1 += sv[1024 + kk] * w; a2 += sv[2048 + kk] * w; a3 += sv[3072 + kk] * w; a4 += sv[4096 + kk] * w; }
        *(LAS f32x2*)(part + (wave * 5 + 0) * 128 + 2 * lane) = a0; *(LAS f32x2*)(part + (wave * 5 + 1) * 128 + 2 * lane) = a1; *(LAS f32x2*)(part + (wave * 5 + 2) * 128 + 2 * lane) = a2;
        *(LAS f32x2*)(part + (wave * 5 + 3) * 128 + 2 * lane) = a3; *(LAS f32x2*)(part + (wave * 5 + 4) * 128 + 2 * lane) = a4;
        LDS_WAIT(); __syncthreads();
        for (int o = tid; o < 640; o += NTHR) { const int who = o >> 7, ln = o & 127; float s = I.b_ada[(size_t)l * INC + cg * 128 + ln];
#pragma unroll
            for (int w = 0; w < 8; ++w) s += part[(w * 5 + who) * 128 + ln];
            MODS[((size_t)l * 5 + who) * INC + cg * 128 + ln] = s; }
        __syncthreads();
    }
    if (blockIdx.x == G - 1) { float* R = (float*)(ws + WS_ROPE);
        for (int i = tid; i < 1024; i += NTHR) { const int pos = i >> 4, f = i & 15; const float inv = powf(10000.0f, -(float)f / 16.0f); const float ang = (float)pos * inv; R[2 * i] = cosf(ang); R[2 * i + 1] = sinf(ang); } }
    if (blockIdx.x == (G > 1 ? G - 2 : 0) && tid < DEPTH * 8) { float* RC = (float*)(ws + WS_RETC); const float a = I.ret_a[tid]; const float lg = -log1pf(expf(-a)); RC[2 * tid] = lg * LOG2E; RC[2 * tid + 1] = expf(128.0f * lg); }
    convert_mats(ws, lds, blockIdx.x, G, wave, lane, 0, 74);
}

struct NormArgs {
    const float* g; const float* shift; const float* scale;
    const float* gate2p; const bf16_t* Y; const int* DST;
    const LAS float* rw; const float* rb; LAS int* route; int* PE; float* PW;
    unsigned char* hn8;
};
struct RowJob { const float* src; const bf16_t* srcb; bf16_t* xs_out; bf16_t* hn; int row; NormArgs A; };
struct RowData { u32x4 x[4]; u32x2 y0[4], y1[4]; };
struct NormStat { f32x4 am[4], sh[4], gt[4]; const float* key; };
template <bool COMB> __device__ __forceinline__ void norm_idx(const RowJob& J, int (&d)[2]) { if constexpr (COMB) { d[0] = J.A.DST[2 * J.row]; d[1] = J.A.DST[2 * J.row + 1]; } }
template <bool SRC32, bool COMB> __device__ __forceinline__ void norm_load(const RowJob& J, const int (&d)[2], RowData& R, int lane) {
#pragma unroll
    for (int j = 0; j < 4; ++j) { const int c = 4 * lane + 256 * j;
        if constexpr (SRC32) R.x[j] = *(const u32x4*)(J.src + c); else { const u32x2 t = *(const u32x2*)(J.srcb + c); R.x[j].x = t.x; R.x[j].y = t.y; } }
    if constexpr (COMB) {
#pragma unroll
        for (int j = 0; j < 4; ++j) { const int c = 4 * lane + 256 * j; R.y0[j] = *(const u32x2*)(J.A.Y + (size_t)d[0] * D + c); R.y1[j] = *(const u32x2*)(J.A.Y + (size_t)d[1] * D + c); } }
}
template <bool COMB> __device__ __forceinline__ void norm_stat_build(const RowJob& J, const f32x4 (&gq)[4], NormStat& S, int lane) {
#pragma unroll
    for (int j = 0; j < 4; ++j) { const int c = 4 * lane + 256 * j; const f32x4 sc = *(const f32x4*)(J.A.scale + c); S.sh[j] = *(const f32x4*)(J.A.shift + c); S.am[j] = gq[j] * (sc + 1.0f);
        if constexpr (COMB) S.gt[j] = *(const f32x4*)(J.A.gate2p + c); }
    S.key = J.A.shift;
}
template <bool SRC32, bool COMB> __device__ __forceinline__ void norm_finish(const RowJob& J, const RowData& R, const NormStat& S, int lane) {
    const NormArgs& A = J.A; const int row = J.row; bf16_t* xs_out = J.xs_out; bf16_t* hn = J.hn;
    f32x4 v[4]; float ss = 0.f;
#pragma unroll
    for (int j = 0; j < 4; ++j) { if constexpr (SRC32) v[j] = __builtin_bit_cast(f32x4, R.x[j]); else v[j] = (f32x4){bflo(R.x[j].x), bfhi(R.x[j].x), bflo(R.x[j].y), bfhi(R.x[j].y)}; }
    if constexpr (COMB) {
#pragma unroll
        for (int j = 0; j < 4; ++j) { const u32x2 y0 = R.y0[j], y1 = R.y1[j]; const f32x4 gt = S.gt[j];
            v[j][0] += gt[0] * (bflo(y0.x) + bflo(y1.x)); v[j][1] += gt[1] * (bfhi(y0.x) + bfhi(y1.x)); v[j][2] += gt[2] * (bflo(y0.y) + bflo(y1.y)); v[j][3] += gt[3] * (bfhi(y0.y) + bfhi(y1.y)); } }
    if (xs_out) {
#pragma unroll
        for (int j = 0; j < 4; ++j) { u32x2 w; w.x = pk2(v[j][0], v[j][1]); w.y = pk2(v[j][2], v[j][3]); *(u32x2*)(xs_out + 4 * lane + 256 * j) = w; } }
#pragma unroll
    for (int j = 0; j < 4; ++j) ss += (v[j][0] * v[j][0] + v[j][1] * v[j][1]) + (v[j][2] * v[j][2] + v[j][3] * v[j][3]);
    const float rs = rsqrtf(wave_sum(ss) * (1.0f / D) + EPS);
    float lg[8];
#pragma unroll
    for (int e = 0; e < 8; ++e) lg[e] = 0.f;
#pragma unroll
    for (int j = 0; j < 4; ++j) { const int c = 4 * lane + 256 * j;
        f32x4 h = v[j] * rs * S.am[j] + S.sh[j];
        if (hn) { u32x2 w; w.x = pk2(h[0], h[1]); w.y = pk2(h[2], h[3]); *(u32x2*)(hn + c) = w; }
        if (A.hn8) { const f32x4 q = h * FP8_SC_X; *(unsigned*)(A.hn8 + c) = pk4_fp8(q[0], q[1], q[2], q[3]); }
        if (A.rw) {
#pragma unroll
            for (int e = 0; e < 8; ++e) { const f32x4 r = *(const LAS f32x4*)(A.rw + e * 1024 + c); lg[e] += (h[0] * r[0] + h[1] * r[1]) + (h[2] * r[2] + h[3] * r[3]); } } }
    if (A.rw) {
#pragma unroll
        for (int e = 0; e < 8; ++e) lg[e] = wave_sum(lg[e]) + A.rb[e];
        int i1 = 0; float v1 = lg[0];
#pragma unroll
        for (int e = 1; e < 8; ++e) if (lg[e] > v1) { v1 = lg[e]; i1 = e; }
        int i2 = -1; float v2 = -INFINITY;
#pragma unroll
        for (int e = 0; e < 8; ++e) if (e != i1 && lg[e] > v2) { v2 = lg[e]; i2 = e; }
        if (i2 < 0) i2 = (i1 + 1) & 7;
        if (lane == 0) { const float w1 = 1.0f / (1.0f + __expf(v2 - v1));
            A.route[0] = i1; A.route[1] = i2;
            A.PE[2 * row] = i1; A.PE[2 * row + 1] = i2; A.PW[2 * row] = w1; A.PW[2 * row + 1] = 1.0f - w1; }
    }
}
template <bool SRC32, bool COMB, class F> __device__ __forceinline__ void norm_rows(int first, int stride, int end, const F& f, int lane) {
    if (first >= end) return;
    RowJob J, Jt; RowData A, B, C; NormStat S; int dn[2] = {0, 0};
    f(first, J);
    f32x4 gq[4];
#pragma unroll
    for (int j = 0; j < 4; ++j) gq[j] = *(const f32x4*)(J.A.g + 4 * lane + 256 * j);
    norm_stat_build<COMB>(J, gq, S, lane);
    norm_idx<COMB>(J, dn); norm_load<SRC32, COMB>(J, dn, A, lane);
    if (first + stride < end) { f(first + stride, Jt); norm_idx<COMB>(Jt, dn); norm_load<SRC32, COMB>(Jt, dn, B, lane); }
    { const int ri = first + 2 * stride < end ? first + 2 * stride : end - 1; f(ri, Jt); norm_idx<COMB>(Jt, dn); }
    int r = first;
#define NR_STEP(LD, FIN, k) { const int rl = r + ((k) + 2) * stride, rf = r + (k) * stride; \
        if (rl < end) { f(rl, Jt); norm_load<SRC32, COMB>(Jt, dn, LD, lane); } \
        if constexpr (COMB) { const int ri = rl + stride < end ? rl + stride : end - 1; f(ri, Jt); norm_idx<COMB>(Jt, dn); }     \
        f(rf, J); if (J.A.shift != S.key) norm_stat_build<COMB>(J, gq, S, lane); norm_finish<SRC32, COMB>(J, FIN, S, lane); \
        if (rf + stride >= end) break; }
#pragma unroll 1
    for (;;) {
        NR_STEP(C, A, 0)
        NR_STEP(A, B, 1)
        NR_STEP(B, C, 2)
        r += 3 * stride;
    }
#undef NR_STEP
}
struct SchedPlain {
    const char* A; const char* B; size_t aTile, bTile; int nM, nN, G, c; bool latOnly; int ntk, lda, ldb;
    __device__ __forceinline__ void a_ready(const pg8::Unit&) const {}
    __device__ __forceinline__ void done(const pg8::Unit&, int) const {}
    __device__ __forceinline__ bool next(int i, pg8::Unit& u) const {
        int pm, pn; if (!pg8::tile_of((long)i * G + c, nM, nN, pm, pn)) return false;
        if (latOnly) pm = pm + pm / 16 + 1;
        u.pm = pm; u.pn = pn; u.aux = 0; u.ntk = ntk; u.mode = 0; u.peer = 0; u.kt0 = 0; u.kind = 0; u.lda = lda; u.ldb = ldb; u.A = A + (size_t)pm * aTile; u.B = B + (size_t)pn * bTile; return true; }
};
template <int KIND> struct SchedG1 {
    const char* A; const char* B; int nM, G, c; unsigned mask; unsigned* cnt;
    __device__ __forceinline__ bool next(int i, pg8::Unit& u) const {
        const unsigned mk = KIND ? mask : (~mask & 0xFFFFFFu), mkA = mk & 0x70u, mkB = mk & ~0x70u;
        const int nA = __builtin_popcount(mkA), nB = __builtin_popcount(mkB); const long L = (long)i * G + (KIND ? G - 1 - c : c), LA = (long)nM * nA;
        int pm, j, pn;
        if (L < LA) { pg8::tile_of(L, nM, nA, pm, j); pn = nth_bit(mkA, j); }
        else { if (nB == 0 || !pg8::tile_of(L - LA, nM, nB, pm, j)) return false; pn = nth_bit(mkB, j); }
        u.pm = pm; u.pn = pn; u.aux = 0; u.mode = 0; u.peer = 0; u.kt0 = 0; u.kind = 0;
        if (KIND) { u.ntk = D / 128; u.lda = D / 2; u.ldb = D / 2; u.A = A + (size_t)pm * (256 * D); u.B = B + (size_t)pn * (256 * D); }
        else { u.ntk = D / 64; u.lda = D; u.ldb = D; u.A = A + (size_t)pm * (256 * D * 2); u.B = B + (size_t)pn * (256 * D * 2); }
        return true; }
    __device__ __forceinline__ void a_ready(const pg8::Unit&) const {}
    __device__ __forceinline__ void done(const pg8::Unit& u, int lane) const {
        if (u.pn >= 4 && u.pn <= 6) { asm volatile("s_waitcnt vmcnt(0)" ::: "memory"); if (lane == 0) __hip_atomic_fetch_add(cnt + 32 * u.pm, 1u, __ATOMIC_RELAXED, __HIP_MEMORY_SCOPE_AGENT); } }
};
struct SchedMoE {
    const char* A; const char* B; size_t aTile, bTile, eStride; int nM, nN, G, c; int ts1, ts2, ts3, ts4, ts5, ts6, ts7; int ntk, lda, ldb;
    __device__ __forceinline__ void a_ready(const pg8::Unit&) const {}
    __device__ __forceinline__ void done(const pg8::Unit&, int) const {}
    __device__ __forceinline__ bool next(int i, pg8::Unit& u) const {
        int pm, pn; if (!pg8::tile_of((long)i * G + c, nM, nN, pm, pn)) return false;
        const int e = (pm >= ts1) + (pm >= ts2) + (pm >= ts3) + (pm >= ts4) + (pm >= ts5) + (pm >= ts6) + (pm >= ts7);
        u.pm = pm; u.pn = pn; u.aux = e; u.ntk = ntk; u.mode = 0; u.peer = 0; u.kt0 = 0; u.kind = 0; u.lda = lda; u.ldb = ldb; u.A = A + (size_t)pm * aTile; u.B = B + (size_t)e * eStride + (size_t)pn * bTile; return true; }
};
template <int P> struct SchedSK {
    const char* A; const char* B; size_t aTile, bTile, eStride; int U, G, vc; bool latOnly; int ts1, ts2, ts3, ts4, ts5, ts6, ts7; int s, e; int lda, ldb;
    __device__ __forceinline__ void a_ready(const pg8::Unit&) const {}
    __device__ __forceinline__ void done(const pg8::Unit&, int) const {}
    __device__ __forceinline__ int bound(int c) const { const unsigned b = (unsigned)c * (unsigned)(U * P) / (unsigned)G; int u = (int)(b / (unsigned)P), o = (int)b - u * P; if (o < 2) o = 0; else if (o > P - 2) { o = 0; ++u; } return u * P + o; }
    __device__ __forceinline__ void init() { s = bound(vc); e = bound(vc + 1); }
    __device__ __forceinline__ bool next(int i, pg8::Unit& u) const {
        const int u0 = s / P, un = u0 + i, st = (i == 0) ? s : un * P; if (st >= e) return false;
        const int uend = (un + 1) * P, en = e < uend ? e : uend, o = st - un * P, oe = en - un * P;
        u.mode = (o > 0) ? 2 : (oe < P ? 1 : 0); u.peer = vc + 1; u.ntk = 2 * (oe - o); u.kt0 = 2 * o; u.kind = 0; u.lda = lda; u.ldb = ldb;
        const int nP = U >> 2; const int pn = un / nP; int pm = un - pn * nP;
        const int ex = (pm >= ts1) + (pm >= ts2) + (pm >= ts3) + (pm >= ts4) + (pm >= ts5) + (pm >= ts6) + (pm >= ts7);
        if (latOnly) pm = pm + pm / 16 + 1;
        u.pm = pm; u.pn = pn; u.aux = ex; u.A = A + (size_t)pm * aTile + (size_t)o * 256; u.B = B + (size_t)ex * eStride + (size_t)pn * bTile + (size_t)o * 256; return true; }
};

template <int P> struct SchedWR {
    const char* A; const char* B; size_t aTile, bTile, eStride; int nP  , G, c; bool latOnly; int ts1, ts2, ts3, ts4, ts5, ts6, ts7; int lda, ldb;
    __device__ __forceinline__ void a_ready(const pg8::Unit&) const {}
    __device__ __forceinline__ void done(const pg8::Unit&, int) const {}
    __device__ __forceinline__ bool next(int i, pg8::Unit& u) const {
        const int U = nP * 4, R = U / G, rem = U - R * G; int p, q = -1;
        const int S = (P >= 16 && 4 * rem <= G) ? 4 : 2;
        if (i < R) p = i * G + c;
        else if (i == R && 2 * rem <= G) { if (c >= S * rem) return false; p = R * G + c / S; q = c % S; }
        else if (i == R) { p = R * G + c; if (p >= U) return false; }
        else return false;
        int pm, pn; pg8::tile_of((long)p, nP, 4, pm, pn);
        const int ex = (pm >= ts1) + (pm >= ts2) + (pm >= ts3) + (pm >= ts4) + (pm >= ts5) + (pm >= ts6) + (pm >= ts7);
        if (latOnly) pm = pm + pm / 16 + 1;
        const int base = P / S, extra = P % S;
        const int o = q < 0 ? 0 : q * base + (q < extra ? q : extra), np = q < 0 ? P : base + (q < extra ? 1 : 0);
        u.pm = pm; u.pn = pn; u.aux = ex; u.kind = 0; u.lda = lda; u.ldb = ldb; u.peer = c + 1; u.mode = q < 0 ? 0 : (q == 0 ? (S == 2 ? 1 : S) : 2); u.kt0 = 2 * o; u.ntk = 2 * np;
        u.A = A + (size_t)pm * aTile + (size_t)o * 256; u.B = B + (size_t)ex * eStride + (size_t)pn * bTile + (size_t)o * 256; return true; }
};
struct SchedM1 {
    const char* Y3; const char* WBR; unsigned* cnt; int c; bool ctx;
    __device__ __forceinline__ bool next(int i, pg8::Unit& u) const {
        int pm, pn;
        if (i == 0) { if (!pg8::tile_of((long)c, 64, 4, pm, pn)) return false; pm = pm + pm / 16 + 1; u.mode = 0; u.kt0 = 0; u.ntk = 24; }
        else if (i == 1 && ctx && c < 48) { const int e = c / 3, br = c - 3 * e; pm = 17 * (e >> 2); pn = e & 3; u.mode = br == 0 ? 3 : 2; u.kt0 = 8 * br; u.ntk = 8; }
        else return false;
        u.pm = pm; u.pn = pn; u.aux = 0; u.kind = 0; u.lda = 1536; u.ldb = 1536; u.peer = c + 1;
        u.A = Y3 + (size_t)pm * (256 * 1536 * 2) + (size_t)u.kt0 * 128; u.B = WBR + (size_t)pn * (256 * 1536 * 2) + (size_t)u.kt0 * 128; return true; }
    __device__ __forceinline__ void a_ready(const pg8::Unit&) const {}
    __device__ __forceinline__ void done(const pg8::Unit& u, int lane) const {
        asm volatile("s_waitcnt vmcnt(0)" ::: "memory"); if (lane == 0) __hip_atomic_fetch_add(cnt + 32 * u.pm, 1u, __ATOMIC_RELAXED, __HIP_MEMORY_SCOPE_AGENT); }
};
struct SchedM2One {
    const char* MB; const char* WOUT; int c; bool ctx; int which;
    __device__ __forceinline__ bool unit(pg8::Unit& u) const {
        int pm, pn;
        if (which == 1) { if (!pg8::tile_of((long)((c + 32) & 255), 64, 4, pm, pn)) return false; pm = pm + pm / 16 + 1; u.mode = 0; u.kt0 = 0; u.ntk = 16; }
        else if (ctx && c >= 224 && c < 256) { const int q = c - 224, e = q >> 1, half = q & 1; pm = 17 * (e >> 2); pn = e & 3; u.mode = half == 0 ? 1 : 2; u.kt0 = 8 * half; u.ntk = 8; }
        else return false;
        u.pm = pm; u.pn = pn; u.aux = 0; u.peer = c + 1; u.kind = 0; u.lda = 1024; u.ldb = 1024;
        u.A = MB + (size_t)pm * (256 * 1024 * 2) + (size_t)u.kt0 * 128; u.B = WOUT + (size_t)pn * (256 * 1024 * 2) + (size_t)u.kt0 * 128; return true; }
    __device__ __forceinline__ bool next(int i, pg8::Unit& u) const { return i == 0 && unit(u); }
    __device__ __forceinline__ void a_ready(const pg8::Unit&) const {}
    __device__ __forceinline__ void done(const pg8::Unit&, int) const {}
};
__device__ __forceinline__ void wait_panel(unsigned* cnt, unsigned* tmo, int pm, int wave_s, unsigned need) {
    if (wave_s == 0) { unsigned spins = 0;
        while ((unsigned)__builtin_amdgcn_readfirstlane(__hip_atomic_load(cnt + 32 * pm, __ATOMIC_RELAXED, __HIP_MEMORY_SCOPE_AGENT)) < need) {
            __builtin_amdgcn_s_sleep(1);
            if (++spins > (1u << 18)) { __hip_atomic_store(tmo, 1u, __ATOMIC_RELAXED, __HIP_MEMORY_SCOPE_AGENT); break; } }
        __builtin_amdgcn_fence(__ATOMIC_ACQUIRE, "agent");
        asm volatile("s_waitcnt vmcnt(0)" ::: "memory"); }
    __syncthreads();
}

struct Args { Ptrs in; float* out; unsigned char* ws; };
static_assert(sizeof(Args) == 30 * 8, "Args layout");
__global__ void __launch_bounds__(NTHR, 2) fwd_kernel(Args) {
    extern __shared__ __attribute__((aligned(16))) unsigned char lds_raw[];
    LAS unsigned char* lds = (LAS unsigned char*)lds_raw;
    volatile LAS unsigned* MISC = (volatile LAS unsigned*)(lds + MISC_OFF);
    const int G = gridDim.x, bx = blockIdx.x, wave_s = __builtin_amdgcn_readfirstlane((int)threadIdx.x >> 6);
#define PHASE_IDS() const int tid = fresh_tid(wave_s), lane = tid & 63, wave = __builtin_amdgcn_readfirstlane(tid >> 6), gw = bx * NWAVES + wave, NGW = G * NWAVES; (void)lane; (void)gw; (void)NGW
    const int vcu = (G % 8 == 0) ? (bx % 8) * (G / 8) + bx / 8 : bx;
    for (int u = threadIdx.x; u < (LDS_BYTES - LDSCTL_OFF) / 4; u += NTHR) ((LAS unsigned*)(lds + LDSCTL_OFF))[u] = 0u;
    __syncthreads();
    (void)xcd_barrier_post((unsigned*)(KWS() + WS_CTL) + CW_BAR, MISC + 8);
#ifdef TPROBE
#ifndef TPROBE_L0
#define TPROBE_L0 -1
#define TPROBE_L1 99
#endif
    int tp_l = -1;
#define TP(type) do { if (bx == 0 && fresh_tid(wave_s) == 0) { const unsigned now_ = (unsigned)__builtin_amdgcn_s_memrealtime(); if (tp_l >= TPROBE_L0 && tp_l <= TPROBE_L1) MISC[16 + (type)] += now_ - MISC[15]; MISC[15] = now_; } } while (0)
#else
#define TP(type) do {} while (0)
#endif
#define GRID_BAR() do { XcdBarrier b_; b_.bar = (unsigned*)(KWS() + WS_CTL) + CW_BAR; b_.x = xb_xcc_id(); b_.st = MISC + 8; xcd_barrier(b_); } while (0)

#ifdef TPROBE
    if (bx == 0 && fresh_tid(wave_s) == 0) MISC[15] = (unsigned)__builtin_amdgcn_s_memrealtime();
#endif
#ifndef SKIP_P0
    {
        PHASE_IDS(); Ptrs I; { const float** pp = (const float**)&I; kargp_t kp = kfresh();
#pragma unroll
            for (int i = 0; i < 28; ++i) pp[i] = ((const float* const __attribute__((address_space(4)))*)kp)[i]; }
        prologue_phase(I, KWS(), lds, tid, lane, wave, G);
#ifdef DUP_P0
        __syncthreads(); prologue_phase(I, KWS(), lds, tid, lane, wave, G);
#endif
    }
#endif
    GRID_BAR(); TP(0);

#pragma unroll 1
    for (int l = 0; l < DEPTH; ++l) {
        const bool need_ctx = (l < DEPTH - 1), moe = (l & 1) != 0; const int jf = l >> 1;
#ifdef TPROBE
        tp_l = l;
#endif
#ifndef SKIP_N1
        {
            PHASE_IDS(); unsigned char* ws = KWS(); bf16_t* XS = WSP(bf16_t, WS_XS); bf16_t* HN = WSP(bf16_t, WS_HN); const float* MODS = WSP(float, WS_MODS);
            const float* modl = MODS + (size_t)l * 5 * INC;
            const bool comb = (l == 2);
            const float* xin = KIN(I_x); const float* cin = KIN(I_ctx); const float* g1 = KIN(I_norm1_g) + (size_t)l * D;
            const bf16_t* YYp = WSP(bf16_t, WS_R2); const int* DSTp = (const int*)(ws + WS_META + MT_DST);
            struct N1Job { int l; bool comb, hn16; bf16_t* XS; bf16_t* HN; unsigned char* HN8; const float* MODS; const float* modl; const float* xin; const float* cin; const float* g1; const bf16_t* Y; const int* DST;
                __device__ __forceinline__ void operator()(int row, RowJob& J) const {
                    const int b = row / TPB, tq = row - b * TPB, who = tq < CTXL ? 4 : b;
                    J.src = (l == 0) ? (tq < CTXL ? cin + ((size_t)b * CTXL + tq) * D : xin + ((size_t)b * SEQ + (tq - CTXL)) * D) : nullptr; J.srcb = XS + (size_t)row * D;
                    J.xs_out = (l == 0 || comb) ? XS + (size_t)row * D : nullptr; J.hn = hn16 ? HN + (size_t)row * D : nullptr; J.row = row;
                    J.A = NormArgs{}; J.A.g = g1; J.A.shift = modl + (size_t)who * INC; J.A.scale = modl + (size_t)who * INC + D; J.A.hn8 = HN8 + (size_t)row * D;
                    if (comb) { J.A.gate2p = MODS + ((size_t)(l - 1) * 5 + who) * INC + 5 * D; J.A.Y = Y; J.A.DST = DST; } } };
            const N1Job job{l, comb, (g1_mask(l) & 0xFFFFFFu) != 0xFFFFFFu  , XS, HN, ws + WS_HN8, MODS, modl, xin, cin, g1, YYp, DSTp};
            { const int RPB = (M + G - 1) / G, r0 = bx * RPB, r1 = (r0 + RPB < M) ? r0 + RPB : M; if (l == 0) norm_rows<true, false>(r0 + wave, NWAVES, r1, job, lane); else if (comb) norm_rows<false, true>(r0 + wave, NWAVES, r1, job, lane); else norm_rows<false, false>(r0 + wave, NWAVES, r1, job, lane); }
        }
#endif
        GRID_BAR(); TP(1);
#ifdef DUP_BAR
        for (int r_ = 0; r_ < 8; ++r_) GRID_BAR();
#endif
#ifndef SKIP_G1
        {
            unsigned char* ws = KWS();
            unsigned* cnt = WSP(unsigned, WS_CTL) + CW_PAN + (4 + l) * 68 * 32;
            {
                SchedG1<0> S{(const char*)WSP(bf16_t, WS_HN), (const char*)(WSP(bf16_t, WS_WIN) + (size_t)l * INC * D), NMT, G, bx, g1_mask(l), cnt};
                pg8::EpiInProj E{WSP(bf16_t, WS_P), WSP(bf16_t, WS_G), KIN(I_qn_a) + l * 64, KIN(I_kn_a) + l * 64, KIN(I_b_gate) + (size_t)l * 3 * D, WSP(float, WS_ROPE), 1.0f};
                pg8::gemm_phase<pg8::EpiInProj, SchedG1<0>, true>(lds, fresh_tid(wave_s), S, E);
            }
            {
                unsigned char* ws2 = KWS();
                SchedG1<1> S{(const char*)(ws2 + WS_HN8), (const char*)(ws2 + WS_WIN + (size_t)l * INC * D * 2 + WG8_OFF), NMT, G, bx, g1_mask(l), (unsigned*)(ws2 + WS_CTL) + CW_PAN + (4 + l) * 68 * 32};
                pg8::EpiInProj E{(bf16_t*)(ws2 + WS_P), (bf16_t*)(ws2 + WS_G), KIN(I_qn_a) + l * 64, KIN(I_kn_a) + l * 64, KIN(I_b_gate) + (size_t)l * 3 * D, (const float*)(ws2 + WS_ROPE), 1.0f / (FP8_SC_X * FP8_SC_WG)};
                pg8::gemm_phase<pg8::EpiInProj, SchedG1<1>, true, true>(lds, fresh_tid(wave_s), S, E);
            }
            TP(3);
            {
                const int nf = __builtin_popcount(g1_mask(l)), remb = (NMT * (24 - nf)) % G, remf = (NMT * nf) % G; const bool mid = remb + remf < G; const int nidle = mid ? G - remb - remf : G, rank = mid ? bx - remb : bx;
                if (rank >= 0 && rank < nidle)
                    ret::kvinc_units(WSP(bf16_t, WS_P), WSP(float, WS_KVS), WSP(float, WS_RETC) + l * 16, rank, nidle, NB * 4 * ret::NCH, cnt, WSP(unsigned, WS_CTL) + CW_TMO, wave_s, (LAS char*)lds, fresh_tid(wave_s));
            }
        }
#endif
        GRID_BAR(); TP(2);
#ifndef SKIP_A2
        { PHASE_IDS(); unsigned char* ws = KWS(); ret::scan_phase(WSP(float, WS_KVS), WSP(bf16_t, WS_KVB), WSP(float, WS_RETC) + l * 16, bx * NTHR + tid, G * NTHR); }
#endif
        GRID_BAR(); TP(4);
#ifndef SKIP_RO
        {
            unsigned char* ws = KWS(); const float* rc = WSP(float, WS_RETC) + l * 16; const float* rg = KIN(I_ret_g) + (size_t)l * 512;
            ret::retout_units(WSP(bf16_t, WS_P), WSP(bf16_t, WS_KVB), WSP(bf16_t, WS_Y3), rg, rc, bx, G, NB * 4 * ret::NCH, !need_ctx, (LAS char*)lds, fresh_tid(wave_s));
        }
#endif
        TP(7);
#ifndef SKIP_AT0
        {
            unsigned char* ws = KWS(); const bf16_t* P = WSP(bf16_t, WS_P); bf16_t* Y3 = WSP(bf16_t, WS_Y3); const float* snk = KIN(I_sink_c) + l * 8;
            const int nU0 = 512 + (need_ctx ? 64 : 0);
#pragma unroll 1
            for (int k = 0;; ++k) {
                int uu;
                if (G == 256) { if (k < 2) uu = (vcu >> 5) * 64 + (vcu & 31) * 2 + k; else if (k == 2 && bx >= 32 && bx < 96 && need_ctx) uu = 512 + (bx - 32); else break; }
                else { uu = bx + k * G; if (uu >= nU0) break; }
                const bf16_t *Qu, *Kh, *Vh; bf16_t* Ou; int NT; float sk = -INFINITY;
                if (uu < 512) {
                    const int xs = uu >> 6, b = xs >> 1, kvh = xs & 1, h = 4 * kvh + ((uu >> 4) & 3), qb = uu & 15;
                    const size_t rb = (size_t)b * TPB, rq = rb + 256 + 256 * qb;
                    Qu = P + rq * PC + 64 * h; Kh = P + rb * PC + 512 + 64 * kvh; Vh = P + rb * PC + 640 + 64 * kvh; Ou = Y3 + rq * 1536 + 64 * h; NT = 68;
                } else {
                    const int v = uu - 512, type = v >> 5, b = (v >> 3) & 3, h = v & 7, kvh = h >> 2; const size_t rb = (size_t)b * TPB;
                    if (type) sk = snk[h] * LOG2E;
                    Qu = P + rb * PC + (type ? 2304 : 0) + 64 * h; Kh = P + rb * PC + (type ? 2816 : 512) + 64 * kvh; Vh = P + rb * PC + (type ? 2944 : 640) + 64 * kvh; Ou = Y3 + rb * 1536 + (type ? 1024 : 0) + 64 * h; NT = 4;
                }
                attn_body::attn_unit<8, 0>(Qu, Kh, Vh, Ou, NT, 0, 0, sk, (char*)lds_raw, fresh_tid(wave_s));
            }
        }
#endif
#ifndef SKIP_AT1
        {
            unsigned char* ws = KWS(); const bf16_t* P = WSP(bf16_t, WS_P); bf16_t* Y3 = WSP(bf16_t, WS_Y3); const float* snk = KIN(I_sink_c) + l * 8;
#pragma unroll 1
            for (int k = 0;; ++k) {
                int uu;
                if (G == 256) { if (k < 2) uu = (vcu >> 5) * 64 + (vcu & 31) * 2 + k; else break; }
                else { uu = bx + k * G; if (uu >= 512) break; }
                const int xs = uu >> 6, b = xs >> 1, kvh = xs & 1, h = 4 * kvh + ((uu >> 4) & 3), qb = uu & 15;
                const size_t rb = (size_t)b * TPB, rq = rb + 256 + 256 * qb;
                const int q0 = 256 * qb, kstart = q0 >= 128 ? q0 - 128 : 0, kend = q0 + 384 <= SEQ ? q0 + 384 : SEQ;
                attn_body::attn_unit<8, 1>(P + rq * PC + 2304 + 64 * h, P + rb * PC + 2816 + 64 * kvh, P + rb * PC + 2944 + 64 * kvh, Y3 + rq * 1536 + 1024 + 64 * h, 4 + (kend - kstart) / 64, kstart, q0 - kstart, snk[h] * LOG2E, (char*)lds_raw, fresh_tid(wave_s));
            }
        }
#endif
        GRID_BAR(); TP(5);
#ifndef SKIP_M1
        {
            unsigned char* ws = KWS();
            unsigned* cnt = WSP(unsigned, WS_CTL) + CW_PAN + l * 68 * 32;
            {
                SchedM1 S{(const char*)WSP(bf16_t, WS_Y3), (const char*)(WSP(bf16_t, WS_WBR) + (size_t)l * D * 1536), cnt, bx, need_ctx};
                pg8::EpiBranch E{WSP(bf16_t, WS_G), WSP(bf16_t, WS_MB)};
                pg8::SKCtx X{ws + WS_PART, WSP(unsigned, WS_CTL) + CW_FLG + 8192 * (8 + l), WSP(unsigned, WS_CTL) + CW_TMO, bx};
                pg8::gemm_phase<pg8::EpiBranch, SchedM1, true>(lds, fresh_tid(wave_s), S, E, X);
            }
#pragma unroll 1
            for (int i = 1; i < 3; ++i) {
                unsigned char* ws2 = KWS();
                SchedM2One S{(const char*)(ws2 + WS_MB), (const char*)((bf16_t*)(ws2 + WS_WOUT) + (size_t)l * D * D), bx, need_ctx, i};
                pg8::Unit u;
                if (S.unit(u)) {
                    wait_panel(cnt, (unsigned*)(ws2 + WS_CTL) + CW_TMO, u.pm, wave_s, 32u);
                    pg8::EpiResid E{(bf16_t*)(ws2 + WS_XS), (float*)(ws2 + WS_MODS) + (size_t)l * 5 * INC + 2 * D};
                    pg8::SKCtx X{ws2 + WS_PART, (unsigned*)(ws2 + WS_CTL) + CW_FLG + 8192 * (12 + l), (unsigned*)(ws2 + WS_CTL) + CW_TMO, bx};
                    pg8::gemm_phase<pg8::EpiResid, SchedM2One, true>(lds, fresh_tid(wave_s), S, E, X);
                }
            }
        }
#endif
        GRID_BAR(); TP(6);
#ifndef SKIP_N2
        {
            PHASE_IDS(); unsigned char* ws = KWS(); const bf16_t* XS = WSP(bf16_t, WS_XS); bf16_t* HN = WSP(bf16_t, WS_HN); const float* modl = WSP(float, WS_MODS) + (size_t)l * 5 * INC;
            const float* g2 = KIN(I_norm2_g) + (size_t)l * D;
            const int nrows = need_ctx ? M : NB * SEQ;
            if (!moe) {
                struct N2Job { bool need_ctx; const bf16_t* XS; bf16_t* HN; const float* modl; const float* g2;
                    __device__ __forceinline__ void operator()(int rr, RowJob& J) const {
                        const int row = need_ctx ? rr : (rr / SEQ) * TPB + CTXL + (rr % SEQ);
                        const int b = row / TPB, tq = row - b * TPB, who = tq < CTXL ? 4 : b;
                        J.src = nullptr; J.srcb = XS + (size_t)row * D; J.xs_out = nullptr; J.hn = HN + (size_t)row * D; J.row = row;
                        J.A = NormArgs{}; J.A.g = g2; J.A.shift = modl + (size_t)who * INC + 3 * D; J.A.scale = modl + (size_t)who * INC + 4 * D; } };
                const N2Job job{need_ctx, XS, HN, modl, g2};
                { const int RPB = (nrows + G - 1) / G, r0 = bx * RPB, r1 = (r0 + RPB < nrows) ? r0 + RPB : nrows; norm_rows<false, false>(r0 + wave, NWAVES, r1, job, lane); }
            } else {
                const int RPB = (nrows + G - 1) / G, r0 = bx * RPB, r1 = (r0 + RPB < nrows) ? r0 + RPB : nrows;
                LAS int* route = (LAS int*)lds;
                const float* rw = KIN(I_router_w) + (size_t)jf * D * NEXP; const float* rb = KIN(I_router_b) + jf * NEXP;
                int* PE = (int*)(ws + WS_META + MT_PE); int* PPOS = (int*)(ws + WS_META + MT_PPOS); float* PW = (float*)(ws + WS_META + MT_PW); int* BC = (int*)(ws + WS_META + MT_BC);
                LAS float* rwl = (LAS float*)(lds + 4096);
                for (int i = tid; i < D * NEXP; i += NTHR) rwl[(i & 7) * 1024 + (i >> 3)] = rw[i];
                LDS_WAIT(); __syncthreads();
                struct N2MJob { bool need_ctx; const bf16_t* XS; bf16_t* HN; const float* modl; const float* g2; const LAS float* rw; const float* rb; LAS int* route; int r0; int* PE; float* PW;
                    __device__ __forceinline__ void operator()(int rr, RowJob& J) const {
                        const int row = need_ctx ? rr : (rr / SEQ) * TPB + CTXL + (rr % SEQ);
                        const int b = row / TPB, tq = row - b * TPB, who = tq < CTXL ? 4 : b;
                        J.src = nullptr; J.srcb = XS + (size_t)row * D; J.xs_out = nullptr; J.hn = nullptr; J.row = row;
                        J.A = NormArgs{}; J.A.g = g2; J.A.shift = modl + (size_t)who * INC + 3 * D; J.A.scale = modl + (size_t)who * INC + 4 * D; J.A.hn8 = (unsigned char*)HN + (size_t)row * D;
                        J.A.rw = rw; J.A.rb = rb; J.A.route = route + 2 * (rr - r0); J.A.PE = PE; J.A.PW = PW; } };
                const N2MJob job{need_ctx, XS, HN, modl, g2, rwl, rb, route, r0, PE, PW};
                norm_rows<false, false>(r0 + wave, NWAVES, r1, job, lane);
                LDS_WAIT(); __syncthreads();
                {
                    const int npair = 2 * (r1 - r0 > 0 ? r1 - r0 : 0); int cnt = 0;
                    for (int k0 = 0; k0 < npair; k0 += 64) { const int k = k0 + lane; const bool mine = (k < npair) && (route[k] == wave);
                        const unsigned long long bal = __ballot(mine);
                        if (mine) { const int rr = r0 + (k >> 1); const int row = need_ctx ? rr : (rr / SEQ) * TPB + CTXL + (rr % SEQ);
                            PPOS[2 * row + (k & 1)] = cnt + __popcll(bal & ((1ull << lane) - 1ull)); }
                        cnt += __popcll(bal); }
                    if (lane == 0) BC[bx * 8 + wave] = cnt;
                }
                __syncthreads();
            }
        }
#endif
        GRID_BAR(); TP(8);
        if (!moe) {
#ifndef SKIP_F1
            {
                unsigned char* ws = KWS();
                SchedPlain S{(const char*)WSP(bf16_t, WS_HN), (const char*)(WSP(bf16_t, WS_W13) + (size_t)jf * 2 * DFF * D), (size_t)256 * D * 2, (size_t)256 * D * 2, need_ctx ? NMT : 64, 2 * DFF / 256, G, bx, !need_ctx, D / 64, D, D};
                pg8::EpiSwiGLU E{WSP(bf16_t, WS_H), DFF};
                pg8::gemm_phase<pg8::EpiSwiGLU, SchedPlain, true>(lds, fresh_tid(wave_s), S, E);
            }
#endif
            GRID_BAR(); TP(9);
#ifndef SKIP_F2
            {
                unsigned char* ws = KWS();
                SchedWR<DFF / 128> S{(const char*)WSP(bf16_t, WS_H), (const char*)(WSP(bf16_t, WS_W2) + (size_t)jf * D * DFF), (size_t)256 * DFF * 2, (size_t)256 * DFF * 2, 0, need_ctx ? NMT : 64, G, bx, !need_ctx, 1 << 30, 1 << 30, 1 << 30, 1 << 30, 1 << 30, 1 << 30, 1 << 30, DFF, DFF};
                pg8::EpiResid E{WSP(bf16_t, WS_XS), WSP(float, WS_MODS) + (size_t)l * 5 * INC + 5 * D};
                pg8::SKCtx X{ws + WS_PART, WSP(unsigned, WS_CTL) + CW_FLG + 8192 * (4 + jf), WSP(unsigned, WS_CTL) + CW_TMO, bx};
                pg8::gemm_phase<pg8::EpiResid, SchedWR<DFF / 128>, true>(lds, fresh_tid(wave_s), S, E, X);
            }
#endif
            GRID_BAR(); TP(10);
        } else {
#ifndef SKIP_GA
            {
                PHASE_IDS(); unsigned char* ws = KWS(); const bf16_t* HN = WSP(bf16_t, WS_HN); bf16_t* HS = WSP(bf16_t, WS_R2);
                const int* PE = (const int*)(ws + WS_META + MT_PE); const int* PPOS = (const int*)(ws + WS_META + MT_PPOS); const float* PW = (const float*)(ws + WS_META + MT_PW);
                int* DST = (int*)(ws + WS_META + MT_DST); float* CW = (float*)(ws + WS_META + MT_CW); const int* BC = (const int*)(ws + WS_META + MT_BC);
                const int nrows = need_ctx ? M : NB * SEQ, RPB = (nrows + G - 1) / G;
                LAS int* PRE = (LAS int*)lds; LAS int* LT = PRE + 8 * 256; LAS int* TOT = LT + 8 * 64;
                if (G <= 256) {
                    int c4[4], sum = 0;
#pragma unroll
                    for (int q = 0; q < 4; ++q) { const int b = 4 * lane + q; c4[q] = (b < G) ? BC[b * 8 + wave] : 0; sum += c4[q]; }
                    LT[wave * 64 + lane] = sum;
                    LDS_WAIT();
                    int pre = 0; for (int q = 0; q < lane; ++q) pre += LT[wave * 64 + q];
                    if (lane == 63) TOT[wave] = pre + sum;
#pragma unroll
                    for (int q = 0; q < 4; ++q) { PRE[(4 * lane + q) * 8 + wave] = pre; pre += c4[q]; }
                }
                LDS_WAIT(); __syncthreads();
                int ts[9]; ts[0] = 0;
#pragma unroll
                for (int e = 0; e < 8; ++e) ts[e + 1] = ts[e] + ((TOT[e] + 255) >> 8);
                if (bx == 0 && tid < 8) __hip_atomic_store(WSP(unsigned, WS_CTL) + CW_CNT + 1024 * jf + 64 * tid, (unsigned)TOT[tid], RLX_AGENT);
                unsigned char* HS8 = (unsigned char*)HS;
#pragma unroll 1
                for (int rr0 = gw; rr0 < nrows; rr0 += 4 * NGW) {
                    int row[4], pe[4][2], pp[4][2]; float pw[4][2]; u32x4 q[4]; bool ok[4];
#pragma unroll
                    for (int k = 0; k < 4; ++k) { const int rr = rr0 + k * NGW; ok[k] = rr < nrows; const int rc = ok[k] ? rr : rr0; row[k] = need_ctx ? rc : (rc / SEQ) * TPB + CTXL + (rc % SEQ); }
#pragma unroll
                    for (int k = 0; k < 4; ++k) { q[k] = *(const u32x4*)((const unsigned char*)HN + (size_t)row[k] * D + 16 * lane);
#pragma unroll
                        for (int s = 0; s < 2; ++s) { pe[k][s] = PE[2 * row[k] + s]; pp[k][s] = PPOS[2 * row[k] + s]; pw[k][s] = PW[2 * row[k] + s]; } }
#pragma unroll
                    for (int k = 0; k < 4; ++k) { const int rr = rr0 + k * NGW, blk = (ok[k] ? rr : rr0) / RPB;
                        if (ok[k]) {
#pragma unroll
                            for (int s = 0; s < 2; ++s) { const int e = pe[k][s], pos = pp[k][s] + PRE[blk * 8 + e];
                                int t0 = 0;
#pragma unroll
                                for (int kk = 1; kk < 8; ++kk) t0 = (e == kk) ? ts[kk] : t0;
                                const int d = 256 * t0 + pos;
                                *(u32x4*)(HS8 + (size_t)d * D + 16 * lane) = q[k];
                                if (lane == 0) { CW[d] = pw[k][s]; DST[2 * row[k] + s] = d; } } } }
                }
            }
#endif
            GRID_BAR(); TP(11);
#ifndef SKIP_E1
            {
                unsigned char* ws = KWS();
                int ts[9]; ts[0] = 0;
#pragma unroll
                for (int e = 0; e < 8; ++e) { const unsigned c = __hip_atomic_load(WSP(unsigned, WS_CTL) + CW_CNT + 1024 * jf + 64 * e, RLX_AGENT); ts[e + 1] = ts[e] + (int)((c + 255u) >> 8); }
                SchedMoE S{(const char*)(ws + WS_R2), (const char*)(ws + WS_E13 + (size_t)jf * 8 * 2 * DFE * D), (size_t)256 * D, (size_t)256 * D, (size_t)2 * DFE * D, ts[8], 2 * DFE / 256, G, bx, ts[1], ts[2], ts[3], ts[4], ts[5], ts[6], ts[7], D / 128, D / 2, D / 2};
                pg8::EpiSwiGLU8 E{ws + WS_H, DFE, 1.0f / (FP8_SC_X * FP8_SC_W13), FP8_SC_H};
                pg8::gemm_phase<pg8::EpiSwiGLU8, SchedMoE, true, true>(lds, fresh_tid(wave_s), S, E);
            }
#endif
            GRID_BAR(); TP(12);
#ifndef SKIP_E2
            {
                unsigned char* ws = KWS();
                int ts[9]; ts[0] = 0;
#pragma unroll
                for (int e = 0; e < 8; ++e) { const unsigned c = __hip_atomic_load(WSP(unsigned, WS_CTL) + CW_CNT + 1024 * jf + 64 * e, RLX_AGENT); ts[e + 1] = ts[e] + (int)((c + 255u) >> 8); }
                SchedWR<DFE / 256> S{(const char*)(ws + WS_H), (const char*)(ws + WS_E2 + (size_t)jf * 8 * D * DFE), (size_t)256 * DFE, (size_t)256 * DFE, (size_t)D * DFE, ts[8], G, bx, false, ts[1], ts[2], ts[3], ts[4], ts[5], ts[6], ts[7], DFE / 2, DFE / 2};
                pg8::EpiMoEDown E{WSP(bf16_t, WS_R2), (const float*)(ws + WS_META + MT_CW), 1.0f / (FP8_SC_H * FP8_SC_W2)};
                pg8::SKCtx X{ws + WS_PART, WSP(unsigned, WS_CTL) + CW_FLG + 8192 * (6 + jf), WSP(unsigned, WS_CTL) + CW_TMO, bx};
                pg8::gemm_phase<pg8::EpiMoEDown, SchedWR<DFE / 256>, true, true>(lds, fresh_tid(wave_s), S, E, X);
            }
#endif
            GRID_BAR(); TP(13);
        }
    }
#ifdef TPROBE
    { unsigned char* ws = KWS(); if (bx == 0 && fresh_tid(wave_s) < 16) WSP(unsigned, WS_RETC + 4096)[fresh_tid(wave_s)] = MISC[16 + fresh_tid(wave_s)]; }
    GRID_BAR();
#endif
    {
        PHASE_IDS(); unsigned char* ws = KWS(); const bf16_t* XS = WSP(bf16_t, WS_XS); const float* MODS = WSP(float, WS_MODS); const bf16_t* YY = WSP(bf16_t, WS_R2); const int* DST = (const int*)(ws + WS_META + MT_DST);
        const float* fgp = KIN(I_final_g); float* outp = KOUT();
        const unsigned tmo = __hip_atomic_load(WSP(unsigned, WS_CTL) + CW_BAR + XB_TMO, RLX_AGENT) | __hip_atomic_load(WSP(unsigned, WS_CTL) + CW_TMO, RLX_AGENT);
#pragma unroll 1
        for (int rr0 = gw; rr0 < NB * SEQ; rr0 += 4 * NGW) {
            int rrk[4], rowk[4], dk[4][2]; const float* gtk[4]; bool ok[4];
#pragma unroll
            for (int k = 0; k < 4; ++k) { const int rr = rr0 + k * NGW; ok[k] = rr < NB * SEQ; rrk[k] = ok[k] ? rr : rr0; const int b = rrk[k] / SEQ; rowk[k] = b * TPB + CTXL + (rrk[k] % SEQ);
                gtk[k] = MODS + ((size_t)3 * 5 + b) * INC + 5 * D; dk[k][0] = DST[2 * rowk[k]]; dk[k][1] = DST[2 * rowk[k] + 1]; }
            u32x2 xb[4][4], y0[4][4], y1[4][4]; f32x4 g4[4][4];
#pragma unroll
            for (int k = 0; k < 4; ++k)
#pragma unroll
                for (int j = 0; j < 4; ++j) { const int c = 4 * lane + 256 * j; xb[k][j] = *(const u32x2*)(XS + (size_t)rowk[k] * D + c);
                    y0[k][j] = *(const u32x2*)(YY + (size_t)dk[k][0] * D + c); y1[k][j] = *(const u32x2*)(YY + (size_t)dk[k][1] * D + c); g4[k][j] = *(const f32x4*)(gtk[k] + c); }
#pragma unroll
            for (int k = 0; k < 4; ++k) {
                const int rr = rrk[k];
                f32x4 v[4]; float ss = 0.f;
#pragma unroll
                for (int j = 0; j < 4; ++j) { v[j] = (f32x4){bflo(xb[k][j].x), bfhi(xb[k][j].x), bflo(xb[k][j].y), bfhi(xb[k][j].y)};
                    v[j][0] += g4[k][j][0] * (bflo(y0[k][j].x) + bflo(y1[k][j].x)); v[j][1] += g4[k][j][1] * (bfhi(y0[k][j].x) + bfhi(y1[k][j].x)); v[j][2] += g4[k][j][2] * (bflo(y0[k][j].y) + bflo(y1[k][j].y)); v[j][3] += g4[k][j][3] * (bfhi(y0[k][j].y) + bfhi(y1[k][j].y));
                    ss += (v[j][0] * v[j][0] + v[j][1] * v[j][1]) + (v[j][2] * v[j][2] + v[j][3] * v[j][3]); }
                float rs = rsqrtf(wave_sum(ss) * (1.0f / D) + EPS);
                if (tmo) rs = __builtin_nanf("");
                if (ok[k]) {
#pragma unroll
                    for (int j = 0; j < 4; ++j) { const int c = 4 * lane + 256 * j; const f32x4 fg = *(const f32x4*)(fgp + c); *(f32x4*)(outp + (size_t)rr * D + c) = v[j] * rs * fg; }
#ifdef TPROBE
            { const unsigned* T = WSP(unsigned, WS_RETC + 4096); const float c2 = (TPROBE_B >= 0 ? (float)T[TPROBE_B < 0 ? 0 : TPROBE_B] : (float)(T[0] + T[1] + T[2] + T[3] + T[4] + T[5] + T[6] + T[7] + T[8] + T[9] + T[10] + T[11] + T[12] + T[13])) * 0.01f * TPROBE_SB;
#pragma unroll
              for (int j = 0; j < 4; ++j) { const int c = 4 * lane + 256 * j; f32x4 o = (f32x4){100.f, 100.f, 100.f, 100.f}; if (rr == 0 && c == 0) o[0] = c2; *(f32x4*)(outp + (size_t)rr * D + c) = o; } }
#endif
                }
            }
        }
    }
#undef GRID_BAR
}

extern "C" void kernel_launch(void* const* d_in, const int* in_sizes, int n_in, void* d_out, int out_size, void* d_ws, size_t ws_size, hipStream_t stream) {
    static int grid = 0;
    if (grid == 0) {
        if (n_in != 28 || out_size != NB * SEQ * D || ws_size < WS_END) { fprintf(stderr, "kernel_launch: unexpected shapes: n_in %d out %d ws %zu (need %zu)\n", n_in, out_size, ws_size, (size_t)WS_END); grid = -1; return; }
        int dev = 0, cus = 0, per_cu = 0;
        if (hipGetDevice(&dev) != hipSuccess || hipDeviceGetAttribute(&cus, hipDeviceAttributeMultiprocessorCount, dev) != hipSuccess) { grid = -1; return; }
        if (hipFuncSetAttribute((const void*)fwd_kernel, hipFuncAttributeMaxDynamicSharedMemorySize, LDS_BYTES) != hipSuccess) { fprintf(stderr, "kernel_launch: hipFuncSetAttribute failed\n"); grid = -1; return; }
        if (hipOccupancyMaxActiveBlocksPerMultiprocessor(&per_cu, (const void*)fwd_kernel, NTHR, LDS_BYTES) != hipSuccess || per_cu < 1) fprintf(stderr, "kernel_launch: occupancy query reports %d\n", per_cu);
        (void)hipGetLastError();
        grid = cus < 256 ? cus : 256;
    }
    if (grid < 0) return;
    if (hipMemsetAsync((char*)d_ws + WS_CTL, 0, CTL_ZERO_BYTES, stream) != hipSuccess) return;
    Args a{};
    const float** pp = (const float**)&a.in;
    for (int i = 0; i < 28; ++i) pp[i] = (const float*)d_in[i];
    a.out = (float*)d_out; a.ws = (unsigned char*)d_ws;
    hipLaunchKernelGGL(fwd_kernel, dim3(grid), dim3(NTHR), LDS_BYTES, stream, a);
}
```

```cpp
#include <hip/hip_runtime.h>
#include <cstdio>
#include <cstdint>
#include <cmath>

constexpr int NB = 4, SEQ = 4096, CTXL = 256, TPB = SEQ + CTXL, M = NB * TPB, D = 1024, DEPTH = 4;
constexpr int INC = 6144, PC = 3072, DFF = 2816, DFE = 3584, NEXP = 8;
constexpr int NMT = M / 256;
constexpr int MOE_ROWS = 2 * M + NEXP * 256;
constexpr float EPS = 1e-6f;
constexpr float LOG2E = 1.4426950408889634f;
constexpr float C2 = 0.125f * LOG2E;

constexpr size_t MiB = 1u << 20;
constexpr size_t WS_CTL = 0, CTL_ZERO_BYTES = 1 * MiB;
constexpr size_t WS_MODS = 1 * MiB;
constexpr size_t WS_ROPE = WS_MODS + 512 * 1024;
constexpr size_t WS_RETC = WS_ROPE + 16 * 1024;
constexpr size_t WS_META = 2 * MiB;
constexpr size_t WS_WIN = 3 * MiB;
constexpr size_t WS_WBR = WS_WIN + 48 * MiB;
constexpr size_t WS_WOUT = WS_WBR + 12 * MiB;
constexpr size_t WS_W13 = WS_WOUT + 8 * MiB;
constexpr size_t WS_W2 = WS_W13 + 22 * MiB;
constexpr size_t WS_E13 = WS_W2 + 11 * MiB;
constexpr size_t WS_E2 = WS_E13 + 224 * MiB;
constexpr size_t WS_XS = WS_E2 + 112 * MiB;
constexpr size_t WS_HN = WS_XS + 68 * MiB;
constexpr size_t WS_P = WS_HN + 34 * MiB;
constexpr size_t WS_G = WS_P + 102 * MiB;
constexpr size_t WS_Y3 = WS_G + 102 * MiB;
constexpr size_t WS_R2 = WS_Y3 + 51 * MiB;
constexpr size_t WS_MB = WS_R2, WS_KVS = WS_R2 + 34 * MiB;
constexpr size_t WS_KVB = WS_HN;
constexpr size_t WS_HN8 = WS_Y3;
#ifndef G1M0
#define G1M0 0xFFF000u
#define G1M1 0xFFF000u
#define G1M2 0xFFFFFFu
#define G1M3 0xFFFFFFu
#endif
__device__ __forceinline__ unsigned g1_mask(int l) { return (l == 0 ? G1M0 : l == 1 ? G1M1 : l == 2 ? G1M2 : G1M3) | 0xFFF000u; }
__device__ __forceinline__ int nth_bit(unsigned m, int j) { for (int t = 0; t < j; ++t) m &= m - 1u; return __builtin_ctz(m); }
constexpr size_t WG8_OFF = (size_t)3072 * D * 2;
constexpr size_t WS_PART = WS_R2 + 72 * MiB;
constexpr size_t WS_END = WS_PART + 64 * MiB;
constexpr size_t WS_H = WS_P;
static_assert((size_t)MOE_ROWS * DFE * 2 <= WS_R2 - WS_P, "HM overlay");
static_assert((size_t)MOE_ROWS * D * 2 <= 72 * MiB, "HS overlay");
constexpr size_t MT_PE = 0, MT_PPOS = MT_PE + (size_t)M * 8, MT_PW = MT_PPOS + (size_t)M * 8, MT_DST = MT_PW + (size_t)M * 8, MT_CW = MT_DST + (size_t)M * 8, MT_BC = MT_CW + (size_t)MOE_ROWS * 4, MT_END = MT_BC + 256 * 8 * 4;
static_assert(MT_END <= 1 * MiB, "meta");
constexpr int CW_TMO = 0, CW_CODE = 1, CW_BAR = 4096, CW_CNT = 8192, CW_FLG = 65536, CW_PAN = 200000;

constexpr int RING_BYTES = 131072, LDSCTL_OFF = RING_BYTES, MISC_OFF = LDSCTL_OFF + 320, LDS_BYTES = 147456;
constexpr int NWAVES = 8, NTHR = 512;

#define GAS __attribute__((address_space(1)))
#define LAS __attribute__((address_space(3)))
typedef unsigned short bf16_t;
typedef unsigned u32x4 __attribute__((ext_vector_type(4)));
typedef unsigned u32x2 __attribute__((ext_vector_type(2)));
typedef float f32x4 __attribute__((ext_vector_type(4)));
typedef float f32x2 __attribute__((ext_vector_type(2)));
typedef float f32x16 __attribute__((ext_vector_type(16)));
typedef short bf16x8 __attribute__((ext_vector_type(8)));
typedef short s16x4 __attribute__((ext_vector_type(4)));
#define RLX_AGENT __ATOMIC_RELAXED, __HIP_MEMORY_SCOPE_AGENT
#define LDS_WAIT() asm volatile("s_waitcnt lgkmcnt(0)" ::: "memory")
#define VM_WAIT() asm volatile("s_waitcnt vmcnt(0)" ::: "memory")
typedef float f32x2v_t __attribute__((ext_vector_type(2))); typedef __bf16 bf16x2v_t __attribute__((ext_vector_type(2)));
__device__ __forceinline__ unsigned pk2(float lo, float hi) { const f32x2v_t v = {lo, hi}; return __builtin_bit_cast(unsigned, __builtin_convertvector(v, bf16x2v_t)); }
__device__ __forceinline__ unsigned f2bf(float f) { return pk2(f, f) & 0xffffu; }
__device__ __forceinline__ float bflo(unsigned w) { return __builtin_bit_cast(float, w << 16); }
__device__ __forceinline__ float bfhi(unsigned w) { return __builtin_bit_cast(float, w & 0xffff0000u); }
typedef int i32x8 __attribute__((ext_vector_type(8)));
typedef int i32x4 __attribute__((ext_vector_type(4)));
__device__ __forceinline__ unsigned pk4_fp8(float a, float b, float c, float d) { int p = __builtin_amdgcn_cvt_pk_fp8_f32(a, b, 0, false); p = __builtin_amdgcn_cvt_pk_fp8_f32(c, d, p, true); return (unsigned)p; }
constexpr float FP8_SC_X = 4.0f, FP8_SC_H = 2.0f, FP8_SC_W13 = 32.0f, FP8_SC_W2 = 64.0f, FP8_SC_WG = 32.0f;
__device__ __forceinline__ float sigmoidf_(float x) { return __builtin_amdgcn_rcpf(1.0f + __builtin_amdgcn_exp2f(x * -LOG2E)); }
__device__ __forceinline__ float siluf_(float x) { return x * sigmoidf_(x); }
__device__ __forceinline__ int fresh_lane() { int l; asm volatile("v_mbcnt_lo_u32_b32 %0, -1, 0\n\tv_mbcnt_hi_u32_b32 %0, -1, %0" : "=v"(l)); return l; }
__device__ __forceinline__ int fresh_tid(int wave_s) { int l; asm volatile("v_mbcnt_lo_u32_b32 %0, -1, 0\n\tv_mbcnt_hi_u32_b32 %0, -1, %0" : "=v"(l)); return wave_s * 64 + l; }
template <int MSK> __device__ __forceinline__ float swz_xor(float v) { return __builtin_bit_cast(float, __builtin_amdgcn_ds_swizzle(__builtin_bit_cast(int, v), (MSK << 10) | 0x1f)); }
__device__ __forceinline__ float xor32_sum(float v) { const unsigned u = __builtin_bit_cast(unsigned, v); auto rr = __builtin_amdgcn_permlane32_swap(u, u, false, false); return __builtin_bit_cast(float, (unsigned)rr[0]) + __builtin_bit_cast(float, (unsigned)rr[1]); }
template <int CTRL> __device__ __forceinline__ float dpp_f(float v) { return __builtin_bit_cast(float, __builtin_amdgcn_update_dpp(0, __builtin_bit_cast(int, v), CTRL, 0xf, 0xf, true)); }
__device__ __forceinline__ float half_sum(float v) { v += dpp_f<0xB1>(v); v += dpp_f<0x4E>(v); v += dpp_f<0x141>(v); v += dpp_f<0x140>(v); v += swz_xor<16>(v); return v; }
__device__ __forceinline__ float wave_sum(float v) { return xor32_sum(half_sum(v)); }

typedef const __attribute__((address_space(4))) unsigned char* kargp_t;
__device__ __forceinline__ kargp_t kfresh() { kargp_t p = (kargp_t)__builtin_amdgcn_kernarg_segment_ptr(); asm volatile("" : "+s"(p)); return p; }
#define KIN(idx) (((const float* const __attribute__((address_space(4)))*)kfresh())[idx])
#define KOUT() (((float* const __attribute__((address_space(4)))*)kfresh())[28])
#define KWS() (((unsigned char* const __attribute__((address_space(4)))*)kfresh())[29])
enum { I_x, I_c, I_ctx, I_c_ctx, I_w_ada, I_b_ada, I_norm1_g, I_norm2_g, I_final_g, I_w_in, I_b_gate, I_qn_a, I_kn_a, I_ret_a, I_ret_g, I_sink_c, I_w_br_a, I_w_br_b, I_w_br_c, I_w_out, I_ffn_w1, I_ffn_w3, I_ffn_w2, I_router_w, I_router_b, I_exp_w1, I_exp_w3, I_exp_w2 };
#define WSP(T, off) ((T*)(ws + (off)))

#define XB_TMO      128
#define XB_XCNT(j)  (256  + 64 * (j))
#define XB_XSUB(j)  (1280 + 64 * (j))
#define XB_XGEN(j)  (2304 + 64 * (j))
#define XB_TOP      3328
#define XB_TOPGEN   3392
#define XCD_BAR_WORDS 3456
#define XB_SPIN_CAP (1u << 20)
__device__ __forceinline__ unsigned xb_ld(unsigned* p)              { return __hip_atomic_load(p, __ATOMIC_RELAXED, __HIP_MEMORY_SCOPE_AGENT); }
__device__ __forceinline__ unsigned xb_add(unsigned* p, unsigned v) { return __hip_atomic_fetch_add(p, v, __ATOMIC_RELAXED, __HIP_MEMORY_SCOPE_AGENT); }
__device__ __forceinline__ unsigned xb_xcc_id() { return (unsigned)__builtin_amdgcn_s_getreg((3 << 11) | 20) & 0xFu; }
#define XB_SPIN(cond, bar) do { unsigned _sp = 0; while (cond) { __builtin_amdgcn_s_sleep(1); \
    if ((++_sp & 255u) == 0u) { if (xb_ld(&(bar)[XB_TMO])) break; if (_sp > XB_SPIN_CAP) { atomicAdd(&(bar)[XB_TMO], 1u); break; } } } } while (0)
struct XcdBarrier { unsigned* bar; unsigned x; volatile LAS unsigned* st; };
__device__ __forceinline__ XcdBarrier xcd_barrier_post(unsigned* bar, volatile LAS unsigned* st) {
    XcdBarrier b; b.bar = bar; b.x = xb_xcc_id(); b.st = st;
    if (threadIdx.x == 0) (void)xb_add(&bar[XB_XCNT(b.x)], 1u);
    return b;
}
__device__ __forceinline__ void xcd_barrier_complete(unsigned* bar, unsigned x, unsigned& nloc, unsigned& nx) {
    const unsigned G = gridDim.x * gridDim.y * gridDim.z;
    unsigned sum, cnt, mine, sp = 0u;
    for (;;) {
        sum = 0u; cnt = 0u; mine = 0u;
#pragma unroll
        for (unsigned j = 0; j < 16; ++j) { const unsigned c = xb_ld(&bar[XB_XCNT(j)]); sum += c; cnt += (c > 0u) ? 1u : 0u; mine = (j == x) ? c : mine; }
        if (sum == G) break;
        __builtin_amdgcn_s_sleep(1);
        if ((++sp & 255u) == 0u) { if (xb_ld(&bar[XB_TMO])) break; if (sp > XB_SPIN_CAP) { atomicAdd(&bar[XB_TMO], 1u); break; } }
    }
    nloc = mine > 0u ? mine : 1u; nx = cnt > 0u ? cnt : 1u;
}
__device__ __forceinline__ void xcd_barrier(const XcdBarrier& b) {
    asm volatile("s_waitcnt vmcnt(0)" ::: "memory");
    __syncthreads();
    if (threadIdx.x == 0) {
        unsigned* bar = b.bar;
        __builtin_amdgcn_s_waitcnt(0);
        unsigned nloc = b.st[0], nx = b.st[1];
        if (nloc == 0u) { xcd_barrier_complete(bar, b.x, nloc, nx); b.st[0] = nloc; b.st[1] = nx; }
        const unsigned old = xb_add(&bar[XB_XSUB(b.x)], 1u);
        const unsigned gen = old / nloc;
        if (old + 1u == (gen + 1u) * nloc) {
            __builtin_amdgcn_fence(__ATOMIC_RELEASE, "agent");
            asm volatile("s_waitcnt vmcnt(0)" ::: "memory");
            const unsigned og = xb_add(&bar[XB_TOP], 1u);
            const unsigned tg = og / nx;
            if (og + 1u == (tg + 1u) * nx) xb_add(&bar[XB_TOPGEN], 1u);
            else XB_SPIN(xb_ld(&bar[XB_TOPGEN]) == tg, bar);
            __builtin_amdgcn_fence(__ATOMIC_ACQUIRE, "agent");
            xb_add(&bar[XB_XGEN(b.x)], 1u);
            asm volatile("s_waitcnt vmcnt(0)" ::: "memory");
        } else {
            XB_SPIN(xb_ld(&bar[XB_XGEN(b.x)]) == gen, bar);
            __builtin_amdgcn_fence(__ATOMIC_ACQUIRE, "agent");
            asm volatile("s_waitcnt vmcnt(0)" ::: "memory");
        }
    }
    __syncthreads();
}
namespace pg8 {
constexpr int BM = 256, BK = 64, HALF = 128, HTB = HALF * BK * 2, STAGE_BYTES = 8 * HTB;
__device__ __forceinline__ int lds_byte(int r, int c) { const int st = (r >> 4) * 2 + (c >> 5), rr = r & 15, cc = c & 31, ob = rr * 64 + cc * 2; return st * 1024 + (ob ^ (((ob >> 9) & 1) << 5)); }
__device__ __forceinline__ void stage_rc(int b, int& R, int& C) { const int st = b / 1024, sb = b % 1024, swz = sb ^ (((sb >> 9) & 1) << 5); R = (st >> 1) * 16 + swz / 64; C = (st & 1) * 32 + (swz % 64) / 2; }
__device__ __forceinline__ int perm32(int rho) { const int n = rho >> 4, i = rho & 15; return 8 * (i >> 2) + 4 * n + (i & 3); }

struct Unit { int pm, pn, aux, ntk, mode, peer, kt0, kind, lda, ldb; const char* A; const char* B; };
struct SKCtx { unsigned char* part; unsigned* flags; unsigned* tmo; int self; };
constexpr unsigned SK_SLOT = 262144u, SK_SPIN_CAP = 1u << 20;
#ifndef SKB
#define SKB 16
#endif
__device__ __forceinline__ void sk_store_partial(const f32x4 (&acc)[2][2][4][2], const SKCtx& X, int wid) {
    const int tid = wid * 64 + fresh_lane();
    const __amdgpu_buffer_rsrc_t rs = __builtin_amdgcn_make_buffer_rsrc(X.part + (size_t)X.self * SK_SLOT, 0, SK_SLOT, 0x00020000);
#pragma unroll
    for (int r = 0; r < 32; ++r) __builtin_amdgcn_raw_buffer_store_b128(__builtin_bit_cast(u32x4, acc[r >> 4][(r >> 3) & 1][(r >> 1) & 3][r & 1]), rs, (unsigned)((r * 512 + tid) * 16), 0, 16);
    asm volatile("s_waitcnt vmcnt(0)" ::: "memory");
    if ((tid & 63) == 0) __hip_atomic_fetch_add(X.flags + 32 * X.self, 1u, __ATOMIC_RELAXED, __HIP_MEMORY_SCOPE_AGENT);
}
__device__ __forceinline__ void sk_add_partial(f32x4 (&acc)[2][2][4][2], const SKCtx& X, int peer, int wid) {
    const int tid = wid * 64 + fresh_lane();
    unsigned spins = 0;
    while ((unsigned)__builtin_amdgcn_readfirstlane(__hip_atomic_load(X.flags + 32 * peer, __ATOMIC_RELAXED, __HIP_MEMORY_SCOPE_AGENT)) < 8u) {
        __builtin_amdgcn_s_sleep(1);
        if (++spins > SK_SPIN_CAP) { if ((tid & 63) == 0) __hip_atomic_store(X.tmo, 1u, __ATOMIC_RELAXED, __HIP_MEMORY_SCOPE_AGENT); break; } }
    __builtin_amdgcn_fence(__ATOMIC_ACQUIRE, "agent");
    asm volatile("s_waitcnt vmcnt(0)" ::: "memory");
    const int t2 = tid;
    const f32x4* p = (const f32x4*)(X.part + (size_t)peer * SK_SLOT) + t2;
#pragma unroll
    for (int r0 = 0; r0 < 32; r0 += SKB) {
        f32x4 v[SKB];
#pragma unroll
        for (int k = 0; k < SKB; ++k) asm volatile("global_load_dwordx4 %0, %1, off sc1" : "=v"(v[k]) : "v"(p + (r0 + k) * 512) : "memory");
        asm volatile("s_waitcnt vmcnt(0)" ::: "memory");
#pragma unroll
        for (int k = 0; k < SKB; ++k) asm volatile("" : "+v"(v[k]));
#pragma unroll
        for (int k = 0; k < SKB; ++k) { const int r = r0 + k; acc[r >> 4][(r >> 3) & 1][(r >> 1) & 3][r & 1] += v[k]; }
    }
}

__device__ __forceinline__ bool tile_of(long L, int nM, int nN, int& pm, int& pn) {
    const int nwg = nM * nN; if (L >= nwg) return false;
    int wgid = (int)L; { const int q = nwg / 8, r = nwg % 8, xcd = wgid % 8, off = wgid / 8; wgid = (xcd < r ? xcd * (q + 1) : r * (q + 1) + (xcd - r) * q) + off; }
    const int nig = 8 * nN, gid = wgid / nig, fm = gid * 8, gsz = (nM - fm) < 8 ? (nM - fm) : 8;
    pm = fm + ((wgid % nig) % gsz); pn = (wgid % nig) / gsz; return true;
}
__device__ __forceinline__ unsigned cvt_pk_bf16(float lo, float hi) { return pk2(lo, hi); }

template <class Epi, class Sched, bool ALIGN_EPI, bool FP8 = false>
__device__ __forceinline__ void gemm_phase(LAS unsigned char* lds, const int tid, const Sched& S, const Epi& E, const SKCtx X = SKCtx{nullptr, nullptr, nullptr, 0}) {
    const int wid = __builtin_amdgcn_readfirstlane(tid >> 6), lane = tid & 63, wr = wid >> 2, wc = wid & 3, fr = lane & 15, fq = lane >> 4;
    unsigned RA2[2], RB2[2], C2[2];
#pragma unroll
    for (int i = 0; i < 2; ++i) { int R, C; stage_rc(tid * 16 + i * 8192, R, C); const int Rb = Epi::PERM ? ((R & ~31) + perm32(R & 31)) : R;
        RA2[i] = (unsigned)R * 2u; RB2[i] = (unsigned)Rb * 2u; C2[i] = (unsigned)C * 2u; }
    const size_t kstep = (size_t)(BK * 2);
    const unsigned ldsw = (unsigned)wid * 1024u;
    const int aoff = lds_byte(wr * 64 + fr, fq * 8), boff = lds_byte(wc * 32 + fr, fq * 8);
#define PG8_SA(b, h) (((b) * 2 + (h)) * HTB)
#define PG8_SB(b, h) ((4 + (b) * 2 + (h)) * HTB)
#define PG8_STAGE(bufoff, gbase, R2, ld) do { _Pragma("unroll") for (int _i = 0; _i < 2; ++_i) \
        __builtin_amdgcn_global_load_lds((const unsigned*)((const char*)(gbase) + ((R2)[_i] * (unsigned)(ld) + C2[_i])), (LAS unsigned*)(lds + (bufoff) + ldsw + _i * 8192), 16, 0, 0); } while (0)
#define PG8_HS(ld) ((size_t)HALF * (size_t)(ld) * 2)
#define PG8_STAGE_A(bufoff, gbase, ld, kd) do { if ((kd) == 1) { _Pragma("unroll") for (int _i = 0; _i < 2; ++_i) \
        __builtin_amdgcn_global_load_lds((const unsigned*)((const char*)(gbase) + (RA2[_i] * (unsigned)(ld) + C2[_i])), (LAS unsigned*)(lds + (bufoff) + ldsw + _i * 8192), 16, 0, 16); } \
    else { PG8_STAGE(bufoff, gbase, RA2, ld); } } while (0)
#define PG8_LDA(dst, b, h) do { if constexpr (FP8) { _Pragma("unroll") for (int m = 0; m < 4; ++m) dst##8[m] = __builtin_shufflevector(*(const LAS i32x4*)(lds + PG8_SA(b, h) + aoff + m * 2048), *(const LAS i32x4*)(lds + PG8_SA(b, h) + aoff + m * 2048 + 1024), 0, 1, 2, 3, 4, 5, 6, 7); } \
    else { _Pragma("unroll") for (int m = 0; m < 4; ++m) _Pragma("unroll") for (int k = 0; k < 2; ++k) dst[m][k] = *(const LAS bf16x8*)(lds + PG8_SA(b, h) + aoff + m * 2048 + k * 1024); } } while (0)
#define PG8_LDB(dst, b, h) do { if constexpr (FP8) { _Pragma("unroll") for (int n = 0; n < 2; ++n) dst##8[n] = __builtin_shufflevector(*(const LAS i32x4*)(lds + PG8_SB(b, h) + boff + n * 2048), *(const LAS i32x4*)(lds + PG8_SB(b, h) + boff + n * 2048 + 1024), 0, 1, 2, 3, 4, 5, 6, 7); } \
    else { _Pragma("unroll") for (int n = 0; n < 2; ++n) _Pragma("unroll") for (int k = 0; k < 2; ++k) dst[n][k] = *(const LAS bf16x8*)(lds + PG8_SB(b, h) + boff + n * 2048 + k * 1024); } } while (0)
#define PG8_MMA(ai, bj, At, Bt) do { __builtin_amdgcn_s_setprio(1); _Pragma("unroll") for (int m = 0; m < 4; ++m) _Pragma("unroll") for (int n = 0; n < 2; ++n) { \
        if constexpr (FP8) asm volatile("v_mfma_scale_f32_16x16x128_f8f6f4 %0, %1, %2, %0, %3, %3 op_sel_hi:[0,0,0]" : "+v"(acc[ai][bj][m][n]) : "v"(Bt##8[n]), "v"(At##8[m]), "v"(one8));   \
        else { _Pragma("unroll") for (int k = 0; k < 2; ++k) acc[ai][bj][m][n] = __builtin_amdgcn_mfma_f32_16x16x32_bf16(Bt[n][k], At[m][k], acc[ai][bj][m][n], 0, 0, 0); } } \
        __builtin_amdgcn_s_setprio(0); } while (0)
#define PG8_WAIT_V(n) asm volatile("s_waitcnt vmcnt(" #n ")" ::: "memory")
#define PG8_WAIT_L(n) asm volatile("s_waitcnt lgkmcnt(" #n ")" ::: "memory")
#define PG8_BAR __builtin_amdgcn_s_barrier()
#define PG8_SCHED __builtin_amdgcn_sched_barrier(0)
    Unit cur, nxt; int ui = 0;
    if (!S.next(0, cur)) return;
    f32x4 acc[2][2][4][2];
#pragma unroll
    for (int a = 0; a < 2; ++a)
#pragma unroll
        for (int b = 0; b < 2; ++b)
#pragma unroll
            for (int m = 0; m < 4; ++m)
#pragma unroll
                for (int n = 0; n < 2; ++n) acc[a][b][m][n] = (f32x4){0.f, 0.f, 0.f, 0.f};
    const int one8 = 0x7f7f7f7f;
    bf16x8 At[4][2], B0[2][2], B1[2][2]; i32x8 At8[4], B08[2], B18[2];
    const char* cA = cur.A; const char* cB = cur.B;
    S.a_ready(cur);
    PG8_STAGE(PG8_SB(0, 0), cB, RB2, cur.ldb); PG8_STAGE(PG8_SB(0, 1), cB + PG8_HS(cur.ldb), RB2, cur.ldb); PG8_STAGE(PG8_SA(0, 0), cA, RA2, cur.lda); PG8_STAGE(PG8_SA(0, 1), cA + PG8_HS(cur.lda), RA2, cur.lda);
    if (wr == 1) PG8_BAR;
    PG8_WAIT_V(2); PG8_BAR;
    PG8_STAGE(PG8_SB(1, 0), cB + kstep, RB2, cur.ldb); PG8_STAGE(PG8_SA(1, 0), cA + kstep, RA2, cur.lda); PG8_STAGE(PG8_SB(1, 1), cB + PG8_HS(cur.ldb) + kstep, RB2, cur.ldb);
    PG8_WAIT_V(6); PG8_BAR;
    for (;;) {
        const bool has_next = S.next(ui + 1, nxt);
        const char* nA = has_next ? nxt.A : cA; const char* nB = has_next ? nxt.B : cB;
        const int nt = cur.ntk;
        for (int t = 0; t < nt; t += 2) {
            const bool last = (t == nt - 2);
            const char* a1 = cA + (size_t)(t + 1) * kstep;
            const char* a2 = last ? nA : cA + (size_t)(t + 2) * kstep; const char* b2 = last ? nB : cB + (size_t)(t + 2) * kstep;
            const char* a3 = a2 + kstep; const char* b3 = b2 + kstep;
            const int lda1 = cur.lda, lda2 = (last && has_next) ? nxt.lda : cur.lda, ldb2 = (last && has_next) ? nxt.ldb : cur.ldb, kd1 = cur.kind, kd2 = (last && has_next) ? nxt.kind : cur.kind;
            if (last && has_next) S.a_ready(nxt);
            if constexpr (Epi::RESCALE) { const int ka = cur.kt0 + t; if (cur.kind == 0 && t > 0 && (ka == 8 || ka == 16)) { const int l2 = fresh_lane(); E.rescale(acc, cur, ka >> 3, wr, wc, l2 & 15, l2 >> 4); asm volatile("s_waitcnt vmcnt(0)" ::: "memory"); } }
            PG8_LDB(B0, 0, 0); PG8_LDB(B1, 0, 1); PG8_SCHED; PG8_LDA(At, 0, 0); PG8_STAGE_A(PG8_SA(1, 1), a1 + PG8_HS(lda1), lda1, kd1);
            PG8_WAIT_V(8); PG8_WAIT_L(0); PG8_BAR; PG8_MMA(0, 0, At, B0); PG8_MMA(0, 1, At, B1); PG8_BAR; PG8_SCHED;
            PG8_LDA(At, 0, 1); PG8_STAGE(PG8_SB(0, 0), b2, RB2, ldb2); PG8_STAGE(PG8_SB(0, 1), b2 + PG8_HS(ldb2), RB2, ldb2); PG8_STAGE_A(PG8_SA(0, 0), a2, lda2, kd2);
            PG8_WAIT_V(8); PG8_WAIT_L(0); PG8_BAR; PG8_MMA(1, 0, At, B0); PG8_MMA(1, 1, At, B1); PG8_BAR; PG8_SCHED;
            PG8_LDB(B0, 1, 0); PG8_LDB(B1, 1, 1); PG8_SCHED; PG8_LDA(At, 1, 0); PG8_STAGE_A(PG8_SA(0, 1), a2 + PG8_HS(lda2), lda2, kd2);
            PG8_WAIT_V(8); PG8_WAIT_L(0); PG8_BAR; PG8_MMA(0, 0, At, B0); PG8_MMA(0, 1, At, B1); PG8_BAR; PG8_SCHED;
            PG8_LDA(At, 1, 1); PG8_STAGE(PG8_SB(1, 0), b3, RB2, ldb2); PG8_STAGE(PG8_SB(1, 1), b3 + PG8_HS(ldb2), RB2, ldb2); PG8_STAGE_A(PG8_SA(1, 0), a3, lda2, kd2);
            PG8_WAIT_V(8); PG8_WAIT_L(0); PG8_BAR; PG8_MMA(1, 0, At, B0); PG8_MMA(1, 1, At, B1); PG8_BAR; PG8_SCHED;
        }
        if constexpr (ALIGN_EPI) { if (wr == 0) PG8_BAR; }
        if constexpr (FP8) asm volatile("s_nop 15\n\ts_nop 15" ::: "memory");
        if constexpr (Epi::RESCALE) { if (cur.kind == 0) { const int l2 = fresh_lane(); E.finalize(acc, cur, (cur.kt0 + nt - 1) >> 3, wr, wc, l2 & 15, l2 >> 4); } }
        if (cur.mode == 2) sk_store_partial(acc, X, wid);
        else { if (cur.mode != 0) {
#pragma unroll 1
                for (int pq = cur.peer, pe = cur.peer + (cur.mode == 1 ? 1 : cur.mode - 1); pq < pe; ++pq) sk_add_partial(acc, X, pq, wid); }
            const int l2 = fresh_lane(); E(acc, cur, wr, wc, l2 & 15, l2 >> 4); S.done(cur, l2); }
        if (!has_next) break;
#pragma unroll
        for (int a = 0; a < 2; ++a)
#pragma unroll
            for (int b = 0; b < 2; ++b)
#pragma unroll
                for (int m = 0; m < 4; ++m)
#pragma unroll
                    for (int n = 0; n < 2; ++n) acc[a][b][m][n] = (f32x4){0.f, 0.f, 0.f, 0.f};
        cur = nxt; cA = nA; cB = nB; ++ui;
        if constexpr (ALIGN_EPI) { if (wr == 1) PG8_BAR; }
    }
    PG8_WAIT_V(0);
    if constexpr (!ALIGN_EPI) { if (wr == 0) PG8_BAR; }
    PG8_BAR;
#undef PG8_SA
#undef PG8_SB
#undef PG8_STAGE
#undef PG8_HS
#undef PG8_STAGE_A
#undef PG8_LDA
#undef PG8_LDB
#undef PG8_MMA
#undef PG8_WAIT_V
#undef PG8_WAIT_L
#undef PG8_BAR
#undef PG8_SCHED
}

__device__ __forceinline__ u32x4 pack8(const f32x4& a, const f32x4& b) { u32x4 w; w.x = cvt_pk_bf16(a[0], a[1]); w.y = cvt_pk_bf16(a[2], a[3]); w.z = cvt_pk_bf16(b[0], b[1]); w.w = cvt_pk_bf16(b[2], b[3]); return w; }
__device__ __forceinline__ void unpack8(const u32x4& w, f32x4& a, f32x4& b) { a = (f32x4){bflo(w.x), bfhi(w.x), bflo(w.y), bfhi(w.y)}; b = (f32x4){bflo(w.z), bfhi(w.z), bflo(w.w), bfhi(w.w)}; }

struct EpiInProj {
    static constexpr bool PERM = true, RESCALE = false;
    bf16_t* P; bf16_t* G; const float* qn; const float* kn; const float* bgate; const float* rope; float isc;
    __device__ __forceinline__ void operator()(const f32x4 (&acc)[2][2][4][2], const Unit& u, int wr, int wc, int fr, int fq) const {
        const int T = u.pn, jt = u.pm % 17; const bool lat = (jt != 0);
        const int row0 = u.pm * BM + wr * 64 + fr;
        if (T >= 12) {
            const int c0 = (T - 12) * 256 + wc * 32 + 8 * fq;
            f32x4 bv[2][2];
#pragma unroll
            for (int bj = 0; bj < 2; ++bj)
#pragma unroll
                for (int n = 0; n < 2; ++n) bv[bj][n] = *(const f32x4*)(bgate + c0 + bj * HALF + 4 * n) * -LOG2E;
            const float ke = -isc * LOG2E;
            unsigned char* G8 = (unsigned char*)G + (T - 12) * 256 + wc * 64 + fq * 16;
#pragma unroll
            for (int ai = 0; ai < 2; ++ai)
#pragma unroll
                for (int m = 0; m < 4; ++m) { u32x4 w;
#pragma unroll
                    for (int bj = 0; bj < 2; ++bj)
#pragma unroll
                        for (int n = 0; n < 2; ++n) { const f32x4 z = acc[ai][bj][m][n] * ke + bv[bj][n]; unsigned d = 0;
#pragma unroll
                            for (int x = 0; x < 4; ++x) d |= (unsigned)(255.999f * __builtin_amdgcn_rcpf(1.0f + __builtin_amdgcn_exp2f(z[x]))) << (8 * x);
                            w[2 * bj + n] = d; }
                    *(u32x4*)(G8 + (size_t)(row0 + ai * HALF + m * 16) * PC) = w; }
            return;
        }
        if (T >= 5 && T <= 8) {
            const int c0 = T * 256 + wc * 32 + 8 * fq; const bool sl = (T >= 7);
#pragma unroll
            for (int ai = 0; ai < 2; ++ai)
#pragma unroll
                for (int m = 0; m < 4; ++m) { bf16_t* rowp = P + (size_t)(row0 + ai * HALF + m * 16) * PC + c0;
#pragma unroll
                    for (int bj = 0; bj < 2; ++bj) { f32x4 v0 = acc[ai][bj][m][0] * isc, v1 = acc[ai][bj][m][1] * isc;
                        if (sl) {
#pragma unroll
                            for (int x = 0; x < 4; ++x) { v0[x] = siluf_(v0[x]); v1[x] = siluf_(v1[x]); } }
                        const u32x4 w = pack8(v0, v1);
                        if (T <= 6) asm volatile("global_store_dwordx4 %0, %1, off sc1\n\ts_nop 1" :: "v"(rowp + bj * HALF), "v"(w) : "memory");
                        else *(u32x4*)(rowp + bj * HALF) = w; } }
            return;
        }
        const bool isv = ((T == 2 || T == 11) && wc >= 2);
        const bool donorm = (T <= 1) || (T == 2 && wc < 2);
        const bool dorope = lat && !isv;
        const float scale = (T <= 1 || T == 9 || T == 10) ? C2 : (T == 3 ? 0.125f : 1.0f);
        const float* gain = (T <= 1) ? qn : kn;
        f32x4 g1[2], g2[2];
        if (donorm) {
#pragma unroll
            for (int n = 0; n < 2; ++n) { g1[n] = *(const f32x4*)(gain + 8 * fq + 4 * n); g2[n] = *(const f32x4*)(gain + 32 + 8 * fq + 4 * n); }
        }
        const int cbase = T * 256 + 64 * wc + 8 * fq;
#pragma unroll
        for (int ai = 0; ai < 2; ++ai)
#pragma unroll
            for (int m = 0; m < 4; ++m) {
                f32x4 t1[2], t2[2];
#pragma unroll
                for (int n = 0; n < 2; ++n) { t1[n] = acc[ai][0][m][n] * isc; t2[n] = acc[ai][1][m][n] * isc; }
                if (donorm) {
                    float ss = 0.f;
#pragma unroll
                    for (int n = 0; n < 2; ++n)
#pragma unroll
                        for (int x = 0; x < 4; ++x) ss += t1[n][x] * t1[n][x] + t2[n][x] * t2[n][x];
                    ss += swz_xor<16>(ss); ss = xor32_sum(ss);
                    const float inv = rsqrtf(ss * (1.0f / 64.0f) + EPS);
#pragma unroll
                    for (int n = 0; n < 2; ++n) { t1[n] = t1[n] * inv * g1[n]; t2[n] = t2[n] * inv * g2[n]; }
                }
                if (dorope) {
                    const int grow = 4 * (jt - 1) + 2 * ai + wr, gcol = 16 * m + fr;
                    const int pos = (fq < 2) ? grow : gcol;
                    const float* rp = rope + ((size_t)pos * 16 + 8 * (fq & 1)) * 2;
#pragma unroll
                    for (int n = 0; n < 2; ++n) {
                        const f32x4 cs0 = *(const f32x4*)(rp + 8 * n), cs1 = *(const f32x4*)(rp + 8 * n + 4);
                        const f32x4 c = (f32x4){cs0[0], cs0[2], cs1[0], cs1[2]}, s = (f32x4){cs0[1], cs0[3], cs1[1], cs1[3]};
                        const f32x4 a = t1[n], b = t2[n];
                        t1[n] = a * c - b * s; t2[n] = a * s + b * c;
                    }
                }
#pragma unroll
                for (int n = 0; n < 2; ++n) { t1[n] = t1[n] * scale; t2[n] = t2[n] * scale; }
                bf16_t* rowp = P + (size_t)(row0 + ai * HALF + m * 16) * PC + cbase;
                const u32x4 w1 = pack8(t1[0], t1[1]), w2 = pack8(t2[0], t2[1]);
                if (T == 4) { asm volatile("global_store_dwordx4 %0, %1, off sc1\n\ts_nop 1" :: "v"(rowp), "v"(w1) : "memory"); asm volatile("global_store_dwordx4 %0, %1, off sc1\n\ts_nop 1" :: "v"(rowp + 32), "v"(w2) : "memory"); }
                else { *(u32x4*)(rowp) = w1; *(u32x4*)(rowp + 32) = w2; }
            }
    }
};

struct EpiBranch {
    static constexpr bool PERM = true, RESCALE = true;
    const bf16_t* G; bf16_t* MB;
    static __device__ __forceinline__ f32x4 dec4(unsigned w) { return (f32x4){(float)(w & 0xffu) + 0.5f, (float)((w >> 8) & 0xffu) + 0.5f, (float)((w >> 16) & 0xffu) + 0.5f, (float)(w >> 24) + 0.5f}; }
    __device__ __forceinline__ void rescale(f32x4 (&acc)[2][2][4][2], const Unit& u, int bnd, int wr, int wc, int fr, int fq) const {
        const int row0 = u.pm * BM + wr * 64 + fr; const unsigned char* gb = (const unsigned char*)G + (4 * (bnd - 1) + u.pn) * 256 + wc * 64 + fq * 16;
#pragma unroll
        for (int ai = 0; ai < 2; ++ai) {
            u32x4 gp[4], gc[4];
#pragma unroll
            for (int m = 0; m < 4; ++m) { const unsigned char* p = gb + (size_t)(row0 + ai * HALF + m * 16) * PC; gp[m] = *(const u32x4*)p; gc[m] = *(const u32x4*)(p + 1024); }
#pragma unroll
            for (int m = 0; m < 4; ++m)
#pragma unroll
                for (int bj = 0; bj < 2; ++bj)
#pragma unroll
                    for (int n = 0; n < 2; ++n) { const f32x4 a = dec4(gp[m][2 * bj + n]), b = dec4(gc[m][2 * bj + n]);
#pragma unroll
                        for (int x = 0; x < 4; ++x) acc[ai][bj][m][n][x] *= a[x] * __builtin_amdgcn_rcpf(b[x]); }
        }
    }
    __device__ __forceinline__ void finalize(f32x4 (&acc)[2][2][4][2], const Unit& u, int br, int wr, int wc, int fr, int fq) const {
        const int row0 = u.pm * BM + wr * 64 + fr; const unsigned char* gb = (const unsigned char*)G + (4 * br + u.pn) * 256 + wc * 64 + fq * 16;
#pragma unroll
        for (int ai = 0; ai < 2; ++ai) {
            u32x4 g2[4];
#pragma unroll
            for (int m = 0; m < 4; ++m) g2[m] = *(const u32x4*)(gb + (size_t)(row0 + ai * HALF + m * 16) * PC);
#pragma unroll
            for (int m = 0; m < 4; ++m)
#pragma unroll
                for (int bj = 0; bj < 2; ++bj)
#pragma unroll
                    for (int n = 0; n < 2; ++n) acc[ai][bj][m][n] = acc[ai][bj][m][n] * (dec4(g2[m][2 * bj + n]) * (1.0f / 256.0f));
        }
    }
    __device__ __forceinline__ void operator()(const f32x4 (&acc)[2][2][4][2], const Unit& u, int wr, int wc, int fr, int fq) const {
        const int row0 = u.pm * BM + wr * 64 + fr, c0 = u.pn * BM + wc * 32 + 8 * fq;
#pragma unroll
        for (int ai = 0; ai < 2; ++ai)
#pragma unroll
            for (int m = 0; m < 4; ++m)
#pragma unroll
                for (int bj = 0; bj < 2; ++bj) { const u32x4 w = pack8(acc[ai][bj][m][0], acc[ai][bj][m][1]); asm volatile("global_store_dwordx4 %0, %1, off sc1\n\ts_nop 1" :: "v"(MB + (size_t)(row0 + ai * HALF + m * 16) * D + c0 + bj * HALF), "v"(w) : "memory"); }
    }
};

struct EpiResid {
    static constexpr bool PERM = true, RESCALE = false;
    bf16_t* XS; const float* gate;
    __device__ __forceinline__ void operator()(const f32x4 (&acc)[2][2][4][2], const Unit& u, int wr, int wc, int fr, int fq) const {
        const int who = (u.pm % 17 == 0) ? 4 : (u.pm / 17);
        const float* gp = gate + (size_t)who * INC;
        const int row0 = u.pm * BM + wr * 64 + fr, c0 = u.pn * BM + wc * 32 + 8 * fq;
        f32x4 gv[2][2];
#pragma unroll
        for (int bj = 0; bj < 2; ++bj)
#pragma unroll
            for (int n = 0; n < 2; ++n) gv[bj][n] = *(const f32x4*)(gp + c0 + bj * HALF + n * 4);
#pragma unroll
        for (int ai = 0; ai < 2; ++ai) {
            u32x4 old[4][2];
#pragma unroll
            for (int m = 0; m < 4; ++m)
#pragma unroll
                for (int bj = 0; bj < 2; ++bj) old[m][bj] = *(const u32x4*)(XS + (size_t)(row0 + ai * HALF + m * 16) * D + c0 + bj * HALF);
#pragma unroll
            for (int m = 0; m < 4; ++m)
#pragma unroll
                for (int bj = 0; bj < 2; ++bj) { f32x4 oa, ob; unpack8(old[m][bj], oa, ob);
                    *(u32x4*)(XS + (size_t)(row0 + ai * HALF + m * 16) * D + c0 + bj * HALF) = pack8(oa + gv[bj][0] * acc[ai][bj][m][0], ob + gv[bj][1] * acc[ai][bj][m][1]); }
            asm volatile("" ::: "memory");
        }
    }
};

struct EpiSwiGLU {
    static constexpr bool PERM = true, RESCALE = false;
    bf16_t* H; int ldh;
    __device__ __forceinline__ void operator()(const f32x4 (&acc)[2][2][4][2], const Unit& u, int wr, int wc, int fr, int fq) const {
        const int row0 = u.pm * BM + wr * 64 + fr, c0 = u.pn * HALF + wc * 32 + 8 * fq;
#pragma unroll
        for (int ai = 0; ai < 2; ++ai)
#pragma unroll
            for (int m = 0; m < 4; ++m) { f32x4 v[2];
#pragma unroll
                for (int n = 0; n < 2; ++n)
#pragma unroll
                    for (int x = 0; x < 4; ++x) v[n][x] = siluf_(acc[ai][0][m][n][x]) * acc[ai][1][m][n][x];
                *(u32x4*)(H + (size_t)(row0 + ai * HALF + m * 16) * ldh + c0) = pack8(v[0], v[1]); }
    }
};

struct EpiSwiGLU8 {
    static constexpr bool PERM = true, RESCALE = false;
    unsigned char* H; int ldh; float isc, osc;
    __device__ __forceinline__ void operator()(const f32x4 (&acc)[2][2][4][2], const Unit& u, int wr, int wc, int fr, int fq) const {
        const int row0 = u.pm * BM + wr * 64 + fr, c0 = u.pn * HALF + wc * 32 + 8 * fq;
        const float ke = -isc * LOG2E, kk = isc * isc * osc;
#pragma unroll
        for (int ai = 0; ai < 2; ++ai)
#pragma unroll
            for (int m = 0; m < 4; ++m) { f32x4 v[2];
#pragma unroll
                for (int n = 0; n < 2; ++n)
#pragma unroll
                    for (int x = 0; x < 4; ++x) { const float a = acc[ai][0][m][n][x];
                        v[n][x] = (a * acc[ai][1][m][n][x]) * (kk * __builtin_amdgcn_rcpf(1.0f + __builtin_amdgcn_exp2f(a * ke))); }
                u32x2 w; w.x = pk4_fp8(v[0][0], v[0][1], v[0][2], v[0][3]); w.y = pk4_fp8(v[1][0], v[1][1], v[1][2], v[1][3]);
                *(u32x2*)(H + (size_t)(row0 + ai * HALF + m * 16) * ldh + c0) = w; }
    }
};

struct EpiMoEDown {
    static constexpr bool PERM = true, RESCALE = false;
    bf16_t* Y; const float* cw; float sc;
    __device__ __forceinline__ void operator()(const f32x4 (&acc)[2][2][4][2], const Unit& u, int wr, int wc, int fr, int fq) const {
        const int row0 = u.pm * BM + wr * 64 + fr, c0 = u.pn * BM + wc * 32 + 8 * fq;
#pragma unroll
        for (int ai = 0; ai < 2; ++ai)
#pragma unroll
            for (int m = 0; m < 4; ++m) { const int row = row0 + ai * HALF + m * 16; const float w = cw[row] * sc;
#pragma unroll
                for (int bj = 0; bj < 2; ++bj) *(u32x4*)(Y + (size_t)row * D + c0 + bj * HALF) = pack8(acc[ai][bj][m][0] * w, acc[ai][bj][m][1] * w); }
    }
};
template <class E0, class E1> struct EpiDual {
    static constexpr bool PERM = true, RESCALE = E0::RESCALE; static_assert(E0::PERM && E1::PERM, "dual phases stage B rows permuted for both kinds");
    E0 e0; E1 e1;
    __device__ __forceinline__ void rescale(f32x4 (&acc)[2][2][4][2], const Unit& u, int bnd, int wr, int wc, int fr, int fq) const { e0.rescale(acc, u, bnd, wr, wc, fr, fq); }
    __device__ __forceinline__ void finalize(f32x4 (&acc)[2][2][4][2], const Unit& u, int br, int wr, int wc, int fr, int fq) const { e0.finalize(acc, u, br, wr, wc, fr, fq); }
    __device__ __forceinline__ void operator()(const f32x4 (&acc)[2][2][4][2], const Unit& u, int wr, int wc, int fr, int fq) const { if (u.kind == 0) e0(acc, u, wr, wc, fr, fq); else e1(acc, u, wr, wc, fr, fq); }
};
}
namespace attn_body {
using bf16=unsigned short;
constexpr int D=64, QKP=3072  , OPITCH=1536  ;
constexpr int NW=8,QBLK=32,QB=QBLK*NW,KVBLK=64;
__device__ __forceinline__ int crow(int r,int hi){return (r&3)+8*(r>>2)+4*hi;}
#define SBAR() __builtin_amdgcn_sched_barrier(0)
__device__ __forceinline__ void wmask(f32x16&p0,f32x16&p1,int t,int qrel,int hi,int qoff){
  const float NEG=-INFINITY; const int base=64*(t-4)+4*hi-qrel-qoff;
  #pragma unroll
  for(int r=0;r<16;++r){const int d=base+(r&3)+8*(r>>2); if(d>128||d<-128)p0[r]=NEG; const int d1=d+32; if(d1>128||d1<-128)p1[r]=NEG;}
}

constexpr int NSLOT=3, SLOTB=8192;
constexpr int LDS_K=0, LDS_V=NSLOT*SLOTB, LDS_WS=2*NSLOT*SLOTB, LDS_OST=LDS_WS+NW*64*4, LDS_BYTES=LDS_OST+NW*4096;
__device__ __forceinline__ void glds16(const void*gsrc,unsigned lds_dst){unsigned keep;
  asm volatile("s_mov_b32 %0, m0\n\ts_mov_b32 m0, %2\n\ts_nop 0\n\tglobal_load_lds_dwordx4 %1, off\n\ts_mov_b32 m0, %0":"=&s"(keep):"v"(gsrc),"s"(lds_dst):"memory");}
__device__ __forceinline__ float max3f(float a,float b,float c){float r;asm("v_max3_f32 %0, %1, %2, %3":"=v"(r):"v"(a),"v"(b),"v"(c));return r;}
__device__ __forceinline__ float max2f(float a,float b){float r;asm("v_max_f32_e32 %0, %1, %2":"=v"(r):"v"(a),"v"(b));return r;}
__device__ __forceinline__ float fadd_s(float a,float b){float r;asm("v_add_f32_e32 %0, %1, %2":"=v"(r):"v"(a),"v"(b));return r;}
__device__ __forceinline__ float fsub_s(float a,float b){float r;asm("v_sub_f32_e32 %0, %1, %2":"=v"(r):"v"(a),"v"(b));return r;}
typedef float f32x2_t __attribute__((ext_vector_type(2))); typedef __bf16 bf16x2_t __attribute__((ext_vector_type(2)));
__device__ __forceinline__ unsigned cvtpk_s(float lo,float hi){f32x2_t v={lo,hi};bf16x2_t b=__builtin_convertvector(v,bf16x2_t);return __builtin_bit_cast(unsigned,b);}
#define WAIT_BAR(N) asm volatile("s_waitcnt vmcnt(" #N ") lgkmcnt(0)\n\ts_barrier":::"memory")

__device__ __forceinline__ void qkt(f32x16&p0,f32x16&p1,const char*Kslot,const bf16x8*qr,const f32x16&negm,int r32,int hi){
  const char*kb=Kslot+hi*1024+r32*16;
  #pragma unroll
  for(int d0=0;d0<4;++d0){
    const bf16x8 b0=*reinterpret_cast<const bf16x8*>(kb+d0*2048);
    const bf16x8 b1=*reinterpret_cast<const bf16x8*>(kb+d0*2048+512);
    if(d0==0){p0=__builtin_amdgcn_mfma_f32_32x32x16_bf16(b0,qr[0],negm,0,0,0);p1=__builtin_amdgcn_mfma_f32_32x32x16_bf16(b1,qr[0],negm,0,0,0);}
    else{p0=__builtin_amdgcn_mfma_f32_32x32x16_bf16(b0,qr[d0],p0,0,0,0);p1=__builtin_amdgcn_mfma_f32_32x32x16_bf16(b1,qr[d0],p1,0,0,0);}}
}
typedef __attribute__((address_space(3))) const char* lds_cptr;
typedef short v4i16_t __attribute__((ext_vector_type(4)));
__device__ __forceinline__ void kload8(bf16x8*kf,lds_cptr kp){
  kf[0]=*(const __attribute__((address_space(3))) bf16x8*)(kp);      kf[1]=*(const __attribute__((address_space(3))) bf16x8*)(kp+512);
  kf[2]=*(const __attribute__((address_space(3))) bf16x8*)(kp+2048); kf[3]=*(const __attribute__((address_space(3))) bf16x8*)(kp+2560);
  kf[4]=*(const __attribute__((address_space(3))) bf16x8*)(kp+4096); kf[5]=*(const __attribute__((address_space(3))) bf16x8*)(kp+4608);
  kf[6]=*(const __attribute__((address_space(3))) bf16x8*)(kp+6144); kf[7]=*(const __attribute__((address_space(3))) bf16x8*)(kp+6656);
}
__device__ __forceinline__ void kload2(bf16x8*kf,lds_cptr kp,int j){ kf[2*j]=*(const __attribute__((address_space(3))) bf16x8*)(kp+j*2048); kf[2*j+1]=*(const __attribute__((address_space(3))) bf16x8*)(kp+j*2048+512); }
__device__ __forceinline__ s16x4 vtr(lds_cptr p){ return __builtin_bit_cast(s16x4,__builtin_amdgcn_ds_read_tr16_b64_v4i16((__attribute__((address_space(3))) v4i16_t*)p)); }
__device__ __forceinline__ float rowmax(const f32x16&p0,const f32x16&p1){
  float a=max3f(p0[0],p0[1],p1[0]),b=max3f(p0[2],p0[3],p1[1]);a=max3f(a,p1[2],p1[3]);
  #pragma unroll
  for(int r=4;r<16;r+=4){a=max3f(a,p0[r],p0[r+1]);b=max3f(b,p0[r+2],p0[r+3]);a=max3f(a,p1[r],p1[r+1]);b=max3f(b,p1[r+2],p1[r+3]);}
  const float m=max2f(a,b);
  auto rr=__builtin_amdgcn_permlane32_swap(__float_as_uint(m),__float_as_uint(m),false,false);
  return max2f(__uint_as_float(rr[0]),__uint_as_float(rr[1]));
}
__device__ __forceinline__ void pv(f32x16*o,int vb,bf16x8 pa0,bf16x8 pa1,bf16x8 pa2,bf16x8 pa3){
  #pragma unroll
  for(int d0=0;d0<2;++d0){s16x4 lo[4],hi[4];
    #pragma unroll
    for(int ks=0;ks<4;++ks){
      asm volatile("ds_read_b64_tr_b16 %0,%1 offset:%c2":"=&v"(lo[ks]):"v"(vb),"i"(d0*4096+ks*1024):"memory");
      asm volatile("ds_read_b64_tr_b16 %0,%1 offset:%c2":"=&v"(hi[ks]):"v"(vb),"i"(d0*4096+ks*1024+512):"memory");}
    asm volatile("s_waitcnt lgkmcnt(0)":::"memory");SBAR();
    #define PK(k) (bf16x8){lo[k][0],lo[k][1],lo[k][2],lo[k][3],hi[k][0],hi[k][1],hi[k][2],hi[k][3]}
    o[d0]=__builtin_amdgcn_mfma_f32_32x32x16_bf16(pa0,PK(0),o[d0],0,0,0);
    o[d0]=__builtin_amdgcn_mfma_f32_32x32x16_bf16(pa1,PK(1),o[d0],0,0,0);
    o[d0]=__builtin_amdgcn_mfma_f32_32x32x16_bf16(pa2,PK(2),o[d0],0,0,0);
    o[d0]=__builtin_amdgcn_mfma_f32_32x32x16_bf16(pa3,PK(3),o[d0],0,0,0);
    #undef PK
  }
}

#ifndef ATTN_STORE16
#define ATTN_STORE16(p,v) (*(u32x4*)(p)=(v))
#endif
template<int THRL,int MODE> __device__ __forceinline__ void attn_unit(const bf16*Qu,const bf16*__restrict__ Kh,const bf16*__restrict__ Vh,bf16*Ou,const int NT,const int kgap,const int qoff,const float sink2,char*shm,const int tid){
  const int lane=tid&63,r32=lane&31,hi=lane>>5; const int wid=__builtin_amdgcn_readfirstlane(tid>>6);
  const bf16*Qw=Qu+(long)(wid*QBLK)*QKP;
  const unsigned lds0=(unsigned)(uintptr_t)shm;
  float*wsf=(float*)(shm+LDS_WS)+wid*64;
  const bf16*ksrc=Kh+(long)lane*QKP+wid*8;
  const bf16*vsrc=Vh+(long)(16*(wid&3)+(lane>>2))*QKP+(wid>>2)*32+(lane&3)*8;
  const unsigned kdst=lds0+LDS_K+wid*1024, vdst=lds0+LDS_V+wid*1024;
  #define ROWOFF(t) ((long)((t)*KVBLK+(((t)>=4)?kgap:0))*QKP)
  #define DMA_K(t,slot) glds16(ksrc+ROWOFF(t),(unsigned)__builtin_amdgcn_readfirstlane(kdst+(slot)))
  #define DMA_V(t,slot) glds16(vsrc+ROWOFF(t),(unsigned)__builtin_amdgcn_readfirstlane(vdst+(slot)))
  const int vb0=(int)(lds0+LDS_V)+((lane>>4)&1)*32+(lane&3)*8+(4*hi+((lane&15)>>2))*64;
  const char*Kbase=shm+LDS_K; bf16x8 kf[8];
  const lds_cptr shm3=(lds_cptr)shm; const lds_cptr kp0=shm3+LDS_K+hi*1024+r32*16; const lds_cptr vp0=shm3+LDS_V+((lane>>4)&1)*32+(lane&3)*8+(4*hi+((lane&15)>>2))*64;
  DMA_K(0,0);DMA_V(0,0);DMA_K(1,SLOTB);
  bf16x8 qr[4];
  #pragma unroll
  for(int d0=0;d0<4;++d0)qr[d0]=*reinterpret_cast<const bf16x8*>(&Qw[(long)r32*QKP+d0*16+hi*8]);
  float mhat=0.f,l_reg=0.f;f32x16 o[2];o[0]=f32x16{};o[1]=f32x16{};f32x16 negm=f32x16{};asm volatile("":"+v"(negm));
  const int qrel=wid*QBLK+r32;
  #define CMASK(P0,P1,t) do{ if(MODE==1&&(t)>=4)wmask(P0,P1,(t),qrel,hi,qoff); }while(0)
  bool resc=false;
  #define START(P0,P1) do{ const float rm=rowmax(P0,P1); resc=false; \
    { const float dl=rm; mhat=fadd_s(mhat,dl); \
      _Pragma("unroll") for(int r=0;r<16;++r){P0[r]=fsub_s(P0[r],dl);P1[r]=fsub_s(P1[r],dl);} \
      _Pragma("unroll") for(int r=0;r<16;++r)negm[r]=-mhat; asm volatile("":"+v"(negm)); } \
    _Pragma("unroll") for(int r=0;r<16;++r)P0[r]=__builtin_amdgcn_exp2f(P0[r]); }while(0)
  #define RESC() do{ if(resc){ asm volatile("s_waitcnt lgkmcnt(0)":::"memory"); \
      _Pragma("unroll") for(int d_=0;d_<2;++d_) _Pragma("unroll") for(int r=0;r<16;++r)o[d_][r]*=wsf[crow(r,hi)]; } }while(0)
  f32x16 pA0,pA1,pB0,pB1;
  int sl_prev=0,sl_cur=0,sl_next=SLOTB;
  #define ROT() do{sl_prev=sl_cur;sl_cur=sl_next;sl_next=(sl_next==(NSLOT-1)*SLOTB)?0:sl_next+SLOTB;}while(0)
  DMA_K(2,2*SLOTB);
  WAIT_BAR(3);
  qkt(pA0,pA1,Kbase,qr,negm,r32,hi);asm volatile("s_nop 15\n\ts_nop 7":"+v"(pA0),"+v"(pA1));CMASK(pA0,pA1,0);
  START(pA0,pA1);
  _Pragma("unroll") for(int r=0;r<16;++r)pA1[r]=__builtin_amdgcn_exp2f(pA1[r]);
  WAIT_BAR(0);
  DMA_K(3,0);DMA_V(1,SLOTB);
  ROT();
  kload8(kf,kp0+sl_cur);
  WAIT_BAR(2);
  s16x4 vlo[8],vhi[8]; u32x4 pw0,pw1,pw2,pw3;
  #define PKW(P,B) cvtpk_s(P[B],P[B+1])
  #define PAF(k) __builtin_bit_cast(bf16x8,pw##k)
  #define VFR(i) (bf16x8){vlo[i][0],vlo[i][1],vlo[i][2],vlo[i][3],vhi[i][0],vhi[i][1],vhi[i][2],vhi[i][3]}
  #define PIN(x) asm volatile("":"+v"(x))
  #define MX3(a,b,c) __builtin_fmaxf(__builtin_fmaxf((a),(b)),(c))
  #define GAPA(MF,A0,A1,A2,A3,W0,W1,PW) do{ MF; sacc+=A0; sacc+=A1; sacc+=A2; sacc+=A3; PIN(sacc); W0; W1; PIN(PW); SBAR(); }while(0)
  #define EX(v) __builtin_amdgcn_exp2f(v)
  #define GAPB(MF,X,B) do{ MF; X[B]=EX(X[B]); X[B+1]=EX(X[B+1]); X[B+2]=EX(X[B+2]); X[B+3]=EX(X[B+3]); PIN(X); SBAR(); }while(0)
  #define VRD(i) do{ vlo[i]=vtr(vp_+(((i)>>2)*4096+((i)&3)*1024)); vhi[i]=vtr(vp_+(((i)>>2)*4096+((i)&3)*1024+512)); }while(0)
  #define KRD(G,j) do{ if(G){ kload2(kf,kp0+sl_next,j); SBAR(); } }while(0)
  #define STEP(C0,C1,P0,P1,t,GK,GV,GL) do{ SBAR(); \
    const lds_cptr vp_=vp0+sl_prev; \
    VRD(0); SBAR(); float sacc=(P0[0]+P0[1]); \
    GAPA(C0=__builtin_amdgcn_mfma_f32_32x32x16_bf16(kf[0],qr[0],negm,0,0,0), P0[2],P0[3],P0[4],P0[5],     pw0[0]=PKW(P0,0), pw0[1]=PKW(P0,2), pw0); \
    VRD(4); SBAR(); GAPA(C1=__builtin_amdgcn_mfma_f32_32x32x16_bf16(kf[1],qr[0],negm,0,0,0), P0[6],P0[7],P0[8],P0[9],     pw0[2]=PKW(P0,4), pw0[3]=PKW(P0,6), pw0); \
    VRD(1); SBAR(); GAPA(C0=__builtin_amdgcn_mfma_f32_32x32x16_bf16(kf[2],qr[1],C0,0,0,0),   P0[10],P0[11],P0[12],P0[13], pw1[0]=PKW(P0,8), pw1[1]=PKW(P0,10), pw1); \
    VRD(5); SBAR(); GAPA(C1=__builtin_amdgcn_mfma_f32_32x32x16_bf16(kf[3],qr[1],C1,0,0,0),   P0[14],P0[15],P1[0],P1[1],   pw1[2]=PKW(P0,12),pw1[3]=PKW(P0,14), pw1); \
    VRD(2); SBAR(); GAPA(C0=__builtin_amdgcn_mfma_f32_32x32x16_bf16(kf[4],qr[2],C0,0,0,0),   P1[2],P1[3],P1[4],P1[5],     pw2[0]=PKW(P1,0), pw2[1]=PKW(P1,2), pw2); \
    VRD(6); SBAR(); GAPA(C1=__builtin_amdgcn_mfma_f32_32x32x16_bf16(kf[5],qr[2],C1,0,0,0),   P1[6],P1[7],P1[8],P1[9],     pw2[2]=PKW(P1,4), pw2[3]=PKW(P1,6), pw2); \
    VRD(3); SBAR(); GAPA(C0=__builtin_amdgcn_mfma_f32_32x32x16_bf16(kf[6],qr[3],C0,0,0,0),   P1[10],P1[11],P1[12],P1[13], pw3[0]=PKW(P1,8), pw3[1]=PKW(P1,10), pw3); \
    VRD(7); SBAR(); GAPA(C1=__builtin_amdgcn_mfma_f32_32x32x16_bf16(kf[7],qr[3],C1,0,0,0),   P1[14],P1[15],0.f,0.f,       pw3[2]=PKW(P1,12),pw3[3]=PKW(P1,14), pw3); \
    l_reg+=sacc; \
    if(GK){DMA_K((t)+3,sl_cur);} if(GV){DMA_V((t)+1,sl_next);} \
    CMASK(C0,C1,t); \
    { float a=MX3(C0[0],C0[1],C1[0]),b=MX3(C0[2],C0[3],C1[1]); a=MX3(a,C1[2],C1[3]); \
      _Pragma("unroll") for(int r=4;r<16;r+=4){a=MX3(a,C0[r],C0[r+1]);b=MX3(b,C0[r+2],C0[r+3]);a=MX3(a,C1[r],C1[r+1]);b=MX3(b,C1[r+2],C1[r+3]);} \
      float rm=__builtin_fmaxf(a,b); { auto rr=__builtin_amdgcn_permlane32_swap(__float_as_uint(rm),__float_as_uint(rm),false,false); rm=__builtin_fmaxf(__uint_as_float(rr[0]),__uint_as_float(rr[1])); } \
      resc=false; \
      if(__builtin_expect(__any(rm>(float)THRL),0)){ const float dl=__builtin_fmaxf(rm,0.f); mhat+=dl; \
        _Pragma("unroll") for(int r=0;r<16;++r){C0[r]-=dl;C1[r]-=dl;} \
        _Pragma("unroll") for(int r=0;r<16;++r)negm[r]=-mhat; asm volatile("":"+v"(negm)); \
        const float f=__builtin_amdgcn_exp2f(-dl); l_reg*=f; if(hi==0)wsf[r32]=f; resc=true; } } \
    SBAR(); \
    GAPB(o[0]=__builtin_amdgcn_mfma_f32_32x32x16_bf16(PAF(0),VFR(0),o[0],0,0,0), C0,0); \
    GAPB(o[1]=__builtin_amdgcn_mfma_f32_32x32x16_bf16(PAF(0),VFR(4),o[1],0,0,0), C0,4); \
    KRD(GL,0); GAPB(o[0]=__builtin_amdgcn_mfma_f32_32x32x16_bf16(PAF(1),VFR(1),o[0],0,0,0), C0,8); \
    KRD(GL,1); GAPB(o[1]=__builtin_amdgcn_mfma_f32_32x32x16_bf16(PAF(1),VFR(5),o[1],0,0,0), C0,12); \
    KRD(GL,2); GAPB(o[0]=__builtin_amdgcn_mfma_f32_32x32x16_bf16(PAF(2),VFR(2),o[0],0,0,0), C1,0); \
    KRD(GL,3); GAPB(o[1]=__builtin_amdgcn_mfma_f32_32x32x16_bf16(PAF(2),VFR(6),o[1],0,0,0), C1,4); \
    GAPB(o[0]=__builtin_amdgcn_mfma_f32_32x32x16_bf16(PAF(3),VFR(3),o[0],0,0,0), C1,8); \
    GAPB(o[1]=__builtin_amdgcn_mfma_f32_32x32x16_bf16(PAF(3),VFR(7),o[1],0,0,0), C1,12); \
    }while(0)
  int t=1;
  for(;t+5<NT;t+=2){
    STEP(pB0,pB1,pA0,pA1,t,true,true,true);     WAIT_BAR(2); RESC(); ROT();
    STEP(pA0,pA1,pB0,pB1,t+1,true,true,true);   WAIT_BAR(2); RESC(); ROT();
  }
  #define ENDW(tt) do{ if((tt)+3<NT){WAIT_BAR(2);} else if((tt)+2<NT){WAIT_BAR(1);} else {WAIT_BAR(0);} }while(0)
  for(;t+1<NT;t+=2){
    STEP(pB0,pB1,pA0,pA1,t,(t+3<NT),(t+1<NT),(t+1<NT));       ENDW(t);   RESC(); ROT();
    STEP(pA0,pA1,pB0,pB1,t+1,(t+4<NT),(t+2<NT),(t+2<NT));     ENDW(t+1); RESC(); ROT();
  }
  STEP(pB0,pB1,pA0,pA1,NT-1,false,false,false); RESC();
  { float sacc=pB0[0]+pB0[1]; _Pragma("unroll") for(int r=2;r<16;++r)sacc+=pB0[r]; _Pragma("unroll") for(int r=0;r<16;++r)sacc+=pB1[r]; l_reg+=sacc;
    pw0=(u32x4){PKW(pB0,0),PKW(pB0,2),PKW(pB0,4),PKW(pB0,6)};pw1=(u32x4){PKW(pB0,8),PKW(pB0,10),PKW(pB0,12),PKW(pB0,14)};pw2=(u32x4){PKW(pB1,0),PKW(pB1,2),PKW(pB1,4),PKW(pB1,6)};pw3=(u32x4){PKW(pB1,8),PKW(pB1,10),PKW(pB1,12),PKW(pB1,14)};
    SBAR(); pv(o,vb0+sl_cur,PAF(0),PAF(1),PAF(2),PAF(3)); }
  #undef PKW
  #undef PAF
  #undef VFR
  #undef PIN
  #undef MX3
  #undef GAPA
  #undef GAPB
  #undef EX
  #undef VRD
  #undef KRD
  #undef STEP
  #undef ENDW
  {auto rr=__builtin_amdgcn_permlane32_swap(__float_as_uint(l_reg),__float_as_uint(l_reg),false,false);l_reg=__uint_as_float(rr[0])+__uint_as_float(rr[1]);}
  l_reg+=__builtin_amdgcn_exp2f(sink2-mhat);
  if(hi==0)wsf[32+r32]=l_reg;asm volatile("s_waitcnt lgkmcnt(0)":::"memory");
  float rli[16];
  #pragma unroll
  for(int r=0;r<16;++r)rli[r]=__builtin_amdgcn_rcpf(wsf[32+crow(r,hi)]);
  bf16*Ow=Ou+(long)(wid*QBLK)*OPITCH;
  { bf16*stg=(bf16*)(shm+LDS_OST)+wid*2048;
    #pragma unroll
    for(int r=0;r<16;++r){const int orow=crow(r,hi);
      #pragma unroll
      for(int d0=0;d0<2;++d0)stg[orow*64+d0*32+r32]=(bf16)f2bf(o[d0][r]*rli[r]);}
    asm volatile("s_waitcnt lgkmcnt(0)":::"memory");
    #pragma unroll
    for(int i=0;i<4;++i){const int row=i*8+(lane>>3),ch=lane&7; const u32x4 v=*(const u32x4*)(stg+row*64+ch*8); ATTN_STORE16(Ow+(long)row*OPITCH+ch*8,v);} }
  asm volatile("s_waitcnt lgkmcnt(0)\n\ts_barrier":::"memory");
  #undef ROWOFF
  #undef DMA_K
  #undef DMA_V
  #undef CMASK
  #undef START
  #undef RESC
  #undef ROT
}
constexpr int ATTN_LDS_BYTES=LDS_BYTES;
#undef SBAR
#undef WAIT_BAR
}
__device__ __forceinline__ void wait_panel(unsigned* cnt, unsigned* tmo, int pm, int wave_s, unsigned need);
namespace ret {
constexpr int RSV = 136, RSK = 72;
constexpr int NCH = TPB / 128;
typedef short v4i16_t __attribute__((ext_vector_type(4)));
__device__ __forceinline__ s16x4 trd(const LAS char* p) { return __builtin_bit_cast(s16x4, __builtin_amdgcn_ds_read_tr16_b64_v4i16((LAS v4i16_t*)p)); }
#define RET_FRAG(lo, hi) (bf16x8){lo[0], lo[1], lo[2], lo[3], hi[0], hi[1], hi[2], hi[3]}
__device__ __forceinline__ size_t kvs_index(int dir, int b, int cidx, int hd) { return ((((size_t)dir * NB + b) * NCH + cidx) * 4 + hd) * 8192; }

__device__ __forceinline__ void stage_v(const bf16_t* P, int row0, int hd, LAS char* vimg, int tid) {
#pragma unroll
    for (int i = 0; i < 4; ++i) { const int c = tid + 512 * i, j = c >> 4, ch = c & 15;
        const u32x4 v = *(const u32x4*)(P + (size_t)(row0 + j) * PC + 1280 + 128 * hd + 8 * ch);
        *(LAS u32x4*)(vimg + (j * RSV + 8 * ch) * 2) = v; }
}

struct KvLoad { u32x4 kw[2], vv[4]; };
__device__ __forceinline__ void kvinc_load(const bf16_t* P, int u, const int tid, KvLoad& L) {
    const int b = u / (4 * NCH), hd = (u / NCH) & 3, cidx = u % NCH, row0 = b * TPB + 128 * cidx;
#pragma unroll
    for (int i = 0; i < 2; ++i) { const int c = tid + 512 * i, j = c >> 3, ch = c & 7; L.kw[i] = *(const u32x4*)(P + (size_t)(row0 + j) * PC + 1024 + 64 * hd + 8 * ch); }
#pragma unroll
    for (int i = 0; i < 4; ++i) { const int c = tid + 512 * i, j = c >> 4, ch = c & 15; L.vv[i] = *(const u32x4*)(P + (size_t)(row0 + j) * PC + 1280 + 128 * hd + 8 * ch); }
}
__device__ __forceinline__ void kvinc_units(const bf16_t* P, float* KVS, const float* rc, int u0, int ustep, int nU, unsigned* cnt, unsigned* tmo, int wave_s, LAS char* lds, const int tid) {
    const int lane = tid & 63, wid = __builtin_amdgcn_readfirstlane(tid >> 6), r = lane & 31, hh = lane >> 5;
    LAS char* kimg0 = lds; LAS char* kimg1 = lds + 128 * RSK * 2; LAS char* vimg = lds + 2 * 128 * RSK * 2;
    int u = u0; if (u >= nU) return;
    ::wait_panel(cnt, tmo, 17 * (u / (4 * NCH)) + ((u % NCH) >> 1), wave_s, 24u);
    KvLoad L; kvinc_load(P, u, tid, L);
#pragma unroll 1
    for (;;) {
        const int b = u / (4 * NCH), hd = (u / NCH) & 3, cidx = u % NCH;
        const float lgf2 = rc[2 * hd], lgb2 = rc[8 + 2 * hd];
#pragma unroll
        for (int i = 0; i < 2; ++i) { const int c = tid + 512 * i, j = c >> 3, ch = c & 7;
            const float wf = __builtin_amdgcn_exp2f((float)(127 - j) * lgf2), wb = __builtin_amdgcn_exp2f((float)j * lgb2);
            f32x4 a, bq; pg8::unpack8(L.kw[i], a, bq);
            *(LAS u32x4*)(kimg0 + (j * RSK + 8 * ch) * 2) = pg8::pack8(a * wf, bq * wf);
            *(LAS u32x4*)(kimg1 + (j * RSK + 8 * ch) * 2) = pg8::pack8(a * wb, bq * wb); }
#pragma unroll
        for (int i = 0; i < 4; ++i) { const int c = tid + 512 * i, j = c >> 4, ch = c & 15; *(LAS u32x4*)(vimg + (j * RSV + 8 * ch) * 2) = L.vv[i]; }
        LDS_WAIT(); __syncthreads();
        const int un = u + ustep;
        if (un < nU) { ::wait_panel(cnt, tmo, 17 * (un / (4 * NCH)) + ((un % NCH) >> 1), wave_s, 24u); kvinc_load(P, un, tid, L); }
        const int dir = wid >> 2, eb = wid & 3;
        const LAS char* kimg = dir ? kimg1 : kimg0;
        const int q = (lane & 15) >> 2, p = lane & 3, c16 = 16 * ((lane >> 4) & 1) + 4 * p;
        f32x16 acc[2]; acc[0] = f32x16{}; acc[1] = f32x16{};
#pragma unroll
        for (int ks = 0; ks < 8; ++ks) {
            const int j0 = 16 * ks + 8 * hh + q;
            const s16x4 vlo = trd(vimg + (j0 * RSV + 32 * eb + c16) * 2), vhi = trd(vimg + ((j0 + 4) * RSV + 32 * eb + c16) * 2);
            const bf16x8 vf = RET_FRAG(vlo, vhi);
#pragma unroll
            for (int db = 0; db < 2; ++db) {
                const s16x4 klo = trd(kimg + (j0 * RSK + 32 * db + c16) * 2), khi = trd(kimg + ((j0 + 4) * RSK + 32 * db + c16) * 2);
                acc[db] = __builtin_amdgcn_mfma_f32_32x32x16_bf16(RET_FRAG(klo, khi), vf, acc[db], 0, 0, 0);
            }
        }
        float* out = KVS + kvs_index(dir, b, cidx, hd);
#pragma unroll
        for (int db = 0; db < 2; ++db)
#pragma unroll
            for (int reg = 0; reg < 16; ++reg) { const int d = 32 * db + (reg & 3) + 8 * (reg >> 2) + 4 * hh; out[d * 128 + 32 * eb + r] = acc[db][reg]; }
        __syncthreads();
        if (un >= nU) break;
        u = un;
    }
}

__device__ __forceinline__ void scan_phase(const float* KVS, bf16_t* KVB, const float* retc_l, int gtid, int gthreads) {
    for (int idx = gtid; idx < 2 * NB * 4 * 4096; idx += gthreads) {
        const int el = (idx & 4095) * 2, seq = idx >> 12, hd = seq & 3, b = (seq >> 2) & 3, dir = seq >> 4;
        const float dec = retc_l[(dir * 4 + hd) * 2 + 1];
        const size_t off = kvs_index(dir, b, 0, hd) + el;
        f32x2 v[NCH];
#pragma unroll
        for (int n = 0; n < NCH; ++n) { const int cidx = dir == 0 ? n : (n < 2 ? 1 - n : 35 - n); v[n] = *(const f32x2*)(KVS + off + (size_t)cidx * 4 * 8192); }
        f32x2 st = (f32x2){0.f, 0.f};
#pragma unroll
        for (int n = 0; n < NCH; ++n) { const int cidx = dir == 0 ? n : (n < 2 ? 1 - n : 35 - n); *(unsigned*)(KVB + off + (size_t)cidx * 4 * 8192) = pk2(st[0], st[1]); st = st * dec + v[n]; }
    }
}

struct RetLoad { u32x4 vv[4], kk[2]; u32x2 hv[2][4]; bf16x8 qr[4]; };
__device__ __forceinline__ void retout_load(const bf16_t* P, const bf16_t* KVS, int u, const int tid, RetLoad& L) {
    const int b = u / (4 * NCH), hd = (u / NCH) & 3, cidx = u % NCH;
    const int lane = tid & 63, wid = __builtin_amdgcn_readfirstlane(tid >> 6), r = lane & 31, hh = lane >> 5;
    const int row0 = b * TPB + 128 * cidx, ib = wid & 3;
#pragma unroll
    for (int i = 0; i < 4; ++i) { const int c = tid + 512 * i, j = c >> 4, ch = c & 15; L.vv[i] = *(const u32x4*)(P + (size_t)(row0 + j) * PC + 1280 + 128 * hd + 8 * ch); }
#pragma unroll
    for (int i = 0; i < 2; ++i) { const int c = tid + 512 * i, j = c >> 3, ch = c & 7; L.kk[i] = *(const u32x4*)(P + (size_t)(row0 + j) * PC + 1024 + 64 * hd + 8 * ch); }
#pragma unroll
    for (int dir = 0; dir < 2; ++dir) { const bf16_t* H = KVS + kvs_index(dir, b, cidx, hd);
#pragma unroll
        for (int i = 0; i < 4; ++i) { const int c = tid + 512 * i; L.hv[dir][i] = *(const u32x2*)(H + (c >> 5) * 128 + (c & 31) * 4); } }
    const int iloc = 32 * ib + r;
#pragma unroll
    for (int d0 = 0; d0 < 4; ++d0) L.qr[d0] = *(const bf16x8*)(P + (size_t)(row0 + iloc) * PC + 768 + 64 * hd + 16 * d0 + 8 * hh);
}
__device__ __forceinline__ void retout_units(const bf16_t* P, const bf16_t* KVS, bf16_t* Y3, const float* gainl, const float* rc, int u0, int ustep, int nU, bool skip_ctx, LAS char* lds, const int tid) {
    const int lane = tid & 63, wid = __builtin_amdgcn_readfirstlane(tid >> 6), r = lane & 31, hh = lane >> 5;
    const int ib = wid & 3, eh = wid >> 2;
    LAS char* vimg = lds; LAS char* himg0 = lds + 128 * RSV * 2; LAS char* himg1 = himg0 + 64 * RSV * 2; LAS char* kimg = himg1 + 64 * RSV * 2;
    LAS float* part1 = (LAS float*)(kimg + 128 * RSK * 2); LAS float* part2 = part1 + 256;
    const int nV = skip_ctx ? (nU / NCH) * (NCH - 2) : nU;
#define RET_UNIT_OF(v) (skip_ctx ? ((v) / (NCH - 2)) * NCH + 2 + (v) % (NCH - 2) : (v))
    int vi = u0; if (vi >= nV) return;
    int u = RET_UNIT_OF(vi);
    RetLoad L; retout_load(P, KVS, u, tid, L);
#pragma unroll 1
    for (;;) {
    const int b = u / (4 * NCH), hd = (u / NCH) & 3, cidx = u % NCH;
    const float lgf2 = rc[2 * hd], lgb2 = rc[8 + 2 * hd];
    const int row0 = b * TPB + 128 * cidx;
    const int iloc = 32 * ib + r;
    bf16x8 qr[4];
#pragma unroll
    for (int d0 = 0; d0 < 4; ++d0) qr[d0] = L.qr[d0];
#pragma unroll
    for (int i = 0; i < 4; ++i) { const int c = tid + 512 * i, j = c >> 4, ch = c & 15; *(LAS u32x4*)(vimg + (j * RSV + 8 * ch) * 2) = L.vv[i]; }
#pragma unroll
    for (int i = 0; i < 2; ++i) { const int c = tid + 512 * i, j = c >> 3, ch = c & 7; *(LAS u32x4*)(kimg + (j * RSK + 8 * ch) * 2) = L.kk[i]; }
#pragma unroll
    for (int dir = 0; dir < 2; ++dir) { LAS char* himg = dir ? himg1 : himg0;
#pragma unroll
        for (int i = 0; i < 4; ++i) { const int c = tid + 512 * i, d = c >> 5, e4 = (c & 31) * 4; *(LAS u32x2*)(himg + (d * RSV + e4) * 2) = L.hv[dir][i]; } }
    LDS_WAIT(); __syncthreads();
    const int vn = vi + ustep, un = RET_UNIT_OF(vn);
    if (vn < nV) retout_load(P, KVS, un, tid, L);
    const int q = (lane & 15) >> 2, p = lane & 3, c16 = 16 * ((lane >> 4) & 1) + 4 * p;
    f32x16 O[2]; O[0] = f32x16{}; O[1] = f32x16{};
#pragma unroll 2
    for (int jb = 0; jb < 4; ++jb) {
        f32x16 X = f32x16{};
#pragma unroll
        for (int d0 = 0; d0 < 4; ++d0) { const bf16x8 kf = *(const LAS bf16x8*)(kimg + ((32 * jb + r) * RSK + 16 * d0 + 8 * hh) * 2);
            X = __builtin_amdgcn_mfma_f32_32x32x16_bf16(kf, qr[d0], X, 0, 0, 0); }
#pragma unroll
        for (int reg = 0; reg < 16; ++reg) { const int jloc = 32 * jb + (reg & 3) + 8 * (reg >> 2) + 4 * hh, dl = iloc - jloc;
            const float w0 = __builtin_amdgcn_exp2f((float)dl * (dl > 0 ? lgf2 : -lgb2));
            X[reg] *= (dl == 0) ? 2.0f : w0; }
        u32x4 pw[2];
        pw[0] = (u32x4){pk2(X[0], X[1]), pk2(X[2], X[3]), pk2(X[4], X[5]), pk2(X[6], X[7])};
        pw[1] = (u32x4){pk2(X[8], X[9]), pk2(X[10], X[11]), pk2(X[12], X[13]), pk2(X[14], X[15])};
#pragma unroll
        for (int s = 0; s < 2; ++s) { const int j0 = 32 * jb + 16 * s + 4 * hh + q;
#pragma unroll
            for (int eb = 0; eb < 2; ++eb) { const int ec = 32 * (2 * eh + eb) + c16;
                const s16x4 lo = trd(vimg + (j0 * RSV + ec) * 2), hi = trd(vimg + ((j0 + 8) * RSV + ec) * 2);
                O[eb] = __builtin_amdgcn_mfma_f32_32x32x16_bf16(__builtin_bit_cast(bf16x8, pw[s]), RET_FRAG(lo, hi), O[eb], 0, 0, 0); } }
    }
#pragma unroll
    for (int dir = 0; dir < 2; ++dir) {
        const float fac = dir == 0 ? __builtin_amdgcn_exp2f((float)(iloc + 1) * lgf2) : __builtin_amdgcn_exp2f((float)(128 - iloc) * lgb2);
        const LAS char* himg = dir ? himg1 : himg0;
#pragma unroll
        for (int d0 = 0; d0 < 4; ++d0) {
            f32x4 a, bq; pg8::unpack8(__builtin_bit_cast(u32x4, qr[d0]), a, bq);
            const u32x4 qs = (u32x4){pk2(a[0] * fac, a[1] * fac), pk2(a[2] * fac, a[3] * fac), pk2(bq[0] * fac, bq[1] * fac), pk2(bq[2] * fac, bq[3] * fac)};
            const int dd0 = 16 * d0 + 8 * hh + q;
#pragma unroll
            for (int eb = 0; eb < 2; ++eb) { const int ec = 32 * (2 * eh + eb) + c16;
                const s16x4 lo = trd(himg + (dd0 * RSV + ec) * 2), hi = trd(himg + ((dd0 + 4) * RSV + ec) * 2);
                O[eb] = __builtin_amdgcn_mfma_f32_32x32x16_bf16(__builtin_bit_cast(bf16x8, qs), RET_FRAG(lo, hi), O[eb], 0, 0, 0); } }
    }
    u32x4 sgv[4]; f32x4 gn0[4], gn1[4];
#pragma unroll
    for (int i = 0; i < 4; ++i) { const int c = tid + 512 * i, row = c >> 4, ch = c & 15;
        sgv[i] = *(const u32x4*)(P + (size_t)(row0 + row) * PC + 1792 + 128 * hd + 8 * ch);
        gn0[i] = *(const f32x4*)(gainl + 128 * hd + 8 * ch); gn1[i] = *(const f32x4*)(gainl + 128 * hd + 8 * ch + 4); }
    float mean[16], rstd[16];
#pragma unroll
    for (int reg = 0; reg < 16; ++reg) mean[reg] = half_sum(O[0][reg] + O[1][reg]);
    if (r == 0) {
#pragma unroll
        for (int reg = 0; reg < 16; ++reg) part1[eh * 128 + 32 * ib + (reg & 3) + 8 * (reg >> 2) + 4 * hh] = mean[reg]; }
    LDS_WAIT(); __syncthreads();
#pragma unroll
    for (int reg = 0; reg < 16; ++reg) { const int i = 32 * ib + (reg & 3) + 8 * (reg >> 2) + 4 * hh; mean[reg] = (part1[i] + part1[128 + i]) * (1.0f / 128.0f); }
#pragma unroll
    for (int reg = 0; reg < 16; ++reg) { const float d0 = O[0][reg] - mean[reg], d1 = O[1][reg] - mean[reg]; rstd[reg] = half_sum(d0 * d0 + d1 * d1); }
    if (r == 0) {
#pragma unroll
        for (int reg = 0; reg < 16; ++reg) part2[eh * 128 + 32 * ib + (reg & 3) + 8 * (reg >> 2) + 4 * hh] = rstd[reg]; }
    LDS_WAIT(); __syncthreads();
#pragma unroll
    for (int reg = 0; reg < 16; ++reg) { const int i = 32 * ib + (reg & 3) + 8 * (reg >> 2) + 4 * hh; rstd[reg] = rsqrtf((part2[i] + part2[128 + i]) * (1.0f / 128.0f) + EPS); }
    LAS bf16_t* yimg = (LAS bf16_t*)vimg;
#pragma unroll
    for (int eb = 0; eb < 2; ++eb) { const int e = 32 * (2 * eh + eb) + r;
#pragma unroll
        for (int reg = 0; reg < 16; ++reg) { const int i = 32 * ib + (reg & 3) + 8 * (reg >> 2) + 4 * hh; yimg[i * RSV + e] = (bf16_t)f2bf((O[eb][reg] - mean[reg]) * rstd[reg]); } }
    LDS_WAIT(); __syncthreads();
#pragma unroll
    for (int i = 0; i < 4; ++i) { const int c = tid + 512 * i, row = c >> 4, ch = c & 15;
        const u32x4 yv = *(const LAS u32x4*)(vimg + (row * RSV + 8 * ch) * 2);
        f32x4 ya, yb, sa, sb; pg8::unpack8(yv, ya, yb); pg8::unpack8(sgv[i], sa, sb);
        *(u32x4*)(Y3 + (size_t)(row0 + row) * 1536 + 512 + 128 * hd + 8 * ch) = pg8::pack8(ya * gn0[i] * sa, yb * gn1[i] * sb); }
    LDS_WAIT(); __syncthreads();
    if (vn >= nV) break;
    vi = vn; u = un;
    }
#undef RET_UNIT_OF
}
}
struct MatD { const float* src; bf16_t* dst; int K, N, mode, nitems, ldd; float q8; };
__device__ __forceinline__ MatD mat_desc(int id, unsigned char* ws) {
    MatD m;
    if (id < 4) { m.src = KIN(I_w_in) + (size_t)id * D * INC; m.K = D; m.N = INC; m.dst = WSP(bf16_t, WS_WIN) + (size_t)id * INC * D; m.mode = 1; }
    else if (id < 16) { const int q = id - 4, l = q / 3, br = q - 3 * l; m.src = KIN(I_w_br_a + br) + (size_t)l * 512 * D; m.K = 512; m.N = D; m.dst = WSP(bf16_t, WS_WBR) + (size_t)l * D * 1536 + br * 512; m.mode = 0; }
    else if (id < 20) { const int l = id - 16; m.src = KIN(I_w_out) + (size_t)l * D * D; m.K = D; m.N = D; m.dst = WSP(bf16_t, WS_WOUT) + (size_t)l * D * D; m.mode = 0; }
    else if (id < 24) { const int q = id - 20, j = q >> 1, wh = q & 1; m.src = KIN(wh ? I_ffn_w3 : I_ffn_w1) + (size_t)j * D * DFF; m.K = D; m.N = DFF; m.dst = WSP(bf16_t, WS_W13) + (size_t)j * 2 * DFF * D; m.mode = 2 + wh; }
    else if (id < 26) { const int j = id - 24; m.src = KIN(I_ffn_w2) + (size_t)j * DFF * D; m.K = DFF; m.N = D; m.dst = WSP(bf16_t, WS_W2) + (size_t)j * D * DFF; m.mode = 0; }
    else if (id < 58) { const int q = id - 26, je = q >> 1, wh = q & 1; m.src = KIN(wh ? I_exp_w3 : I_exp_w1) + (size_t)je * D * DFE; m.K = D; m.N = DFE; m.dst = (bf16_t*)(ws + WS_E13 + (size_t)je * 2 * DFE * D); m.mode = 2 + wh; }
    else { const int je = id - 58; m.src = KIN(I_exp_w2) + (size_t)je * DFE * D; m.K = DFE; m.N = D; m.dst = (bf16_t*)(ws + WS_E2 + (size_t)je * D * DFE); m.mode = 0; }
    m.nitems = (m.K / 64) * (m.N / 32); m.ldd = (id >= 4 && id < 16) ? 1536 : m.K; m.q8 = id >= 58 ? FP8_SC_W2 : (id >= 26 ? FP8_SC_W13 : 0.f);
    return m;
}
struct ItemRef { const float* src; bf16_t* dst; int K, N, ldd; float q8; };
struct ItemIt { int id, id_end, base, g, W; };
__device__ __forceinline__ bool item_next(ItemIt& it, unsigned char* ws, ItemRef& r) {
    while (it.id < it.id_end) { const MatD m = mat_desc(it.id, ws);
        if (it.g < it.base + m.nitems) { const int item = it.g - it.base; it.g += it.W;
            const int nblk = m.N / 32, kb = item / nblk, nb = item - kb * nblk, k0 = 64 * kb, n0 = 32 * nb;
            int drow0 = n0;
            if (m.mode == 1) { const int T = n0 >> 8, cl = n0 & 255; const bool head = (T <= 4) || (T >= 9 && T <= 11); if (head) drow0 = 256 * T + 128 * ((cl >> 5) & 1) + 32 * (cl >> 6); }
            else if (m.mode >= 2) { drow0 = 256 * (n0 >> 7) + 128 * (m.mode - 2) + (n0 & 127); }
            r.src = m.src + (size_t)k0 * m.N + n0; r.q8 = m.q8; r.dst = m.q8 > 0.f ? (bf16_t*)((unsigned char*)m.dst + (size_t)drow0 * m.ldd + k0) : m.dst + (size_t)drow0 * m.ldd + k0; r.K = m.K; r.N = m.N; r.ldd = m.ldd;
            if (m.mode == 1 && ((g1_mask(it.id) >> (n0 >> 8)) & 1u)) { r.q8 = FP8_SC_WG; r.dst = (bf16_t*)((unsigned char*)m.dst + WG8_OFF + (size_t)drow0 * D + k0); }
            return true; }
        it.base += m.nitems; ++it.id; }
    return false;
}
__device__ __forceinline__ void tr_load(const ItemRef& r, float (&v)[32], int lane) {
    const float* p = r.src + (size_t)(lane >> 5) * r.N + (lane & 31);
#pragma unroll
    for (int i = 0; i < 32; ++i) v[i] = __builtin_nontemporal_load(p + (size_t)(2 * i) * r.N);
}
__device__ __forceinline__ void tr_store(const ItemRef& r, const float (&v)[32], LAS float* scr, int lane) {
#pragma unroll
    for (int i = 0; i < 32; ++i) { const int kk = 2 * i + (lane >> 5); scr[kk * 33 + (lane & 31)] = v[i]; }
    LDS_WAIT(); asm volatile("" ::: "memory");
    if (r.q8 > 0.f) {
#pragma unroll
        for (int jj = 0; jj < 2; ++jj) { const int ch = lane + 64 * jj, n = ch >> 2, c4 = ch & 3; const LAS float* s = scr + (16 * c4) * 33 + n; float e[16];
#pragma unroll
            for (int x = 0; x < 16; ++x) e[x] = s[x * 33] * r.q8;
            u32x4 o; o.x = pk4_fp8(e[0], e[1], e[2], e[3]); o.y = pk4_fp8(e[4], e[5], e[6], e[7]); o.z = pk4_fp8(e[8], e[9], e[10], e[11]); o.w = pk4_fp8(e[12], e[13], e[14], e[15]);
            *(u32x4*)((unsigned char*)r.dst + (size_t)n * r.ldd + 16 * c4) = o; }
        LDS_WAIT(); asm volatile("" ::: "memory");
        return;
    }
    const int c = lane & 7;
#pragma unroll
    for (int j = 0; j < 4; ++j) { const int n = (lane >> 3) + 8 * j; const LAS float* s = scr + (8 * c) * 33 + n;
        u32x4 o; o.x = pg8::cvt_pk_bf16(s[0 * 33], s[1 * 33]); o.y = pg8::cvt_pk_bf16(s[2 * 33], s[3 * 33]); o.z = pg8::cvt_pk_bf16(s[4 * 33], s[5 * 33]); o.w = pg8::cvt_pk_bf16(s[6 * 33], s[7 * 33]);
        *(u32x4*)(r.dst + (size_t)n * r.ldd + 8 * c) = o; }
    LDS_WAIT(); asm volatile("" ::: "memory");
}
__device__ __forceinline__ void convert_mats(unsigned char* ws, LAS unsigned char* lds, int rank, int nrank, int wave, int lane, int id0, int id1) {
    LAS float* scr = (LAS float*)(lds + wave * 8704);
    ItemIt it{id0, id1, 0, rank * NWAVES + wave, nrank * NWAVES};
    ItemRef ra, rb; float va[32], vb[32];
    bool ha = item_next(it, ws, ra);
    if (ha) tr_load(ra, va, lane);
#pragma unroll 1
    while (ha) {
        const bool hb = item_next(it, ws, rb);
        if (hb) tr_load(rb, vb, lane);
        tr_store(ra, va, scr, lane);
        if (!hb) break;
        ha = item_next(it, ws, ra);
        if (ha) tr_load(ra, va, lane);
        tr_store(rb, vb, scr, lane);
    }
}

struct Ptrs {
    const float *x, *c, *ctx, *c_ctx, *w_ada, *b_ada, *norm1_g, *norm2_g, *final_g, *w_in, *b_gate, *qn_a, *kn_a, *ret_a, *ret_g, *sink_c,
                *w_br_a, *w_br_b, *w_br_c, *w_out, *ffn_w1, *ffn_w3, *ffn_w2, *router_w, *router_b, *exp_w1, *exp_w3, *exp_w2;
};

__device__ __forceinline__ void prologue_phase(const Ptrs& I, unsigned char* ws, LAS unsigned char* lds, int tid, int lane, int wave, int G) {
    LAS float* sv = (LAS float*)(lds + 69632);
    LAS float* part = (LAS float*)(lds + 69632 + 20480);
    for (int i = tid; i < 5 * 1024; i += NTHR) { const int who = i >> 10, k = i & 1023; const float cv = who < 4 ? I.c[who * 1024 + k] : I.c_ctx[k]; sv[i] = siluf_(cv); }
    LDS_WAIT(); __syncthreads();
    float* MODS = (float*)(ws + WS_MODS);
#ifdef DUP_MODS
    for (int rep = 0; rep < 2; ++rep)
#endif
    for (int it = blockIdx.x; it < DEPTH * 48; it += G) {
        const int l = it / 48, cg = it % 48, col = cg * 128 + 2 * lane;
        const float* wp = I.w_ada + ((size_t)l * 1024 + wave * 128) * INC + col;
        f32x2 a0 = {0.f, 0.f}, a1 = a0, a2 = a0, a3 = a0, a4 = a0;
#pragma unroll 16
        for (int k = 0; k < 128; ++k) { const f32x2 w = *(const f32x2*)(wp + (size_t)k * INC); const int kk = wave * 128 + k;
            a0 += sv[kk] * w; a1 += sv[1024 + kk] * w; a2 += sv[2048 + kk] * w; a3 += sv[3072 + kk] * w; a4 += sv[4096 + kk] * w; }
        *(LAS f32x2*)(part + (wave * 5 + 0) * 128 + 2 * lane) = a0; *(LAS f32x2*)(part + (wave * 5 + 1) * 128 + 2 * lane) = a1; *(LAS f32x2*)(part + (wave * 5 + 2) * 128 + 2 * lane) = a2;
        *(LAS f32x2*)(part + (wave * 5 + 3) * 128 + 2 * lane) = a3; *(LAS f32x2*)(part + (wave * 5 + 4) * 128 + 2 * lane) = a4;
        LDS_WAIT(); __syncthreads();
        for (int o = tid; o < 640; o += NTHR) { const int who = o >> 7, ln = o & 127; float s = I.b_ada[(size_t)l * INC + cg * 128 + ln];
#pragma unroll
            for (int w = 0; w < 8; ++w) s += part[(w * 5 + who) * 128 + ln];
            MODS[((size_t)l * 5 + who) * INC + cg * 128 + ln] = s; }
        __syncthreads();
    }
    if (blockIdx.x == G - 1) { float* R = (float*)(ws + WS_ROPE);
        for (int i = tid; i < 1024; i += NTHR) { const int pos = i >> 4, f = i & 15; const float inv = powf(10000.0f, -(float)f / 16.0f); const float ang = (float)pos * inv; R[2 * i] = cosf(ang); R[2 * i + 1] = sinf(ang); } }
    if (blockIdx.x == (G > 1 ? G - 2 : 0) && tid < DEPTH * 8) { float* RC = (float*)(ws + WS_RETC); const float a = I.ret_a[tid]; const float lg = -log1pf(expf(-a)); RC[2 * tid] = lg * LOG2E; RC[2 * tid + 1] = expf(128.0f * lg); }
    convert_mats(ws, lds, blockIdx.x, G, wave, lane, 0, 74);
}

struct NormArgs {
    const float* g; const float* shift; const float* scale;
    const float* gate2p; const bf16_t* Y; const int* DST;
    const LAS float* rw; const float* rb; LAS int* route; int* PE; float* PW;
    unsigned char* hn8;
};
struct RowJob { const float* src; const bf16_t* srcb; bf16_t* xs_out; bf16_t* hn; int row; NormArgs A; };
struct RowData { u32x4 x[4]; u32x2 y0[4], y1[4]; };
struct NormStat { f32x4 am[4], sh[4], gt[4]; const float* key; };
template <bool COMB> __device__ __forceinline__ void norm_idx(const RowJob& J, int (&d)[2]) { if constexpr (COMB) { d[0] = J.A.DST[2 * J.row]; d[1] = J.A.DST[2 * J.row + 1]; } }
template <bool SRC32, bool COMB> __device__ __forceinline__ void norm_load(const RowJob& J, const int (&d)[2], RowData& R, int lane) {
#pragma unroll
    for (int j = 0; j < 4; ++j) { const int c = 4 * lane + 256 * j;
        if constexpr (SRC32) R.x[j] = *(const u32x4*)(J.src + c); else { const u32x2 t = *(const u32x2*)(J.srcb + c); R.x[j].x = t.x; R.x[j].y = t.y; } }
    if constexpr (COMB) {
#pragma unroll
        for (int j = 0; j < 4; ++j) { const int c = 4 * lane + 256 * j; R.y0[j] = *(const u32x2*)(J.A.Y + (size_t)d[0] * D + c); R.y1[j] = *(const u32x2*)(J.A.Y + (size_t)d[1] * D + c); } }
}
template <bool COMB> __device__ __forceinline__ void norm_stat_build(const RowJob& J, const f32x4 (&gq)[4], NormStat& S, int lane) {
#pragma unroll
    for (int j = 0; j < 4; ++j) { const int c = 4 * lane + 256 * j; const f32x4 sc = *(const f32x4*)(J.A.scale + c); S.sh[j] = *(const f32x4*)(J.A.shift + c); S.am[j] = gq[j] * (sc + 1.0f);
        if constexpr (COMB) S.gt[j] = *(const f32x4*)(J.A.gate2p + c); }
    S.key = J.A.shift;
}
template <bool SRC32, bool COMB> __device__ __forceinline__ void norm_finish(const RowJob& J, const RowData& R, const NormStat& S, int lane) {
    const NormArgs& A = J.A; const int row = J.row; bf16_t* xs_out = J.xs_out; bf16_t* hn = J.hn;
    f32x4 v[4]; float ss = 0.f;
#pragma unroll
    for (int j = 0; j < 4; ++j) { if constexpr (SRC32) v[j] = __builtin_bit_cast(f32x4, R.x[j]); else v[j] = (f32x4){bflo(R.x[j].x), bfhi(R.x[j].x), bflo(R.x[j].y), bfhi(R.x[j].y)}; }
    if constexpr (COMB) {
#pragma unroll
        for (int j = 0; j < 4; ++j) { const u32x2 y0 = R.y0[j], y1 = R.y1[j]; const f32x4 gt = S.gt[j];
            v[j][0] += gt[0] * (bflo(y0.x) + bflo(y1.x)); v[j][1] += gt[1] * (bfhi(y0.x) + bfhi(y1.x)); v[j][2] += gt[2] * (bflo(y0.y) + bflo(y1.y)); v[j][3] += gt[3] * (bfhi(y0.y) + bfhi(y1.y)); } }
    if (xs_out) {
#pragma unroll
        for (int j = 0; j < 4; ++j) { u32x2 w; w.x = pk2(v[j][0], v[j][1]); w.y = pk2(v[j][2], v[j][3]); *(u32x2*)(xs_out + 4 * lane + 256 * j) = w; } }
#pragma unroll
    for (int j = 0; j < 4; ++j) ss += (v[j][0] * v[j][0] + v[j][1] * v[j][1]) + (v[j][2] * v[j][2] + v[j][3] * v[j][3]);
    const float rs = rsqrtf(wave_sum(ss) * (1.0f / D) + EPS);
    float lg[8];
#pragma unroll
    for (int e = 0; e < 8; ++e) lg[e] = 0.f;
#pragma unroll
    for (int j = 0; j < 4; ++j) { const int c = 4 * lane + 256 * j;
        f32x4 h = v[j] * rs * S.am[j] + S.sh[j];
        if (hn) { u32x2 w; w.x = pk2(h[0], h[1]); w.y = pk2(h[2], h[3]); *(u32x2*)(hn + c) = w; }
        if (A.hn8) { const f32x4 q = h * FP8_SC_X; *(unsigned*)(A.hn8 + c) = pk4_fp8(q[0], q[1], q[2], q[3]); }
        if (A.rw) {
#pragma unroll
            for (int e = 0; e < 8; ++e) { const f32x4 r = *(const LAS f32x4*)(A.rw + e * 1024 + c); lg[e] += (h[0] * r[0] + h[1] * r[1]) + (h[2] * r[2] + h[3] * r[3]); } } }
    if (A.rw) {
#pragma unroll
        for (int e = 0; e < 8; ++e) lg[e] = wave_sum(lg[e]) + A.rb[e];
        int i1 = 0; float v1 = lg[0];
#pragma unroll
        for (int e = 1; e < 8; ++e) if (lg[e] > v1) { v1 = lg[e]; i1 = e; }
        int i2 = -1; float v2 = -INFINITY;
#pragma unroll
        for (int e = 0; e < 8; ++e) if (e != i1 && lg[e] > v2) { v2 = lg[e]; i2 = e; }
        if (i2 < 0) i2 = (i1 + 1) & 7;
        if (lane == 0) { const float w1 = 1.0f / (1.0f + __expf(v2 - v1));
            A.route[0] = i1; A.route[1] = i2;
            A.PE[2 * row] = i1; A.PE[2 * row + 1] = i2; A.PW[2 * row] = w1; A.PW[2 * row + 1] = 1.0f - w1; }
    }
}
template <bool SRC32, bool COMB, class F> __device__ __forceinline__ void norm_rows(int first, int stride, int end, const F& f, int lane) {
    if (first >= end) return;
    RowJob J, Jt; RowData A, B, C; NormStat S; int dn[2] = {0, 0};
    f(first, J);
    f32x4 gq[4];
#pragma unroll
    for (int j = 0; j < 4; ++j) gq[j] = *(const f32x4*)(J.A.g + 4 * lane + 256 * j);
    norm_stat_build<COMB>(J, gq, S, lane);
    norm_idx<COMB>(J, dn); norm_load<SRC32, COMB>(J, dn, A, lane);
    if (first + stride < end) { f(first + stride, Jt); norm_idx<COMB>(Jt, dn); norm_load<SRC32, COMB>(Jt, dn, B, lane); }
    { const int ri = first + 2 * stride < end ? first + 2 * stride : end - 1; f(ri, Jt); norm_idx<COMB>(Jt, dn); }
    int r = first;
#define NR_STEP(LD, FIN, k) { const int rl = r + ((k) + 2) * stride, rf = r + (k) * stride; \
        if (rl < end) { f(rl, Jt); norm_load<SRC32, COMB>(Jt, dn, LD, lane); } \
        if constexpr (COMB) { const int ri = rl + stride < end ? rl + stride : end - 1; f(ri, Jt); norm_idx<COMB>(Jt, dn); }     \
        f(rf, J); if (J.A.shift != S.key) norm_stat_build<COMB>(J, gq, S, lane); norm_finish<SRC32, COMB>(J, FIN, S, lane); \
        if (rf + stride >= end) break; }
#pragma unroll 1
    for (;;) {
        NR_STEP(C, A, 0)
        NR_STEP(A, B, 1)
        NR_STEP(B, C, 2)
        r += 3 * stride;
    }
#undef NR_STEP
}
struct SchedPlain {
    const char* A; const char* B; size_t aTile, bTile; int nM, nN, G, c; bool latOnly; int ntk, lda, ldb;
    __device__ __forceinline__ void a_ready(const pg8::Unit&) const {}
    __device__ __forceinline__ void done(const pg8::Unit&, int) const {}
    __device__ __forceinline__ bool next(int i, pg8::Unit& u) const {
        int pm, pn; if (!pg8::tile_of((long)i * G + c, nM, nN, pm, pn)) return false;
        if (latOnly) pm = pm + pm / 16 + 1;
        u.pm = pm; u.pn = pn; u.aux = 0; u.ntk = ntk; u.mode = 0; u.peer = 0; u.kt0 = 0; u.kind = 0; u.lda = lda; u.ldb = ldb; u.A = A + (size_t)pm * aTile; u.B = B + (size_t)pn * bTile; return true; }
};
template <int KIND> struct SchedG1 {
    const char* A; const char* B; int nM, G, c; unsigned mask; unsigned* cnt;
    __device__ __forceinline__ bool next(int i, pg8::Unit& u) const {
        const unsigned mk = KIND ? mask : (~mask & 0xFFFFFFu), mkA = mk & 0x70u, mkB = mk & ~0x70u;
        const int nA = __builtin_popcount(mkA), nB = __builtin_popcount(mkB); const long L = (long)i * G + (KIND ? G - 1 - c : c), LA = (long)nM * nA;
        int pm, j, pn;
        if (L < LA) { pg8::tile_of(L, nM, nA, pm, j); pn = nth_bit(mkA, j); }
        else { if (nB == 0 || !pg8::tile_of(L - LA, nM, nB, pm, j)) return false; pn = nth_bit(mkB, j); }
        u.pm = pm; u.pn = pn; u.aux = 0; u.mode = 0; u.peer = 0; u.kt0 = 0; u.kind = 0;
        if (KIND) { u.ntk = D / 128; u.lda = D / 2; u.ldb = D / 2; u.A = A + (size_t)pm * (256 * D); u.B = B + (size_t)pn * (256 * D); }
        else { u.ntk = D / 64; u.lda = D; u.ldb = D; u.A = A + (size_t)pm * (256 * D * 2); u.B = B + (size_t)pn * (256 * D * 2); }
        return true; }
    __device__ __forceinline__ void a_ready(const pg8::Unit&) const {}
    __device__ __forceinline__ void done(const pg8::Unit& u, int lane) const {
        if (u.pn >= 4 && u.pn <= 6) { asm volatile("s_waitcnt vmcnt(0)" ::: "memory"); if (lane == 0) __hip_atomic_fetch_add(cnt + 32 * u.pm, 1u, __ATOMIC_RELAXED, __HIP_MEMORY_SCOPE_AGENT); } }
};
struct SchedMoE {
    const char* A; const char* B; size_t aTile, bTile, eStride; int nM, nN, G, c; int ts1, ts2, ts3, ts4, ts5, ts6, ts7; int ntk, lda, ldb;
    __device__ __forceinline__ void a_ready(const pg8::Unit&) const {}
    __device__ __forceinline__ void done(const pg8::Unit&, int) const {}
    __device__ __forceinline__ bool next(int i, pg8::Unit& u) const {
        int pm, pn; if (!pg8::tile_of((long)i * G + c, nM, nN, pm, pn)) return false;
        const int e = (pm >= ts1) + (pm >= ts2) + (pm >= ts3) + (pm >= ts4) + (pm >= ts5) + (pm >= ts6) + (pm >= ts7);
        u.pm = pm; u.pn = pn; u.aux = e; u.ntk = ntk; u.mode = 0; u.peer = 0; u.kt0 = 0; u.kind = 0; u.lda = lda; u.ldb = ldb; u.A = A + (size_t)pm * aTile; u.B = B + (size_t)e * eStride + (size_t)pn * bTile; return true; }
};
template <int P> struct SchedSK {
    const char* A; const char* B; size_t aTile, bTile, eStride; int U, G, vc; bool latOnly; int ts1, ts2, ts3, ts4, ts5, ts6, ts7; int s, e; int lda, ldb;
    __device__ __forceinline__ void a_ready(const pg8::Unit&) const {}
    __device__ __forceinline__ void done(const pg8::Unit&, int) const {}
    __device__ __forceinline__ int bound(int c) const { const unsigned b = (unsigned)c * (unsigned)(U * P) / (unsigned)G; int u = (int)(b / (unsigned)P), o = (int)b - u * P; if (o < 2) o = 0; else if (o > P - 2) { o = 0; ++u; } return u * P + o; }
    __device__ __forceinline__ void init() { s = bound(vc); e = bound(vc + 1); }
    __device__ __forceinline__ bool next(int i, pg8::Unit& u) const {
        const int u0 = s / P, un = u0 + i, st = (i == 0) ? s : un * P; if (st >= e) return false;
        const int uend = (un + 1) * P, en = e < uend ? e : uend, o = st - un * P, oe = en - un * P;
        u.mode = (o > 0) ? 2 : (oe < P ? 1 : 0); u.peer = vc + 1; u.ntk = 2 * (oe - o); u.kt0 = 2 * o; u.kind = 0; u.lda = lda; u.ldb = ldb;
        const int nP = U >> 2; const int pn = un / nP; int pm = un - pn * nP;
        const int ex = (pm >= ts1) + (pm >= ts2) + (pm >= ts3) + (pm >= ts4) + (pm >= ts5) + (pm >= ts6) + (pm >= ts7);
        if (latOnly) pm = pm + pm / 16 + 1;
        u.pm = pm; u.pn = pn; u.aux = ex; u.A = A + (size_t)pm * aTile + (size_t)o * 256; u.B = B + (size_t)ex * eStride + (size_t)pn * bTile + (size_t)o * 256; return true; }
};

template <int P> struct SchedWR {
    const char* A; const char* B; size_t aTile, bTile, eStride; int nP  , G, c; bool latOnly; int ts1, ts2, ts3, ts4, ts5, ts6, ts7; int lda, ldb;
    __device__ __forceinline__ void a_ready(const pg8::Unit&) const {}
    __device__ __forceinline__ void done(const pg8::Unit&, int) const {}
    __device__ __forceinline__ bool next(int i, pg8::Unit& u) const {
        const int U = nP * 4, R = U / G, rem = U - R * G; int p, q = -1;
        const int S = (P >= 16 && 4 * rem <= G) ? 4 : 2;
        if (i < R) p = i * G + c;
        else if (i == R && 2 * rem <= G) { if (c >= S * rem) return false; p = R * G + c / S; q = c % S; }
        else if (i == R) { p = R * G + c; if (p >= U) return false; }
        else return false;
        int pm, pn; pg8::tile_of((long)p, nP, 4, pm, pn);
        const int ex = (pm >= ts1) + (pm >= ts2) + (pm >= ts3) + (pm >= ts4) + (pm >= ts5) + (pm >= ts6) + (pm >= ts7);
        if (latOnly) pm = pm + pm / 16 + 1;
        const int base = P / S, extra = P % S;
        const int o = q < 0 ? 0 : q * base + (q < extra ? q : extra), np = q < 0 ? P : base + (q < extra ? 1 : 0);
        u.pm = pm; u.pn = pn; u.aux = ex; u.kind = 0; u.lda = lda; u.ldb = ldb; u.peer = c + 1; u.mode = q < 0 ? 0 : (q == 0 ? (S == 2 ? 1 : S) : 2); u.kt0 = 2 * o; u.ntk = 2 * np;
        u.A = A + (size_t)pm * aTile + (size_t)o * 256; u.B = B + (size_t)ex * eStride + (size_t)pn * bTile + (size_t)o * 256; return true; }
};
struct SchedM1 {
    const char* Y3; const char* WBR; unsigned* cnt; int c; bool ctx;
    __device__ __forceinline__ bool next(int i, pg8::Unit& u) const {
        int pm, pn;
        if (i == 0) { if (!pg8::tile_of((long)c, 64, 4, pm, pn)) return false; pm = pm + pm / 16 + 1; u.mode = 0; u.kt0 = 0; u.ntk = 24; }
        else if (i == 1 && ctx && c < 48) { const int e = c / 3, br = c - 3 * e; pm = 17 * (e >> 2); pn = e & 3; u.mode = br == 0 ? 3 : 2; u.kt0 = 8 * br; u.ntk = 8; }
        else return false;
        u.pm = pm; u.pn = pn; u.aux = 0; u.kind = 0; u.lda = 1536; u.ldb = 1536; u.peer = c + 1;
        u.A = Y3 + (size_t)pm * (256 * 1536 * 2) + (size_t)u.kt0 * 128; u.B = WBR + (size_t)pn * (256 * 1536 * 2) + (size_t)u.kt0 * 128; return true; }
    __device__ __forceinline__ void a_ready(const pg8::Unit&) const {}
    __device__ __forceinline__ void done(const pg8::Unit& u, int lane) const {
        asm volatile("s_waitcnt vmcnt(0)" ::: "memory"); if (lane == 0) __hip_atomic_fetch_add(cnt + 32 * u.pm, 1u, __ATOMIC_RELAXED, __HIP_MEMORY_SCOPE_AGENT); }
};
struct SchedM2One {
    const char* MB; const char* WOUT; int c; bool ctx; int which;
    __device__ __forceinline__ bool unit(pg8::Unit& u) const {
        int pm, pn;
        if (which == 1) { if (!pg8::tile_of((long)((c + 32) & 255), 64, 4, pm, pn)) return false; pm = pm + pm / 16 + 1; u.mode = 0; u.kt0 = 0; u.ntk = 16; }
        else if (ctx && c >= 224 && c < 256) { const int q = c - 224, e = q >> 1, half = q & 1; pm = 17 * (e >> 2); pn = e & 3; u.mode = half == 0 ? 1 : 2; u.kt0 = 8 * half; u.ntk = 8; }
        else return false;
        u.pm = pm; u.pn = pn; u.aux = 0; u.peer = c + 1; u.kind = 0; u.lda = 1024; u.ldb = 1024;
        u.A = MB + (size_t)pm * (256 * 1024 * 2) + (size_t)u.kt0 * 128; u.B = WOUT + (size_t)pn * (256 * 1024 * 2) + (size_t)u.kt0 * 128; return true; }
    __device__ __forceinline__ bool next(int i, pg8::Unit& u) const { return i == 0 && unit(u); }
    __device__ __forceinline__ void a_ready(const pg8::Unit&) const {}
    __device__ __forceinline__ void done(const pg8::Unit&, int) const {}
};
__device__ __forceinline__ void wait_panel(unsigned* cnt, unsigned* tmo, int pm, int wave_s, unsigned need) {
    if (wave_s == 0) { unsigned spins = 0;
        while ((unsigned)__builtin_amdgcn_readfirstlane(__hip_atomic_load(cnt + 32 * pm, __ATOMIC_RELAXED, __HIP_MEMORY_SCOPE_AGENT)) < need) {
            __builtin_amdgcn_s_sleep(1);
            if (++spins > (1u << 18)) { __hip_atomic_store(tmo, 1u, __ATOMIC_RELAXED, __HIP_MEMORY_SCOPE_AGENT); break; } }
        __builtin_amdgcn_fence(__ATOMIC_ACQUIRE, "agent");
        asm volatile("s_waitcnt vmcnt(0)" ::: "memory"); }
    __syncthreads();
}

struct Args { Ptrs in; float* out; unsigned char* ws; };
static_assert(sizeof(Args) == 30 * 8, "Args layout");
__global__ void __launch_bounds__(NTHR, 2) fwd_kernel(Args) {
    extern __shared__ __attribute__((aligned(16))) unsigned char lds_raw[];
    LAS unsigned char* lds = (LAS unsigned char*)lds_raw;
    volatile LAS unsigned* MISC = (volatile LAS unsigned*)(lds + MISC_OFF);
    const int G = gridDim.x, bx = blockIdx.x, wave_s = __builtin_amdgcn_readfirstlane((int)threadIdx.x >> 6);
#define PHASE_IDS() const int tid = fresh_tid(wave_s), lane = tid & 63, wave = __builtin_amdgcn_readfirstlane(tid >> 6), gw = bx * NWAVES + wave, NGW = G * NWAVES; (void)lane; (void)gw; (void)NGW
    const int vcu = (G % 8 == 0) ? (bx % 8) * (G / 8) + bx / 8 : bx;
    for (int u = threadIdx.x; u < (LDS_BYTES - LDSCTL_OFF) / 4; u += NTHR) ((LAS unsigned*)(lds + LDSCTL_OFF))[u] = 0u;
    __syncthreads();
    (void)xcd_barrier_post((unsigned*)(KWS() + WS_CTL) + CW_BAR, MISC + 8);
#ifdef TPROBE
#ifndef TPROBE_L0
#define TPROBE_L0 -1
#define TPROBE_L1 99
#endif
    int tp_l = -1;
#define TP(type) do { if (bx == 0 && fresh_tid(wave_s) == 0) { const unsigned now_ = (unsigned)__builtin_amdgcn_s_memrealtime(); if (tp_l >= TPROBE_L0 && tp_l <= TPROBE_L1) MISC[16 + (type)] += now_ - MISC[15]; MISC[15] = now_; } } while (0)
#else
#define TP(type) do {} while (0)
#endif
#define GRID_BAR() do { XcdBarrier b_; b_.bar = (unsigned*)(KWS() + WS_CTL) + CW_BAR; b_.x = xb_xcc_id(); b_.st = MISC + 8; xcd_barrier(b_); } while (0)

#ifdef TPROBE
    if (bx == 0 && fresh_tid(wave_s) == 0) MISC[15] = (unsigned)__builtin_amdgcn_s_memrealtime();
#endif
#ifndef SKIP_P0
    {
        PHASE_IDS(); Ptrs I; { const float** pp = (const float**)&I; kargp_t kp = kfresh();
#pragma unroll
            for (int i = 0; i < 28; ++i) pp[i] = ((const float* const __attribute__((address_space(4)))*)kp)[i]; }
        prologue_phase(I, KWS(), lds, tid, lane, wave, G);
#ifdef DUP_P0
        __syncthreads(); prologue_phase(I, KWS(), lds, tid, lane, wave, G);
#endif
    }
#endif
    GRID_BAR(); TP(0);

#pragma unroll 1
    for (int l = 0; l < DEPTH; ++l) {
        const bool need_ctx = (l < DEPTH - 1), moe = (l & 1) != 0; const int jf = l >> 1;
#ifdef TPROBE
        tp_l = l;
#endif
#ifndef SKIP_N1
        {
            PHASE_IDS(); unsigned char* ws = KWS(); bf16_t* XS = WSP(bf16_t, WS_XS); bf16_t* HN = WSP(bf16_t, WS_HN); const float* MODS = WSP(float, WS_MODS);
            const float* modl = MODS + (size_t)l * 5 * INC;
            const bool comb = (l == 2);
            const float* xin = KIN(I_x); const float* cin = KIN(I_ctx); const float* g1 = KIN(I_norm1_g) + (size_t)l * D;
            const bf16_t* YYp = WSP(bf16_t, WS_R2); const int* DSTp = (const int*)(ws + WS_META + MT_DST);
            struct N1Job { int l; bool comb, hn16; bf16_t* XS; bf16_t* HN; unsigned char* HN8; const float* MODS; const float* modl; const float* xin; const float* cin; const float* g1; const bf16_t* Y; const int* DST;
                __device__ __forceinline__ void operator()(int row, RowJob& J) const {
                    const int b = row / TPB, tq = row - b * TPB, who = tq < CTXL ? 4 : b;
                    J.src = (l == 0) ? (tq < CTXL ? cin + ((size_t)b * CTXL + tq) * D : xin + ((size_t)b * SEQ + (tq - CTXL)) * D) : nullptr; J.srcb = XS + (size_t)row * D;
                    J.xs_out = (l == 0 || comb) ? XS + (size_t)row * D : nullptr; J.hn = hn16 ? HN + (size_t)row * D : nullptr; J.row = row;
                    J.A = NormArgs{}; J.A.g = g1; J.A.shift = modl + (size_t)who * INC; J.A.scale = modl + (size_t)who * INC + D; J.A.hn8 = HN8 + (size_t)row * D;
                    if (comb) { J.A.gate2p = MODS + ((size_t)(l - 1) * 5 + who) * INC + 5 * D; J.A.Y = Y; J.A.DST = DST; } } };
            const N1Job job{l, comb, (g1_mask(l) & 0xFFFFFFu) != 0xFFFFFFu  , XS, HN, ws + WS_HN8, MODS, modl, xin, cin, g1, YYp, DSTp};
            { const int RPB = (M + G - 1) / G, r0 = bx * RPB, r1 = (r0 + RPB < M) ? r0 + RPB : M; if (l == 0) norm_rows<true, false>(r0 + wave, NWAVES, r1, job, lane); else if (comb) norm_rows<false, true>(r0 + wave, NWAVES, r1, job, lane); else norm_rows<false, false>(r0 + wave, NWAVES, r1, job, lane); }
        }
#endif
        GRID_BAR(); TP(1);
#ifdef DUP_BAR
        for (int r_ = 0; r_ < 8; ++r_) GRID_BAR();
#endif
#ifndef SKIP_G1
        {
            unsigned char* ws = KWS();
            unsigned* cnt = WSP(unsigned, WS_CTL) + CW_PAN + (4 + l) * 68 * 32;
            {
                SchedG1<0> S{(const char*)WSP(bf16_t, WS_HN), (const char*)(WSP(bf16_t, WS_WIN) + (size_t)l * INC * D), NMT, G, bx, g1_mask(l), cnt};
                pg8::EpiInProj E{WSP(bf16_t, WS_P), WSP(bf16_t, WS_G), KIN(I_qn_a) + l * 64, KIN(I_kn_a) + l * 64, KIN(I_b_gate) + (size_t)l * 3 * D, WSP(float, WS_ROPE), 1.0f};
                pg8::gemm_phase<pg8::EpiInProj, SchedG1<0>, true>(lds, fresh_tid(wave_s), S, E);
            }
            {
                unsigned char* ws2 = KWS();
                SchedG1<1> S{(const char*)(ws2 + WS_HN8), (const char*)(ws2 + WS_WIN + (size_t)l * INC * D * 2 + WG8_OFF), NMT, G, bx, g1_mask(l), (unsigned*)(ws2 + WS_CTL) + CW_PAN + (4 + l) * 68 * 32};
                pg8::EpiInProj E{(bf16_t*)(ws2 + WS_P), (bf16_t*)(ws2 + WS_G), KIN(I_qn_a) + l * 64, KIN(I_kn_a) + l * 64, KIN(I_b_gate) + (size_t)l * 3 * D, (const float*)(ws2 + WS_ROPE), 1.0f / (FP8_SC_X * FP8_SC_WG)};
                pg8::gemm_phase<pg8::EpiInProj, SchedG1<1>, true, true>(lds, fresh_tid(wave_s), S, E);
            }
            TP(3);
            {
                const int nf = __builtin_popcount(g1_mask(l)), remb = (NMT * (24 - nf)) % G, remf = (NMT * nf) % G; const bool mid = remb + remf < G; const int nidle = mid ? G - remb - remf : G, rank = mid ? bx - remb : bx;
                if (rank >= 0 && rank < nidle)
                    ret::kvinc_units(WSP(bf16_t, WS_P), WSP(float, WS_KVS), WSP(float, WS_RETC) + l * 16, rank, nidle, NB * 4 * ret::NCH, cnt, WSP(unsigned, WS_CTL) + CW_TMO, wave_s, (LAS char*)lds, fresh_tid(wave_s));
            }
        }
#endif
        GRID_BAR(); TP(2);
#ifndef SKIP_A2
        { PHASE_IDS(); unsigned char* ws = KWS(); ret::scan_phase(WSP(float, WS_KVS), WSP(bf16_t, WS_KVB), WSP(float, WS_RETC) + l * 16, bx * NTHR + tid, G * NTHR); }
#endif
        GRID_BAR(); TP(4);
#ifndef SKIP_RO
        {
            unsigned char* ws = KWS(); const float* rc = WSP(float, WS_RETC) + l * 16; const float* rg = KIN(I_ret_g) + (size_t)l * 512;
            ret::retout_units(WSP(bf16_t, WS_P), WSP(bf16_t, WS_KVB), WSP(bf16_t, WS_Y3), rg, rc, bx, G, NB * 4 * ret::NCH, !need_ctx, (LAS char*)lds, fresh_tid(wave_s));
        }
#endif
        TP(7);
#ifndef SKIP_AT0
        {
            unsigned char* ws = KWS(); const bf16_t* P = WSP(bf16_t, WS_P); bf16_t* Y3 = WSP(bf16_t, WS_Y3); const float* snk = KIN(I_sink_c) + l * 8;
            const int nU0 = 512 + (need_ctx ? 64 : 0);
#pragma unroll 1
            for (int k = 0;; ++k) {
                int uu;
                if (G == 256) { if (k < 2) uu = (vcu >> 5) * 64 + (vcu & 31) * 2 + k; else if (k == 2 && bx >= 32 && bx < 96 && need_ctx) uu = 512 + (bx - 32); else break; }
                else { uu = bx + k * G; if (uu >= nU0) break; }
                const bf16_t *Qu, *Kh, *Vh; bf16_t* Ou; int NT; float sk = -INFINITY;
                if (uu < 512) {
                    const int xs = uu >> 6, b = xs >> 1, kvh = xs & 1, h = 4 * kvh + ((uu >> 4) & 3), qb = uu & 15;
                    const size_t rb = (size_t)b * TPB, rq = rb + 256 + 256 * qb;
                    Qu = P + rq * PC + 64 * h; Kh = P + rb * PC + 512 + 64 * kvh; Vh = P + rb * PC + 640 + 64 * kvh; Ou = Y3 + rq * 1536 + 64 * h; NT = 68;
                } else {
                    const int v = uu - 512, type = v >> 5, b = (v >> 3) & 3, h = v & 7, kvh = h >> 2; const size_t rb = (size_t)b * TPB;
                    if (type) sk = snk[h] * LOG2E;
                    Qu = P + rb * PC + (type ? 2304 : 0) + 64 * h; Kh = P + rb * PC + (type ? 2816 : 512) + 64 * kvh; Vh = P + rb * PC + (type ? 2944 : 640) + 64 * kvh; Ou = Y3 + rb * 1536 + (type ? 1024 : 0) + 64 * h; NT = 4;
                }
                attn_body::attn_unit<8, 0>(Qu, Kh, Vh, Ou, NT, 0, 0, sk, (char*)lds_raw, fresh_tid(wave_s));
            }
        }
#endif
#ifndef SKIP_AT1
        {
            unsigned char* ws = KWS(); const bf16_t* P = WSP(bf16_t, WS_P); bf16_t* Y3 = WSP(bf16_t, WS_Y3); const float* snk = KIN(I_sink_c) + l * 8;
#pragma unroll 1
            for (int k = 0;; ++k) {
                int uu;
                if (G == 256) { if (k < 2) uu = (vcu >> 5) * 64 + (vcu & 31) * 2 + k; else break;
                    const int j = uu & 63; const int hq = j < 8 ? (j >> 1) : (j - 8) / 14, qq = j < 8 ? ((j & 1) ? 15 : 0) : 1 + (j - 8) % 14; uu = (uu & ~63) | (hq << 4) | qq; }
                else { uu = bx + k * G; if (uu >= 512) break; }
                const int xs = uu >> 6, b = xs >> 1, kvh = xs & 1, h = 4 * kvh + ((uu >> 4) & 3), qb = uu & 15;
                const size_t rb = (size_t)b * TPB, rq = rb + 256 + 256 * qb;
                const int q0 = 256 * qb, kstart = q0 >= 128 ? q0 - 128 : 0, kend = q0 + 384 <= SEQ ? q0 + 384 : SEQ;
                attn_body::attn_unit<8, 1>(P + rq * PC + 2304 + 64 * h, P + rb * PC + 2816 + 64 * kvh, P + rb * PC + 2944 + 64 * kvh, Y3 + rq * 1536 + 1024 + 64 * h, 4 + (kend - kstart) / 64, kstart, q0 - kstart, snk[h] * LOG2E, (char*)lds_raw, fresh_tid(wave_s));
            }
        }
#endif
        GRID_BAR(); TP(5);
#ifndef SKIP_M1
        {
            unsigned char* ws = KWS();
            unsigned* cnt = WSP(unsigned, WS_CTL) + CW_PAN + l * 68 * 32;
            {
                SchedM1 S{(const char*)WSP(bf16_t, WS_Y3), (const char*)(WSP(bf16_t, WS_WBR) + (size_t)l * D * 1536), cnt, bx, need_ctx};
                pg8::EpiBranch E{WSP(bf16_t, WS_G), WSP(bf16_t, WS_MB)};
                pg8::SKCtx X{ws + WS_PART, WSP(unsigned, WS_CTL) + CW_FLG + 8192 * (8 + l), WSP(unsigned, WS_CTL) + CW_TMO, bx};
                pg8::gemm_phase<pg8::EpiBranch, SchedM1, true>(lds, fresh_tid(wave_s), S, E, X);
            }
#pragma unroll 1
            for (int i = 1; i < 3; ++i) {
                unsigned char* ws2 = KWS();
                SchedM2One S{(const char*)(ws2 + WS_MB), (const char*)((bf16_t*)(ws2 + WS_WOUT) + (size_t)l * D * D), bx, need_ctx, i};
                pg8::Unit u;
                if (S.unit(u)) {
                    wait_panel(cnt, (unsigned*)(ws2 + WS_CTL) + CW_TMO, u.pm, wave_s, 32u);
                    pg8::EpiResid E{(bf16_t*)(ws2 + WS_XS), (float*)(ws2 + WS_MODS) + (size_t)l * 5 * INC + 2 * D};
                    pg8::SKCtx X{ws2 + WS_PART, (unsigned*)(ws2 + WS_CTL) + CW_FLG + 8192 * (12 + l), (unsigned*)(ws2 + WS_CTL) + CW_TMO, bx};
                    pg8::gemm_phase<pg8::EpiResid, SchedM2One, true>(lds, fresh_tid(wave_s), S, E, X);
                }
            }
        }
#endif
        GRID_BAR(); TP(6);
#ifndef SKIP_N2
        {
            PHASE_IDS(); unsigned char* ws = KWS(); const bf16_t* XS = WSP(bf16_t, WS_XS); bf16_t* HN = WSP(bf16_t, WS_HN); const float* modl = WSP(float, WS_MODS) + (size_t)l * 5 * INC;
            const float* g2 = KIN(I_norm2_g) + (size_t)l * D;
            const int nrows = need_ctx ? M : NB * SEQ;
            if (!moe) {
                struct N2Job { bool need_ctx; const bf16_t* XS; bf16_t* HN; const float* modl; const float* g2;
                    __device__ __forceinline__ void operator()(int rr, RowJob& J) const {
                        const int row = need_ctx ? rr : (rr / SEQ) * TPB + CTXL + (rr % SEQ);
                        const int b = row / TPB, tq = row - b * TPB, who = tq < CTXL ? 4 : b;
                        J.src = nullptr; J.srcb = XS + (size_t)row * D; J.xs_out = nullptr; J.hn = HN + (size_t)row * D; J.row = row;
                        J.A = NormArgs{}; J.A.g = g2; J.A.shift = modl + (size_t)who * INC + 3 * D; J.A.scale = modl + (size_t)who * INC + 4 * D; } };
                const N2Job job{need_ctx, XS, HN, modl, g2};
                { const int RPB = (nrows + G - 1) / G, r0 = bx * RPB, r1 = (r0 + RPB < nrows) ? r0 + RPB : nrows; norm_rows<false, false>(r0 + wave, NWAVES, r1, job, lane); }
            } else {
                const int RPB = (nrows + G - 1) / G, r0 = bx * RPB, r1 = (r0 + RPB < nrows) ? r0 + RPB : nrows;
                LAS int* route = (LAS int*)lds;
                const float* rw = KIN(I_router_w) + (size_t)jf * D * NEXP; const float* rb = KIN(I_router_b) + jf * NEXP;
                int* PE = (int*)(ws + WS_META + MT_PE); int* PPOS = (int*)(ws + WS_META + MT_PPOS); float* PW = (float*)(ws + WS_META + MT_PW); int* BC = (int*)(ws + WS_META + MT_BC);
                LAS float* rwl = (LAS float*)(lds + 4096);
                for (int i = tid; i < D * NEXP; i += NTHR) rwl[(i & 7) * 1024 + (i >> 3)] = rw[i];
                LDS_WAIT(); __syncthreads();
                struct N2MJob { bool need_ctx; const bf16_t* XS; bf16_t* HN; const float* modl; const float* g2; const LAS float* rw; const float* rb; LAS int* route; int r0; int* PE; float* PW;
                    __device__ __forceinline__ void operator()(int rr, RowJob& J) const {
                        const int row = need_ctx ? rr : (rr / SEQ) * TPB + CTXL + (rr % SEQ);
                        const int b = row / TPB, tq = row - b * TPB, who = tq < CTXL ? 4 : b;
                        J.src = nullptr; J.srcb = XS + (size_t)row * D; J.xs_out = nullptr; J.hn = nullptr; J.row = row;
                        J.A = NormArgs{}; J.A.g = g2; J.A.shift = modl + (size_t)who * INC + 3 * D; J.A.scale = modl + (size_t)who * INC + 4 * D; J.A.hn8 = (unsigned char*)HN + (size_t)row * D;
                        J.A.rw = rw; J.A.rb = rb; J.A.route = route + 2 * (rr - r0); J.A.PE = PE; J.A.PW = PW; } };
                const N2MJob job{need_ctx, XS, HN, modl, g2, rwl, rb, route, r0, PE, PW};
                norm_rows<false, false>(r0 + wave, NWAVES, r1, job, lane);
                LDS_WAIT(); __syncthreads();
                {
                    const int npair = 2 * (r1 - r0 > 0 ? r1 - r0 : 0); int cnt = 0;
                    for (int k0 = 0; k0 < npair; k0 += 64) { const int k = k0 + lane; const bool mine = (k < npair) && (route[k] == wave);
                        const unsigned long long bal = __ballot(mine);
                        if (mine) { const int rr = r0 + (k >> 1); const int row = need_ctx ? rr : (rr / SEQ) * TPB + CTXL + (rr % SEQ);
                            PPOS[2 * row + (k & 1)] = cnt + __popcll(bal & ((1ull << lane) - 1ull)); }
                        cnt += __popcll(bal); }
                    if (lane == 0) BC[bx * 8 + wave] = cnt;
                }
                __syncthreads();
            }
        }
#endif
        GRID_BAR(); TP(8);
        if (!moe) {
#ifndef SKIP_F1
            {
                unsigned char* ws = KWS();
                SchedPlain S{(const char*)WSP(bf16_t, WS_HN), (const char*)(WSP(bf16_t, WS_W13) + (size_t)jf * 2 * DFF * D), (size_t)256 * D * 2, (size_t)256 * D * 2, need_ctx ? NMT : 64, 2 * DFF / 256, G, bx, !need_ctx, D / 64, D, D};
                pg8::EpiSwiGLU E{WSP(bf16_t, WS_H), DFF};
                pg8::gemm_phase<pg8::EpiSwiGLU, SchedPlain, true>(lds, fresh_tid(wave_s), S, E);
            }
#endif
            GRID_BAR(); TP(9);
#ifndef SKIP_F2
            {
                unsigned char* ws = KWS();
                SchedWR<DFF / 128> S{(const char*)WSP(bf16_t, WS_H), (const char*)(WSP(bf16_t, WS_W2) + (size_t)jf * D * DFF), (size_t)256 * DFF * 2, (size_t)256 * DFF * 2, 0, need_ctx ? NMT : 64, G, bx, !need_ctx, 1 << 30, 1 << 30, 1 << 30, 1 << 30, 1 << 30, 1 << 30, 1 << 30, DFF, DFF};
                pg8::EpiResid E{WSP(bf16_t, WS_XS), WSP(float, WS_MODS) + (size_t)l * 5 * INC + 5 * D};
                pg8::SKCtx X{ws + WS_PART, WSP(unsigned, WS_CTL) + CW_FLG + 8192 * (4 + jf), WSP(unsigned, WS_CTL) + CW_TMO, bx};
                pg8::gemm_phase<pg8::EpiResid, SchedWR<DFF / 128>, true>(lds, fresh_tid(wave_s), S, E, X);
            }
#endif
            GRID_BAR(); TP(10);
        } else {
#ifndef SKIP_GA
            {
                PHASE_IDS(); unsigned char* ws = KWS(); const bf16_t* HN = WSP(bf16_t, WS_HN); bf16_t* HS = WSP(bf16_t, WS_R2);
                const int* PE = (const int*)(ws + WS_META + MT_PE); const int* PPOS = (const int*)(ws + WS_META + MT_PPOS); const float* PW = (const float*)(ws + WS_META + MT_PW);
                int* DST = (int*)(ws + WS_META + MT_DST); float* CW = (float*)(ws + WS_META + MT_CW); const int* BC = (const int*)(ws + WS_META + MT_BC);
                const int nrows = need_ctx ? M : NB * SEQ, RPB = (nrows + G - 1) / G;
                LAS int* PRE = (LAS int*)lds; LAS int* LT = PRE + 8 * 256; LAS int* TOT = LT + 8 * 64;
                if (G <= 256) {
                    int c4[4], sum = 0;
#pragma unroll
                    for (int q = 0; q < 4; ++q) { const int b = 4 * lane + q; c4[q] = (b < G) ? BC[b * 8 + wave] : 0; sum += c4[q]; }
                    LT[wave * 64 + lane] = sum;
                    LDS_WAIT();
                    int pre = 0; for (int q = 0; q < lane; ++q) pre += LT[wave * 64 + q];
                    if (lane == 63) TOT[wave] = pre + sum;
#pragma unroll
                    for (int q = 0; q < 4; ++q) { PRE[(4 * lane + q) * 8 + wave] = pre; pre += c4[q]; }
                }
                LDS_WAIT(); __syncthreads();
                int ts[9]; ts[0] = 0;
#pragma unroll
                for (int e = 0; e < 8; ++e) ts[e + 1] = ts[e] + ((TOT[e] + 255) >> 8);
                if (bx == 0 && tid < 8) __hip_atomic_store(WSP(unsigned, WS_CTL) + CW_CNT + 1024 * jf + 64 * tid, (unsigned)TOT[tid], RLX_AGENT);
                unsigned char* HS8 = (unsigned char*)HS;
#pragma unroll 1
                for (int rr0 = gw; rr0 < nrows; rr0 += 4 * NGW) {
                    int row[4], pe[4][2], pp[4][2]; float pw[4][2]; u32x4 q[4]; bool ok[4];
#pragma unroll
                    for (int k = 0; k < 4; ++k) { const int rr = rr0 + k * NGW; ok[k] = rr < nrows; const int rc = ok[k] ? rr : rr0; row[k] = need_ctx ? rc : (rc / SEQ) * TPB + CTXL + (rc % SEQ); }
#pragma unroll
                    for (int k = 0; k < 4; ++k) { q[k] = *(const u32x4*)((const unsigned char*)HN + (size_t)row[k] * D + 16 * lane);
#pragma unroll
                        for (int s = 0; s < 2; ++s) { pe[k][s] = PE[2 * row[k] + s]; pp[k][s] = PPOS[2 * row[k] + s]; pw[k][s] = PW[2 * row[k] + s]; } }
#pragma unroll
                    for (int k = 0; k < 4; ++k) { const int rr = rr0 + k * NGW, blk = (ok[k] ? rr : rr0) / RPB;
                        if (ok[k]) {
#pragma unroll
                            for (int s = 0; s < 2; ++s) { const int e = pe[k][s], pos = pp[k][s] + PRE[blk * 8 + e];
                                int t0 = 0;
#pragma unroll
                                for (int kk = 1; kk < 8; ++kk) t0 = (e == kk) ? ts[kk] : t0;
                                const int d = 256 * t0 + pos;
                                *(u32x4*)(HS8 + (size_t)d * D + 16 * lane) = q[k];
                                if (lane == 0) { CW[d] = pw[k][s]; DST[2 * row[k] + s] = d; } } } }
                }
            }
#endif
            GRID_BAR(); TP(11);
#ifndef SKIP_E1
            {
                unsigned char* ws = KWS();
                int ts[9]; ts[0] = 0;
#pragma unroll
                for (int e = 0; e < 8; ++e) { const unsigned c = __hip_atomic_load(WSP(unsigned, WS_CTL) + CW_CNT + 1024 * jf + 64 * e, RLX_AGENT); ts[e + 1] = ts[e] + (int)((c + 255u) >> 8); }
                SchedMoE S{(const char*)(ws + WS_R2), (const char*)(ws + WS_E13 + (size_t)jf * 8 * 2 * DFE * D), (size_t)256 * D, (size_t)256 * D, (size_t)2 * DFE * D, ts[8], 2 * DFE / 256, G, bx, ts[1], ts[2], ts[3], ts[4], ts[5], ts[6], ts[7], D / 128, D / 2, D / 2};
                pg8::EpiSwiGLU8 E{ws + WS_H, DFE, 1.0f / (FP8_SC_X * FP8_SC_W13), FP8_SC_H};
                pg8::gemm_phase<pg8::EpiSwiGLU8, SchedMoE, true, true>(lds, fresh_tid(wave_s), S, E);
            }
#endif
            GRID_BAR(); TP(12);
#ifndef SKIP_E2
            {
                unsigned char* ws = KWS();
                int ts[9]; ts[0] = 0;
#pragma unroll
                for (int e = 0; e < 8; ++e) { const unsigned c = __hip_atomic_load(WSP(unsigned, WS_CTL) + CW_CNT + 1024 * jf + 64 * e, RLX_AGENT); ts[e + 1] = ts[e] + (int)((c + 255u) >> 8); }
                SchedWR<DFE / 256> S{(const char*)(ws + WS_H), (const char*)(ws + WS_E2 + (size_t)jf * 8 * D * DFE), (size_t)256 * DFE, (size_t)256 * DFE, (size_t)D * DFE, ts[8], G, bx, false, ts[1], ts[2], ts[3], ts[4], ts[5], ts[6], ts[7], DFE / 2, DFE / 2};
                pg8::EpiMoEDown E{WSP(bf16_t, WS_R2), (const float*)(ws + WS_META + MT_CW), 1.0f / (FP8_SC_H * FP8_SC_W2)};
                pg8::SKCtx X{ws + WS_PART, WSP(unsigned, WS_CTL) + CW_FLG + 8192 * (6 + jf), WSP(unsigned, WS_CTL) + CW_TMO, bx};
                pg8::gemm_phase<pg8::EpiMoEDown, SchedWR<DFE / 256>, true, true>(lds, fresh_tid(wave_s), S, E, X);
            }
#endif
            GRID_BAR(); TP(13);
        }
    }
#ifdef TPROBE
    { unsigned char* ws = KWS(); if (bx == 0 && fresh_tid(wave_s) < 16) WSP(unsigned, WS_RETC + 4096)[fresh_tid(wave_s)] = MISC[16 + fresh_tid(wave_s)]; }
    GRID_BAR();
#endif
    {
        PHASE_IDS(); unsigned char* ws = KWS(); const bf16_t* XS = WSP(bf16_t, WS_XS); const float* MODS = WSP(float, WS_MODS); const bf16_t* YY = WSP(bf16_t, WS_R2); const int* DST = (const int*)(ws + WS_META + MT_DST);
        const float* fgp = KIN(I_final_g); float* outp = KOUT();
        const unsigned tmo = __hip_atomic_load(WSP(unsigned, WS_CTL) + CW_BAR + XB_TMO, RLX_AGENT) | __hip_atomic_load(WSP(unsigned, WS_CTL) + CW_TMO, RLX_AGENT);
#pragma unroll 1
        for (int rr0 = gw; rr0 < NB * SEQ; rr0 += 4 * NGW) {
            int rrk[4], rowk[4], dk[4][2]; const float* gtk[4]; bool ok[4];
#pragma unroll
            for (int k = 0; k < 4; ++k) { const int rr = rr0 + k * NGW; ok[k] = rr < NB * SEQ; rrk[k] = ok[k] ? rr : rr0; const int b = rrk[k] / SEQ; rowk[k] = b * TPB + CTXL + (rrk[k] % SEQ);
                gtk[k] = MODS + ((size_t)3 * 5 + b) * INC + 5 * D; dk[k][0] = DST[2 * rowk[k]]; dk[k][1] = DST[2 * rowk[k] + 1]; }
            u32x2 xb[4][4], y0[4][4], y1[4][4]; f32x4 g4[4][4];
#pragma unroll
            for (int k = 0; k < 4; ++k)
#pragma unroll
                for (int j = 0; j < 4; ++j) { const int c = 4 * lane + 256 * j; xb[k][j] = *(const u32x2*)(XS + (size_t)rowk[k] * D + c);
                    y0[k][j] = *(const u32x2*)(YY + (size_t)dk[k][0] * D + c); y1[k][j] = *(const u32x2*)(YY + (size_t)dk[k][1] * D + c); g4[k][j] = *(const f32x4*)(gtk[k] + c); }
#pragma unroll
            for (int k = 0; k < 4; ++k) {
                const int rr = rrk[k];
                f32x4 v[4]; float ss = 0.f;
#pragma unroll
                for (int j = 0; j < 4; ++j) { v[j] = (f32x4){bflo(xb[k][j].x), bfhi(xb[k][j].x), bflo(xb[k][j].y), bfhi(xb[k][j].y)};
                    v[j][0] += g4[k][j][0] * (bflo(y0[k][j].x) + bflo(y1[k][j].x)); v[j][1] += g4[k][j][1] * (bfhi(y0[k][j].x) + bfhi(y1[k][j].x)); v[j][2] += g4[k][j][2] * (bflo(y0[k][j].y) + bflo(y1[k][j].y)); v[j][3] += g4[k][j][3] * (bfhi(y0[k][j].y) + bfhi(y1[k][j].y));
                    ss += (v[j][0] * v[j][0] + v[j][1] * v[j][1]) + (v[j][2] * v[j][2] + v[j][3] * v[j][3]); }
                float rs = rsqrtf(wave_sum(ss) * (1.0f / D) + EPS);
                if (tmo) rs = __builtin_nanf("");
                if (ok[k]) {
#pragma unroll
                    for (int j = 0; j < 4; ++j) { const int c = 4 * lane + 256 * j; const f32x4 fg = *(const f32x4*)(fgp + c); *(f32x4*)(outp + (size_t)rr * D + c) = v[j] * rs * fg; }
#ifdef TPROBE
            { const unsigned* T = WSP(unsigned, WS_RETC + 4096); const float c2 = (TPROBE_B >= 0 ? (float)T[TPROBE_B < 0 ? 0 : TPROBE_B] : (float)(T[0] + T[1] + T[2] + T[3] + T[4] + T[5] + T[6] + T[7] + T[8] + T[9] + T[10] + T[11] + T[12] + T[13])) * 0.01f * TPROBE_SB;
#pragma unroll
              for (int j = 0; j < 4; ++j) { const int c = 4 * lane + 256 * j; f32x4 o = (f32x4){100.f, 100.f, 100.f, 100.f}; if (rr == 0 && c == 0) o[0] = c2; *(f32x4*)(outp + (size_t)rr * D + c) = o; } }
#endif
                }
            }
        }
    }
#undef GRID_BAR
}

extern "C" void kernel_launch(void* const* d_in, const int* in_sizes, int n_in, void* d_out, int out_size, void* d_ws, size_t ws_size, hipStream_t stream) {
    static int grid = 0;
    if (grid == 0) {
        if (n_in != 28 || out_size != NB * SEQ * D || ws_size < WS_END) { fprintf(stderr, "kernel_launch: unexpected shapes: n_in %d out %d ws %zu (need %zu)\n", n_in, out_size, ws_size, (size_t)WS_END); grid = -1; return; }
        int dev = 0, cus = 0, per_cu = 0;
        if (hipGetDevice(&dev) != hipSuccess || hipDeviceGetAttribute(&cus, hipDeviceAttributeMultiprocessorCount, dev) != hipSuccess) { grid = -1; return; }
        if (hipFuncSetAttribute((const void*)fwd_kernel, hipFuncAttributeMaxDynamicSharedMemorySize, LDS_BYTES) != hipSuccess) { fprintf(stderr, "kernel_launch: hipFuncSetAttribute failed\n"); grid = -1; return; }
        if (hipOccupancyMaxActiveBlocksPerMultiprocessor(&per_cu, (const void*)fwd_kernel, NTHR, LDS_BYTES) != hipSuccess || per_cu < 1) fprintf(stderr, "kernel_launch: occupancy query reports %d\n", per_cu);
        (void)hipGetLastError();
        grid = cus < 256 ? cus : 256;
    }
    if (grid < 0) return;
    if (hipMemsetAsync((char*)d_ws + WS_CTL, 0, CTL_ZERO_BYTES, stream) != hipSuccess) return;
    Args a{};
    const float** pp = (const float**)&a.in;
    for (int i = 0; i < 28; ++i) pp[i] = (const float*)d_in[i];
    a.out = (float*)d_out; a.ws = (unsigned char*)d_ws;
    hipLaunchKernelGGL(fwd_kernel, dim3(grid), dim3(NTHR), LDS_BYTES, stream, a);
}
```

```cpp
#include <hip/hip_runtime.h>
#include <cstdio>
#include <cstdint>
#include <cmath>

constexpr int NB = 4, SEQ = 4096, CTXL = 256, TPB = SEQ + CTXL, M = NB * TPB, D = 1024, DEPTH = 4;
constexpr int INC = 6144, PC = 3072, DFF = 2816, DFE = 3584, NEXP = 8;
constexpr int NMT = M / 256;
constexpr int MOE_ROWS = 2 * M + NEXP * 256;
constexpr float EPS = 1e-6f;
constexpr float LOG2E = 1.4426950408889634f;
constexpr float C2 = 0.125f * LOG2E;

constexpr size_t MiB = 1u << 20;
constexpr size_t WS_CTL = 0, CTL_ZERO_BYTES = 1 * MiB;
constexpr size_t WS_MODS = 1 * MiB;
constexpr size_t WS_ROPE = WS_MODS + 512 * 1024;
constexpr size_t WS_RETC = WS_ROPE + 16 * 1024;
constexpr size_t WS_META = 2 * MiB;
constexpr size_t WS_WIN = 3 * MiB;
constexpr size_t WS_WBR = WS_WIN + 48 * MiB;
constexpr size_t WS_WOUT = WS_WBR + 12 * MiB;
constexpr size_t WS_W13 = WS_WOUT + 8 * MiB;
constexpr size_t WS_W2 = WS_W13 + 22 * MiB;
constexpr size_t WS_E13 = WS_W2 + 11 * MiB;
constexpr size_t WS_E2 = WS_E13 + 224 * MiB;
constexpr size_t WS_XS = WS_E2 + 112 * MiB;
constexpr size_t WS_HN = WS_XS + 68 * MiB;
constexpr size_t WS_P = WS_HN + 34 * MiB;
constexpr size_t WS_G = WS_P + 102 * MiB;
constexpr size_t WS_Y3 = WS_G + 102 * MiB;
constexpr size_t WS_R2 = WS_Y3 + 51 * MiB;
constexpr size_t WS_MB = WS_R2, WS_KVS = WS_R2 + 34 * MiB;
constexpr size_t WS_KVB = WS_HN;
constexpr size_t WS_HN8 = WS_Y3;
#ifndef G1M0
#define G1M0 0xFFF000u
#define G1M1 0xFFF000u
#define G1M2 0xFFFFFFu
#define G1M3 0xFFFFFFu
#endif
__device__ __forceinline__ unsigned g1_mask(int l) { return (l == 0 ? G1M0 : l == 1 ? G1M1 : l == 2 ? G1M2 : G1M3) | 0xFFF000u; }
__device__ __forceinline__ int nth_bit(unsigned m, int j) { for (int t = 0; t < j; ++t) m &= m - 1u; return __builtin_ctz(m); }
constexpr size_t WG8_OFF = (size_t)3072 * D * 2;
constexpr size_t WS_PART = WS_R2 + 72 * MiB;
constexpr size_t WS_END = WS_PART + 64 * MiB;
constexpr size_t WS_H = WS_P;
static_assert((size_t)MOE_ROWS * DFE * 2 <= WS_R2 - WS_P, "HM overlay");
static_assert((size_t)MOE_ROWS * D * 2 <= 72 * MiB, "HS overlay");
constexpr size_t MT_PE = 0, MT_PPOS = MT_PE + (size_t)M * 8, MT_PW = MT_PPOS + (size_t)M * 8, MT_DST = MT_PW + (size_t)M * 8, MT_CW = MT_DST + (size_t)M * 8, MT_BC = MT_CW + (size_t)MOE_ROWS * 4, MT_END = MT_BC + 256 * 8 * 4;
static_assert(MT_END <= 1 * MiB, "meta");
constexpr int CW_TMO = 0, CW_CODE = 1, CW_BAR = 4096, CW_CNT = 8192, CW_FLG = 65536, CW_PAN = 200000;

constexpr int RING_BYTES = 131072, LDSCTL_OFF = RING_BYTES, MISC_OFF = LDSCTL_OFF + 320, LDS_BYTES = 147456;
constexpr int NWAVES = 8, NTHR = 512;

#define GAS __attribute__((address_space(1)))
#define LAS __attribute__((address_space(3)))
typedef unsigned short bf16_t;
typedef unsigned u32x4 __attribute__((ext_vector_type(4)));
typedef unsigned u32x2 __attribute__((ext_vector_type(2)));
typedef float f32x4 __attribute__((ext_vector_type(4)));
typedef float f32x2 __attribute__((ext_vector_type(2)));
typedef float f32x16 __attribute__((ext_vector_type(16)));
typedef short bf16x8 __attribute__((ext_vector_type(8)));
typedef short s16x4 __attribute__((ext_vector_type(4)));
#define RLX_AGENT __ATOMIC_RELAXED, __HIP_MEMORY_SCOPE_AGENT
#define LDS_WAIT() asm volatile("s_waitcnt lgkmcnt(0)" ::: "memory")
#define VM_WAIT() asm volatile("s_waitcnt vmcnt(0)" ::: "memory")
typedef float f32x2v_t __attribute__((ext_vector_type(2))); typedef __bf16 bf16x2v_t __attribute__((ext_vector_type(2)));
__device__ __forceinline__ unsigned pk2(float lo, float hi) { const f32x2v_t v = {lo, hi}; return __builtin_bit_cast(unsigned, __builtin_convertvector(v, bf16x2v_t)); }
__device__ __forceinline__ unsigned f2bf(float f) { return pk2(f, f) & 0xffffu; }
__device__ __forceinline__ float bflo(unsigned w) { return __builtin_bit_cast(float, w << 16); }
__device__ __forceinline__ float bfhi(unsigned w) { return __builtin_bit_cast(float, w & 0xffff0000u); }
typedef int i32x8 __attribute__((ext_vector_type(8)));
typedef int i32x4 __attribute__((ext_vector_type(4)));
__device__ __forceinline__ unsigned pk4_fp8(float a, float b, float c, float d) { int p = __builtin_amdgcn_cvt_pk_fp8_f32(a, b, 0, false); p = __builtin_amdgcn_cvt_pk_fp8_f32(c, d, p, true); return (unsigned)p; }
constexpr float FP8_SC_X = 4.0f, FP8_SC_H = 2.0f, FP8_SC_W13 = 32.0f, FP8_SC_W2 = 64.0f, FP8_SC_WG = 32.0f;
__device__ __forceinline__ float sigmoidf_(float x) { return __builtin_amdgcn_rcpf(1.0f + __builtin_amdgcn_exp2f(x * -LOG2E)); }
__device__ __forceinline__ float siluf_(float x) { return x * sigmoidf_(x); }
__device__ __forceinline__ int fresh_lane() { int l; asm volatile("v_mbcnt_lo_u32_b32 %0, -1, 0\n\tv_mbcnt_hi_u32_b32 %0, -1, %0" : "=v"(l)); return l; }
__device__ __forceinline__ int fresh_tid(int wave_s) { int l; asm volatile("v_mbcnt_lo_u32_b32 %0, -1, 0\n\tv_mbcnt_hi_u32_b32 %0, -1, %0" : "=v"(l)); return wave_s * 64 + l; }
template <int MSK> __device__ __forceinline__ float swz_xor(float v) { return __builtin_bit_cast(float, __builtin_amdgcn_ds_swizzle(__builtin_bit_cast(int, v), (MSK << 10) | 0x1f)); }
__device__ __forceinline__ float xor32_sum(float v) { const unsigned u = __builtin_bit_cast(unsigned, v); auto rr = __builtin_amdgcn_permlane32_swap(u, u, false, false); return __builtin_bit_cast(float, (unsigned)rr[0]) + __builtin_bit_cast(float, (unsigned)rr[1]); }
template <int CTRL> __device__ __forceinline__ float dpp_f(float v) { return __builtin_bit_cast(float, __builtin_amdgcn_update_dpp(0, __builtin_bit_cast(int, v), CTRL, 0xf, 0xf, true)); }
__device__ __forceinline__ float half_sum(float v) { v += dpp_f<0xB1>(v); v += dpp_f<0x4E>(v); v += dpp_f<0x141>(v); v += dpp_f<0x140>(v); v += swz_xor<16>(v); return v; }
__device__ __forceinline__ float wave_sum(float v) { return xor32_sum(half_sum(v)); }

typedef const __attribute__((address_space(4))) unsigned char* kargp_t;
__device__ __forceinline__ kargp_t kfresh() { kargp_t p = (kargp_t)__builtin_amdgcn_kernarg_segment_ptr(); asm volatile("" : "+s"(p)); return p; }
#define KIN(idx) (((const float* const __attribute__((address_space(4)))*)kfresh())[idx])
#define KOUT() (((float* const __attribute__((address_space(4)))*)kfresh())[28])
#define KWS() (((unsigned char* const __attribute__((address_space(4)))*)kfresh())[29])
enum { I_x, I_c, I_ctx, I_c_ctx, I_w_ada, I_b_ada, I_norm1_g, I_norm2_g, I_final_g, I_w_in, I_b_gate, I_qn_a, I_kn_a, I_ret_a, I_ret_g, I_sink_c, I_w_br_a, I_w_br_b, I_w_br_c, I_w_out, I_ffn_w1, I_ffn_w3, I_ffn_w2, I_router_w, I_router_b, I_exp_w1, I_exp_w3, I_exp_w2 };
#define WSP(T, off) ((T*)(ws + (off)))

#define XB_TMO      128
#define XB_XCNT(j)  (256  + 64 * (j))
#define XB_XSUB(j)  (1280 + 64 * (j))
#define XB_XGEN(j)  (2304 + 64 * (j))
#define XB_TOP      3328
#define XB_TOPGEN   3392
#define XCD_BAR_WORDS 3456
#define XB_SPIN_CAP (1u << 20)
__device__ __forceinline__ unsigned xb_ld(unsigned* p)              { return __hip_atomic_load(p, __ATOMIC_RELAXED, __HIP_MEMORY_SCOPE_AGENT); }
__device__ __forceinline__ unsigned xb_add(unsigned* p, unsigned v) { return __hip_atomic_fetch_add(p, v, __ATOMIC_RELAXED, __HIP_MEMORY_SCOPE_AGENT); }
__device__ __forceinline__ unsigned xb_xcc_id() { return (unsigned)__builtin_amdgcn_s_getreg((3 << 11) | 20) & 0xFu; }
#define XB_SPIN(cond, bar) do { unsigned _sp = 0; while (cond) { __builtin_amdgcn_s_sleep(1); \
    if ((++_sp & 255u) == 0u) { if (xb_ld(&(bar)[XB_TMO])) break; if (_sp > XB_SPIN_CAP) { atomicAdd(&(bar)[XB_TMO], 1u); break; } } } } while (0)
struct XcdBarrier { unsigned* bar; unsigned x; volatile LAS unsigned* st; };
__device__ __forceinline__ XcdBarrier xcd_barrier_post(unsigned* bar, volatile LAS unsigned* st) {
    XcdBarrier b; b.bar = bar; b.x = xb_xcc_id(); b.st = st;
    if (threadIdx.x == 0) (void)xb_add(&bar[XB_XCNT(b.x)], 1u);
    return b;
}
__device__ __forceinline__ void xcd_barrier_complete(unsigned* bar, unsigned x, unsigned& nloc, unsigned& nx) {
    const unsigned G = gridDim.x * gridDim.y * gridDim.z;
    unsigned sum, cnt, mine, sp = 0u;
    for (;;) {
        sum = 0u; cnt = 0u; mine = 0u;
#pragma unroll
        for (unsigned j = 0; j < 16; ++j) { const unsigned c = xb_ld(&bar[XB_XCNT(j)]); sum += c; cnt += (c > 0u) ? 1u : 0u; mine = (j == x) ? c : mine; }
        if (sum == G) break;
        __builtin_amdgcn_s_sleep(1);
        if ((++sp & 255u) == 0u) { if (xb_ld(&bar[XB_TMO])) break; if (sp > XB_SPIN_CAP) { atomicAdd(&bar[XB_TMO], 1u); break; } }
    }
    nloc = mine > 0u ? mine : 1u; nx = cnt > 0u ? cnt : 1u;
}
__device__ __forceinline__ void xcd_barrier(const XcdBarrier& b) {
    asm volatile("s_waitcnt vmcnt(0)" ::: "memory");
    __syncthreads();
    if (threadIdx.x == 0) {
        unsigned* bar = b.bar;
        __builtin_amdgcn_s_waitcnt(0);
        unsigned nloc = b.st[0], nx = b.st[1];
        if (nloc == 0u) { xcd_barrier_complete(bar, b.x, nloc, nx); b.st[0] = nloc; b.st[1] = nx; }
        const unsigned old = xb_add(&bar[XB_XSUB(b.x)], 1u);
        const unsigned gen = old / nloc;
        if (old + 1u == (gen + 1u) * nloc) {
            __builtin_amdgcn_fence(__ATOMIC_RELEASE, "agent");
            asm volatile("s_waitcnt vmcnt(0)" ::: "memory");
            const unsigned og = xb_add(&bar[XB_TOP], 1u);
            const unsigned tg = og / nx;
            if (og + 1u == (tg + 1u) * nx) xb_add(&bar[XB_TOPGEN], 1u);
            else XB_SPIN(xb_ld(&bar[XB_TOPGEN]) == tg, bar);
            __builtin_amdgcn_fence(__ATOMIC_ACQUIRE, "agent");
            xb_add(&bar[XB_XGEN(b.x)], 1u);
            asm volatile("s_waitcnt vmcnt(0)" ::: "memory");
        } else {
            XB_SPIN(xb_ld(&bar[XB_XGEN(b.x)]) == gen, bar);
            __builtin_amdgcn_fence(__ATOMIC_ACQUIRE, "agent");
            asm volatile("s_waitcnt vmcnt(0)" ::: "memory");
        }
    }
    __syncthreads();
}
namespace pg8 {
constexpr int BM = 256, BK = 64, HALF = 128, HTB = HALF * BK * 2, STAGE_BYTES = 8 * HTB;
__device__ __forceinline__ int lds_byte(int r, int c) { const int st = (r >> 4) * 2 + (c >> 5), rr = r & 15, cc = c & 31, ob = rr * 64 + cc * 2; return st * 1024 + (ob ^ (((ob >> 9) & 1) << 5)); }
__device__ __forceinline__ void stage_rc(int b, int& R, int& C) { const int st = b / 1024, sb = b % 1024, swz = sb ^ (((sb >> 9) & 1) << 5); R = (st >> 1) * 16 + swz / 64; C = (st & 1) * 32 + (swz % 64) / 2; }
__device__ __forceinline__ int perm32(int rho) { const int n = rho >> 4, i = rho & 15; return 8 * (i >> 2) + 4 * n + (i & 3); }

struct Unit { int pm, pn, aux, ntk, mode, peer, kt0, kind, lda, ldb; const char* A; const char* B; };
struct SKCtx { unsigned char* part; unsigned* flags; unsigned* tmo; int self; };
constexpr unsigned SK_SLOT = 262144u, SK_SPIN_CAP = 1u << 20;
#ifndef SKB
#define SKB 16
#endif
__device__ __forceinline__ void sk_store_partial(const f32x4 (&acc)[2][2][4][2], const SKCtx& X, int wid) {
    const int tid = wid * 64 + fresh_lane();
    const __amdgpu_buffer_rsrc_t rs = __builtin_amdgcn_make_buffer_rsrc(X.part + (size_t)X.self * SK_SLOT, 0, SK_SLOT, 0x00020000);
#pragma unroll
    for (int r = 0; r < 32; ++r) __builtin_amdgcn_raw_buffer_store_b128(__builtin_bit_cast(u32x4, acc[r >> 4][(r >> 3) & 1][(r >> 1) & 3][r & 1]), rs, (unsigned)((r * 512 + tid) * 16), 0, 16);
    asm volatile("s_waitcnt vmcnt(0)" ::: "memory");
    if ((tid & 63) == 0) __hip_atomic_fetch_add(X.flags + 32 * X.self, 1u, __ATOMIC_RELAXED, __HIP_MEMORY_SCOPE_AGENT);
}
__device__ __forceinline__ void sk_add_partial(f32x4 (&acc)[2][2][4][2], const SKCtx& X, int peer, int wid) {
    const int tid = wid * 64 + fresh_lane();
    unsigned spins = 0;
    while ((unsigned)__builtin_amdgcn_readfirstlane(__hip_atomic_load(X.flags + 32 * peer, __ATOMIC_RELAXED, __HIP_MEMORY_SCOPE_AGENT)) < 8u) {
        __builtin_amdgcn_s_sleep(1);
        if (++spins > SK_SPIN_CAP) { if ((tid & 63) == 0) __hip_atomic_store(X.tmo, 1u, __ATOMIC_RELAXED, __HIP_MEMORY_SCOPE_AGENT); break; } }
    __builtin_amdgcn_fence(__ATOMIC_ACQUIRE, "agent");
    asm volatile("s_waitcnt vmcnt(0)" ::: "memory");
    const int t2 = tid;
    const f32x4* p = (const f32x4*)(X.part + (size_t)peer * SK_SLOT) + t2;
#pragma unroll
    for (int r0 = 0; r0 < 32; r0 += SKB) {
        f32x4 v[SKB];
#pragma unroll
        for (int k = 0; k < SKB; ++k) asm volatile("global_load_dwordx4 %0, %1, off sc1" : "=v"(v[k]) : "v"(p + (r0 + k) * 512) : "memory");
        asm volatile("s_waitcnt vmcnt(0)" ::: "memory");
#pragma unroll
        for (int k = 0; k < SKB; ++k) asm volatile("" : "+v"(v[k]));
#pragma unroll
        for (int k = 0; k < SKB; ++k) { const int r = r0 + k; acc[r >> 4][(r >> 3) & 1][(r >> 1) & 3][r & 1] += v[k]; }
    }
}

__device__ __forceinline__ bool tile_of(long L, int nM, int nN, int& pm, int& pn) {
    const int nwg = nM * nN; if (L >= nwg) return false;
    int wgid = (int)L; { const int q = nwg / 8, r = nwg % 8, xcd = wgid % 8, off = wgid / 8; wgid = (xcd < r ? xcd * (q + 1) : r * (q + 1) + (xcd - r) * q) + off; }
    const int nig = 8 * nN, gid = wgid / nig, fm = gid * 8, gsz = (nM - fm) < 8 ? (nM - fm) : 8;
    pm = fm + ((wgid % nig) % gsz); pn = (wgid % nig) / gsz; return true;
}
__device__ __forceinline__ unsigned cvt_pk_bf16(float lo, float hi) { return pk2(lo, hi); }

template <class Epi, class Sched, bool ALIGN_EPI, bool FP8 = false>
__device__ __forceinline__ void gemm_phase(LAS unsigned char* lds, const int tid, const Sched& S, const Epi& E, const SKCtx X = SKCtx{nullptr, nullptr, nullptr, 0}) {
    const int wid = __builtin_amdgcn_readfirstlane(tid >> 6), lane = tid & 63, wr = wid >> 2, wc = wid & 3, fr = lane & 15, fq = lane >> 4;
    unsigned RA2[2], RB2[2], C2[2];
#pragma unroll
    for (int i = 0; i < 2; ++i) { int R, C; stage_rc(tid * 16 + i * 8192, R, C); const int Rb = Epi::PERM ? ((R & ~31) + perm32(R & 31)) : R;
        RA2[i] = (unsigned)R * 2u; RB2[i] = (unsigned)Rb * 2u; C2[i] = (unsigned)C * 2u; }
    const size_t kstep = (size_t)(BK * 2);
    const unsigned ldsw = (unsigned)wid * 1024u;
    const int aoff = lds_byte(wr * 64 + fr, fq * 8), boff = lds_byte(wc * 32 + fr, fq * 8);
#define PG8_SA(b, h) (((b) * 2 + (h)) * HTB)
#define PG8_SB(b, h) ((4 + (b) * 2 + (h)) * HTB)
#define PG8_STAGE(bufoff, gbase, R2, ld) do { _Pragma("unroll") for (int _i = 0; _i < 2; ++_i) \
        __builtin_amdgcn_global_load_lds((const unsigned*)((const char*)(gbase) + ((R2)[_i] * (unsigned)(ld) + C2[_i])), (LAS unsigned*)(lds + (bufoff) + ldsw + _i * 8192), 16, 0, 0); } while (0)
#define PG8_HS(ld) ((size_t)HALF * (size_t)(ld) * 2)
#define PG8_STAGE_A(bufoff, gbase, ld, kd) do { if ((kd) == 1) { _Pragma("unroll") for (int _i = 0; _i < 2; ++_i) \
        __builtin_amdgcn_global_load_lds((const unsigned*)((const char*)(gbase) + (RA2[_i] * (unsigned)(ld) + C2[_i])), (LAS unsigned*)(lds + (bufoff) + ldsw + _i * 8192), 16, 0, 16); } \
    else { PG8_STAGE(bufoff, gbase, RA2, ld); } } while (0)
#define PG8_LDA(dst, b, h) do { if constexpr (FP8) { _Pragma("unroll") for (int m = 0; m < 4; ++m) dst##8[m] = __builtin_shufflevector(*(const LAS i32x4*)(lds + PG8_SA(b, h) + aoff + m * 2048), *(const LAS i32x4*)(lds + PG8_SA(b, h) + aoff + m * 2048 + 1024), 0, 1, 2, 3, 4, 5, 6, 7); } \
    else { _Pragma("unroll") for (int m = 0; m < 4; ++m) _Pragma("unroll") for (int k = 0; k < 2; ++k) dst[m][k] = *(const LAS bf16x8*)(lds + PG8_SA(b, h) + aoff + m * 2048 + k * 1024); } } while (0)
#define PG8_LDB(dst, b, h) do { if constexpr (FP8) { _Pragma("unroll") for (int n = 0; n < 2; ++n) dst##8[n] = __builtin_shufflevector(*(const LAS i32x4*)(lds + PG8_SB(b, h) + boff + n * 2048), *(const LAS i32x4*)(lds + PG8_SB(b, h) + boff + n * 2048 + 1024), 0, 1, 2, 3, 4, 5, 6, 7); } \
    else { _Pragma("unroll") for (int n = 0; n < 2; ++n) _Pragma("unroll") for (int k = 0; k < 2; ++k) dst[n][k] = *(const LAS bf16x8*)(lds + PG8_SB(b, h) + boff + n * 2048 + k * 1024); } } while (0)
#define PG8_MMA(ai, bj, At, Bt) do { __builtin_amdgcn_s_setprio(1); _Pragma("unroll") for (int m = 0; m < 4; ++m) _Pragma("unroll") for (int n = 0; n < 2; ++n) { \
        if constexpr (FP8) asm volatile("v_mfma_scale_f32_16x16x128_f8f6f4 %0, %1, %2, %0, %3, %3 op_sel_hi:[0,0,0]" : "+v"(acc[ai][bj][m][n]) : "v"(Bt##8[n]), "v"(At##8[m]), "v"(one8));   \
        else { _Pragma("unroll") for (int k = 0; k < 2; ++k) acc[ai][bj][m][n] = __builtin_amdgcn_mfma_f32_16x16x32_bf16(Bt[n][k], At[m][k], acc[ai][bj][m][n], 0, 0, 0); } } \
        __builtin_amdgcn_s_setprio(0); } while (0)
#define PG8_WAIT_V(n) asm volatile("s_waitcnt vmcnt(" #n ")" ::: "memory")
#define PG8_WAIT_L(n) asm volatile("s_waitcnt lgkmcnt(" #n ")" ::: "memory")
#define PG8_BAR __builtin_amdgcn_s_barrier()
#define PG8_SCHED __builtin_amdgcn_sched_barrier(0)
    Unit cur, nxt; int ui = 0;
    if (!S.next(0, cur)) return;
    f32x4 acc[2][2][4][2];
#pragma unroll
    for (int a = 0; a < 2; ++a)
#pragma unroll
        for (int b = 0; b < 2; ++b)
#pragma unroll
            for (int m = 0; m < 4; ++m)
#pragma unroll
                for (int n = 0; n < 2; ++n) acc[a][b][m][n] = (f32x4){0.f, 0.f, 0.f, 0.f};
    const int one8 = 0x7f7f7f7f;
    bf16x8 At[4][2], B0[2][2], B1[2][2]; i32x8 At8[4], B08[2], B18[2];
    const char* cA = cur.A; const char* cB = cur.B;
    S.a_ready(cur);
    PG8_STAGE(PG8_SB(0, 0), cB, RB2, cur.ldb); PG8_STAGE(PG8_SB(0, 1), cB + PG8_HS(cur.ldb), RB2, cur.ldb); PG8_STAGE(PG8_SA(0, 0), cA, RA2, cur.lda); PG8_STAGE(PG8_SA(0, 1), cA + PG8_HS(cur.lda), RA2, cur.lda);
    if (wr == 1) PG8_BAR;
    PG8_WAIT_V(2); PG8_BAR;
    PG8_STAGE(PG8_SB(1, 0), cB + kstep, RB2, cur.ldb); PG8_STAGE(PG8_SA(1, 0), cA + kstep, RA2, cur.lda); PG8_STAGE(PG8_SB(1, 1), cB + PG8_HS(cur.ldb) + kstep, RB2, cur.ldb);
    PG8_WAIT_V(6); PG8_BAR;
    for (;;) {
        const bool has_next = S.next(ui + 1, nxt);
        const char* nA = has_next ? nxt.A : cA; const char* nB = has_next ? nxt.B : cB;
        const int nt = cur.ntk;
        for (int t = 0; t < nt; t += 2) {
            const bool last = (t == nt - 2);
            const char* a1 = cA + (size_t)(t + 1) * kstep;
            const char* a2 = last ? nA : cA + (size_t)(t + 2) * kstep; const char* b2 = last ? nB : cB + (size_t)(t + 2) * kstep;
            const char* a3 = a2 + kstep; const char* b3 = b2 + kstep;
            const int lda1 = cur.lda, lda2 = (last && has_next) ? nxt.lda : cur.lda, ldb2 = (last && has_next) ? nxt.ldb : cur.ldb, kd1 = cur.kind, kd2 = (last && has_next) ? nxt.kind : cur.kind;
            if (last && has_next) S.a_ready(nxt);
            if constexpr (Epi::RESCALE) { const int ka = cur.kt0 + t; if (cur.kind == 0 && t > 0 && (ka == 8 || ka == 16)) { const int l2 = fresh_lane(); E.rescale(acc, cur, ka >> 3, wr, wc, l2 & 15, l2 >> 4); asm volatile("s_waitcnt vmcnt(0)" ::: "memory"); } }
            PG8_LDB(B0, 0, 0); PG8_LDB(B1, 0, 1); PG8_SCHED; PG8_LDA(At, 0, 0); PG8_STAGE_A(PG8_SA(1, 1), a1 + PG8_HS(lda1), lda1, kd1);
            PG8_WAIT_V(8); PG8_WAIT_L(0); PG8_BAR; PG8_MMA(0, 0, At, B0); PG8_MMA(0, 1, At, B1); PG8_BAR; PG8_SCHED;
            PG8_LDA(At, 0, 1); PG8_STAGE(PG8_SB(0, 0), b2, RB2, ldb2); PG8_STAGE(PG8_SB(0, 1), b2 + PG8_HS(ldb2), RB2, ldb2); PG8_STAGE_A(PG8_SA(0, 0), a2, lda2, kd2);
            PG8_WAIT_V(8); PG8_WAIT_L(0); PG8_BAR; PG8_MMA(1, 0, At, B0); PG8_MMA(1, 1, At, B1); PG8_BAR; PG8_SCHED;
            PG8_LDB(B0, 1, 0); PG8_LDB(B1, 1, 1); PG8_SCHED; PG8_LDA(At, 1, 0); PG8_STAGE_A(PG8_SA(0, 1), a2 + PG8_HS(lda2), lda2, kd2);
            PG8_WAIT_V(8); PG8_WAIT_L(0); PG8_BAR; PG8_MMA(0, 0, At, B0); PG8_MMA(0, 1, At, B1); PG8_BAR; PG8_SCHED;
            PG8_LDA(At, 1, 1); PG8_STAGE(PG8_SB(1, 0), b3, RB2, ldb2); PG8_STAGE(PG8_SB(1, 1), b3 + PG8_HS(ldb2), RB2, ldb2); PG8_STAGE_A(PG8_SA(1, 0), a3, lda2, kd2);
            PG8_WAIT_V(8); PG8_WAIT_L(0); PG8_BAR; PG8_MMA(1, 0, At, B0); PG8_MMA(1, 1, At, B1); PG8_BAR; PG8_SCHED;
        }
        if constexpr (ALIGN_EPI) { if (wr == 0) PG8_BAR; }
        if constexpr (FP8) asm volatile("s_nop 15\n\ts_nop 15" ::: "memory");
        if constexpr (Epi::RESCALE) { if (cur.kind == 0) { const int l2 = fresh_lane(); E.finalize(acc, cur, (cur.kt0 + nt - 1) >> 3, wr, wc, l2 & 15, l2 >> 4); } }
        if (cur.mode == 2) sk_store_partial(acc, X, wid);
        else { if (cur.mode != 0) {
#pragma unroll 1
                for (int pq = cur.peer, pe = cur.peer + (cur.mode == 1 ? 1 : cur.mode - 1); pq < pe; ++pq) sk_add_partial(acc, X, pq, wid); }
            const int l2 = fresh_lane(); E(acc, cur, wr, wc, l2 & 15, l2 >> 4); S.done(cur, l2); }
        if (!has_next) break;
#pragma unroll
        for (int a = 0; a < 2; ++a)
#pragma unroll
            for (int b = 0; b < 2; ++b)
#pragma unroll
                for (int m = 0; m < 4; ++m)
#pragma unroll
                    for (int n = 0; n < 2; ++n) acc[a][b][m][n] = (f32x4){0.f, 0.f, 0.f, 0.f};
        cur = nxt; cA = nA; cB = nB; ++ui;
        if constexpr (ALIGN_EPI) { if (wr == 1) PG8_BAR; }
    }
    PG8_WAIT_V(0);
    if constexpr (!ALIGN_EPI) { if (wr == 0) PG8_BAR; }
    PG8_BAR;
#undef PG8_SA
#undef PG8_SB
#undef PG8_STAGE
#undef PG8_HS
#undef PG8_STAGE_A
#undef PG8_LDA
#undef PG8_LDB
#undef PG8_MMA
#undef PG8_WAIT_V
#undef PG8_WAIT_L
#undef PG8_BAR
#undef PG8_SCHED
}

__device__ __forceinline__ u32x4 pack8(const f32x4& a, const f32x4& b) { u32x4 w; w.x = cvt_pk_bf16(a[0], a[1]); w.y = cvt_pk_bf16(a[2], a[3]); w.z = cvt_pk_bf16(b[0], b[1]); w.w = cvt_pk_bf16(b[2], b[3]); return w; }
__device__ __forceinline__ void unpack8(const u32x4& w, f32x4& a, f32x4& b) { a = (f32x4){bflo(w.x), bfhi(w.x), bflo(w.y), bfhi(w.y)}; b = (f32x4){bflo(w.z), bfhi(w.z), bflo(w.w), bfhi(w.w)}; }

struct EpiInProj {
    static constexpr bool PERM = true, RESCALE = false;
    bf16_t* P; bf16_t* G; const float* qn; const float* kn; const float* bgate; const float* rope; float isc;
    __device__ __forceinline__ void operator()(const f32x4 (&acc)[2][2][4][2], const Unit& u, int wr, int wc, int fr, int fq) const {
        const int T = u.pn, jt = u.pm % 17; const bool lat = (jt != 0);
        const int row0 = u.pm * BM + wr * 64 + fr;
        if (T >= 12) {
            const int c0 = (T - 12) * 256 + wc * 32 + 8 * fq;
            f32x4 bv[2][2];
#pragma unroll
            for (int bj = 0; bj < 2; ++bj)
#pragma unroll
                for (int n = 0; n < 2; ++n) bv[bj][n] = *(const f32x4*)(bgate + c0 + bj * HALF + 4 * n) * -LOG2E;
            const float ke = -isc * LOG2E;
            unsigned char* G8 = (unsigned char*)G + (T - 12) * 256 + wc * 64 + fq * 16;
#pragma unroll
            for (int ai = 0; ai < 2; ++ai)
#pragma unroll
                for (int m = 0; m < 4; ++m) { u32x4 w;
#pragma unroll
                    for (int bj = 0; bj < 2; ++bj)
#pragma unroll
                        for (int n = 0; n < 2; ++n) { const f32x4 z = acc[ai][bj][m][n] * ke + bv[bj][n]; unsigned d = 0;
#pragma unroll
                            for (int x = 0; x < 4; ++x) d |= (unsigned)(255.999f * __builtin_amdgcn_rcpf(1.0f + __builtin_amdgcn_exp2f(z[x]))) << (8 * x);
                            w[2 * bj + n] = d; }
                    *(u32x4*)(G8 + (size_t)(row0 + ai * HALF + m * 16) * PC) = w; }
            return;
        }
        if (T >= 5 && T <= 8) {
            const int c0 = T * 256 + wc * 32 + 8 * fq; const bool sl = (T >= 7);
#pragma unroll
            for (int ai = 0; ai < 2; ++ai)
#pragma unroll
                for (int m = 0; m < 4; ++m) { bf16_t* rowp = P + (size_t)(row0 + ai * HALF + m * 16) * PC + c0;
#pragma unroll
                    for (int bj = 0; bj < 2; ++bj) { f32x4 v0 = acc[ai][bj][m][0] * isc, v1 = acc[ai][bj][m][1] * isc;
                        if (sl) {
#pragma unroll
                            for (int x = 0; x < 4; ++x) { v0[x] = siluf_(v0[x]); v1[x] = siluf_(v1[x]); } }
                        const u32x4 w = pack8(v0, v1);
                        if (T <= 6) asm volatile("global_store_dwordx4 %0, %1, off sc1\n\ts_nop 1" :: "v"(rowp + bj * HALF), "v"(w) : "memory");
                        else *(u32x4*)(rowp + bj * HALF) = w; } }
            return;
        }
        const bool isv = ((T == 2 || T == 11) && wc >= 2);
        const bool donorm = (T <= 1) || (T == 2 && wc < 2);
        const bool dorope = lat && !isv;
        const float scale = (T <= 1 || T == 9 || T == 10) ? C2 : (T == 3 ? 0.125f : 1.0f);
        const float* gain = (T <= 1) ? qn : kn;
        f32x4 g1[2], g2[2];
        if (donorm) {
#pragma unroll
            for (int n = 0; n < 2; ++n) { g1[n] = *(const f32x4*)(gain + 8 * fq + 4 * n); g2[n] = *(const f32x4*)(gain + 32 + 8 * fq + 4 * n); }
        }
        const int cbase = T * 256 + 64 * wc + 8 * fq;
#pragma unroll
        for (int ai = 0; ai < 2; ++ai)
#pragma unroll
            for (int m = 0; m < 4; ++m) {
                f32x4 t1[2], t2[2];
#pragma unroll
                for (int n = 0; n < 2; ++n) { t1[n] = acc[ai][0][m][n] * isc; t2[n] = acc[ai][1][m][n] * isc; }
                if (donorm) {
                    float ss = 0.f;
#pragma unroll
                    for (int n = 0; n < 2; ++n)
#pragma unroll
                        for (int x = 0; x < 4; ++x) ss += t1[n][x] * t1[n][x] + t2[n][x] * t2[n][x];
                    ss += swz_xor<16>(ss); ss = xor32_sum(ss);
                    const float inv = rsqrtf(ss * (1.0f / 64.0f) + EPS);
#pragma unroll
                    for (int n = 0; n < 2; ++n) { t1[n] = t1[n] * inv * g1[n]; t2[n] = t2[n] * inv * g2[n]; }
                }
                if (dorope) {
                    const int grow = 4 * (jt - 1) + 2 * ai + wr, gcol = 16 * m + fr;
                    const int pos = (fq < 2) ? grow : gcol;
                    const float* rp = rope + ((size_t)pos * 16 + 8 * (fq & 1)) * 2;
#pragma unroll
                    for (int n = 0; n < 2; ++n) {
                        const f32x4 cs0 = *(const f32x4*)(rp + 8 * n), cs1 = *(const f32x4*)(rp + 8 * n + 4);
                        const f32x4 c = (f32x4){cs0[0], cs0[2], cs1[0], cs1[2]}, s = (f32x4){cs0[1], cs0[3], cs1[1], cs1[3]};
                        const f32x4 a = t1[n], b = t2[n];
                        t1[n] = a * c - b * s; t2[n] = a * s + b * c;
                    }
                }
#pragma unroll
                for (int n = 0; n < 2; ++n) { t1[n] = t1[n] * scale; t2[n] = t2[n] * scale; }
                bf16_t* rowp = P + (size_t)(row0 + ai * HALF + m * 16) * PC + cbase;
                const u32x4 w1 = pack8(t1[0], t1[1]), w2 = pack8(t2[0], t2[1]);
                if (T == 4) { asm volatile("global_store_dwordx4 %0, %1, off sc1\n\ts_nop 1" :: "v"(rowp), "v"(w1) : "memory"); asm volatile("global_store_dwordx4 %0, %1, off sc1\n\ts_nop 1" :: "v"(rowp + 32), "v"(w2) : "memory"); }
                else { *(u32x4*)(rowp) = w1; *(u32x4*)(rowp + 32) = w2; }
            }
    }
};

struct EpiBranch {
    static constexpr bool PERM = true, RESCALE = true;
    const bf16_t* G; bf16_t* MB;
    static __device__ __forceinline__ f32x4 dec4(unsigned w) { return (f32x4){(float)(w & 0xffu) + 0.5f, (float)((w >> 8) & 0xffu) + 0.5f, (float)((w >> 16) & 0xffu) + 0.5f, (float)(w >> 24) + 0.5f}; }
    __device__ __forceinline__ void rescale(f32x4 (&acc)[2][2][4][2], const Unit& u, int bnd, int wr, int wc, int fr, int fq) const {
        const int row0 = u.pm * BM + wr * 64 + fr; const unsigned char* gb = (const unsigned char*)G + (4 * (bnd - 1) + u.pn) * 256 + wc * 64 + fq * 16;
#pragma unroll
        for (int ai = 0; ai < 2; ++ai) {
            u32x4 gp[4], gc[4];
#pragma unroll
            for (int m = 0; m < 4; ++m) { const unsigned char* p = gb + (size_t)(row0 + ai * HALF + m * 16) * PC; gp[m] = *(const u32x4*)p; gc[m] = *(const u32x4*)(p + 1024); }
#pragma unroll
            for (int m = 0; m < 4; ++m)
#pragma unroll
                for (int bj = 0; bj < 2; ++bj)
#pragma unroll
                    for (int n = 0; n < 2; ++n) { const f32x4 a = dec4(gp[m][2 * bj + n]), b = dec4(gc[m][2 * bj + n]);
#pragma unroll
                        for (int x = 0; x < 4; ++x) acc[ai][bj][m][n][x] *= a[x] * __builtin_amdgcn_rcpf(b[x]); }
        }
    }
    __device__ __forceinline__ void finalize(f32x4 (&acc)[2][2][4][2], const Unit& u, int br, int wr, int wc, int fr, int fq) const {
        const int row0 = u.pm * BM + wr * 64 + fr; const unsigned char* gb = (const unsigned char*)G + (4 * br + u.pn) * 256 + wc * 64 + fq * 16;
#pragma unroll
        for (int ai = 0; ai < 2; ++ai) {
            u32x4 g2[4];
#pragma unroll
            for (int m = 0; m < 4; ++m) g2[m] = *(const u32x4*)(gb + (size_t)(row0 + ai * HALF + m * 16) * PC);
#pragma unroll
            for (int m = 0; m < 4; ++m)
#pragma unroll
                for (int bj = 0; bj < 2; ++bj)
#pragma unroll
                    for (int n = 0; n < 2; ++n) acc[ai][bj][m][n] = acc[ai][bj][m][n] * (dec4(g2[m][2 * bj + n]) * (1.0f / 256.0f));
        }
    }
    __device__ __forceinline__ void operator()(const f32x4 (&acc)[2][2][4][2], const Unit& u, int wr, int wc, int fr, int fq) const {
        const int row0 = u.pm * BM + wr * 64 + fr, c0 = u.pn * BM + wc * 32 + 8 * fq;
#pragma unroll
        for (int ai = 0; ai < 2; ++ai)
#pragma unroll
            for (int m = 0; m < 4; ++m)
#pragma unroll
                for (int bj = 0; bj < 2; ++bj) { const u32x4 w = pack8(acc[ai][bj][m][0], acc[ai][bj][m][1]); asm volatile("global_store_dwordx4 %0, %1, off sc1\n\ts_nop 1" :: "v"(MB + (size_t)(row0 + ai * HALF + m * 16) * D + c0 + bj * HALF), "v"(w) : "memory"); }
    }
};

struct EpiResid {
    static constexpr bool PERM = true, RESCALE = false;
    bf16_t* XS; const float* gate;
    __device__ __forceinline__ void operator()(const f32x4 (&acc)[2][2][4][2], const Unit& u, int wr, int wc, int fr, int fq) const {
        const int who = (u.pm % 17 == 0) ? 4 : (u.pm / 17);
        const float* gp = gate + (size_t)who * INC;
        const int row0 = u.pm * BM + wr * 64 + fr, c0 = u.pn * BM + wc * 32 + 8 * fq;
        f32x4 gv[2][2];
#pragma unroll
        for (int bj = 0; bj < 2; ++bj)
#pragma unroll
            for (int n = 0; n < 2; ++n) gv[bj][n] = *(const f32x4*)(gp + c0 + bj * HALF + n * 4);
#pragma unroll
        for (int ai = 0; ai < 2; ++ai) {
            u32x4 old[4][2];
#pragma unroll
            for (int m = 0; m < 4; ++m)
#pragma unroll
                for (int bj = 0; bj < 2; ++bj) old[m][bj] = *(const u32x4*)(XS + (size_t)(row0 + ai * HALF + m * 16) * D + c0 + bj * HALF);
#pragma unroll
            for (int m = 0; m < 4; ++m)
#pragma unroll
                for (int bj = 0; bj < 2; ++bj) { f32x4 oa, ob; unpack8(old[m][bj], oa, ob);
                    *(u32x4*)(XS + (size_t)(row0 + ai * HALF + m * 16) * D + c0 + bj * HALF) = pack8(oa + gv[bj][0] * acc[ai][bj][m][0], ob + gv[bj][1] * acc[ai][bj][m][1]); }
            asm volatile("" ::: "memory");
        }
    }
};

struct EpiSwiGLU {
    static constexpr bool PERM = true, RESCALE = false;
    bf16_t* H; int ldh;
    __device__ __forceinline__ void operator()(const f32x4 (&acc)[2][2][4][2], const Unit& u, int wr, int wc, int fr, int fq) const {
        const int row0 = u.pm * BM + wr * 64 + fr, c0 = u.pn * HALF + wc * 32 + 8 * fq;
#pragma unroll
        for (int ai = 0; ai < 2; ++ai)
#pragma unroll
            for (int m = 0; m < 4; ++m) { f32x4 v[2];
#pragma unroll
                for (int n = 0; n < 2; ++n)
#pragma unroll
                    for (int x = 0; x < 4; ++x) v[n][x] = siluf_(acc[ai][0][m][n][x]) * acc[ai][1][m][n][x];
                *(u32x4*)(H + (size_t)(row0 + ai * HALF + m * 16) * ldh + c0) = pack8(v[0], v[1]); }
    }
};

struct EpiSwiGLU8 {
    static constexpr bool PERM = true, RESCALE = false;
    unsigned char* H; int ldh; float isc, osc;
    __device__ __forceinline__ void operator()(const f32x4 (&acc)[2][2][4][2], const Unit& u, int wr, int wc, int fr, int fq) const {
        const int row0 = u.pm * BM + wr * 64 + fr, c0 = u.pn * HALF + wc * 32 + 8 * fq;
        const float ke = -isc * LOG2E, kk = isc * isc * osc;
#pragma unroll
        for (int ai = 0; ai < 2; ++ai)
#pragma unroll
            for (int m = 0; m < 4; ++m) { f32x4 v[2];
#pragma unroll
                for (int n = 0; n < 2; ++n)
#pragma unroll
                    for (int x = 0; x < 4; ++x) { const float a = acc[ai][0][m][n][x];
                        v[n][x] = (a * acc[ai][1][m][n][x]) * (kk * __builtin_amdgcn_rcpf(1.0f + __builtin_amdgcn_exp2f(a * ke))); }
                u32x2 w; w.x = pk4_fp8(v[0][0], v[0][1], v[0][2], v[0][3]); w.y = pk4_fp8(v[1][0], v[1][1], v[1][2], v[1][3]);
                *(u32x2*)(H + (size_t)(row0 + ai * HALF + m * 16) * ldh + c0) = w; }
    }
};

struct EpiMoEDown {
    static constexpr bool PERM = true, RESCALE = false;
    bf16_t* Y; const float* cw; float sc;
    __device__ __forceinline__ void operator()(const f32x4 (&acc)[2][2][4][2], const Unit& u, int wr, int wc, int fr, int fq) const {
        const int row0 = u.pm * BM + wr * 64 + fr, c0 = u.pn * BM + wc * 32 + 8 * fq;
#pragma unroll
        for (int ai = 0; ai < 2; ++ai)
#pragma unroll
            for (int m = 0; m < 4; ++m) { const int row = row0 + ai * HALF + m * 16; const float w = cw[row] * sc;
#pragma unroll
                for (int bj = 0; bj < 2; ++bj) *(u32x4*)(Y + (size_t)row * D + c0 + bj * HALF) = pack8(acc[ai][bj][m][0] * w, acc[ai][bj][m][1] * w); }
    }
};
template <class E0, class E1> struct EpiDual {
    static constexpr bool PERM = true, RESCALE = E0::RESCALE; static_assert(E0::PERM && E1::PERM, "dual phases stage B rows permuted for both kinds");
    E0 e0; E1 e1;
    __device__ __forceinline__ void rescale(f32x4 (&acc)[2][2][4][2], const Unit& u, int bnd, int wr, int wc, int fr, int fq) const { e0.rescale(acc, u, bnd, wr, wc, fr, fq); }
    __device__ __forceinline__ void finalize(f32x4 (&acc)[2][2][4][2], const Unit& u, int br, int wr, int wc, int fr, int fq) const { e0.finalize(acc, u, br, wr, wc, fr, fq); }
    __device__ __forceinline__ void operator()(const f32x4 (&acc)[2][2][4][2], const Unit& u, int wr, int wc, int fr, int fq) const { if (u.kind == 0) e0(acc, u, wr, wc, fr, fq); else e1(acc, u, wr, wc, fr, fq); }
};
}
namespace attn_body {
using bf16=unsigned short;
constexpr int D=64, QKP=3072  , OPITCH=1536  ;
constexpr int NW=8,QBLK=32,QB=QBLK*NW,KVBLK=64;
__device__ __forceinline__ int crow(int r,int hi){return (r&3)+8*(r>>2)+4*hi;}
#define SBAR() __builtin_amdgcn_sched_barrier(0)
__device__ __forceinline__ void wmask(f32x16&p0,f32x16&p1,int t,int qrel,int hi,int qoff){
  const float NEG=-INFINITY; const unsigned base=(unsigned)(64*(t-4)+4*hi-qrel-qoff+128);
  #pragma unroll
  for(int r=0;r<16;++r){const unsigned u=base+(unsigned)((r&3)+8*(r>>2)); if(u>256u)p0[r]=NEG; if(u+32u>256u)p1[r]=NEG;}
}

constexpr int NSLOT=3, SLOTB=8192;
constexpr int LDS_K=0, LDS_V=NSLOT*SLOTB, LDS_WS=2*NSLOT*SLOTB, LDS_OST=LDS_WS+NW*64*4, LDS_BYTES=LDS_OST+NW*4096;
__device__ __forceinline__ void glds16(const void*gsrc,unsigned lds_dst){unsigned keep;
  asm volatile("s_mov_b32 %0, m0\n\ts_mov_b32 m0, %2\n\ts_nop 0\n\tglobal_load_lds_dwordx4 %1, off\n\ts_mov_b32 m0, %0":"=&s"(keep):"v"(gsrc),"s"(lds_dst):"memory");}
__device__ __forceinline__ float max3f(float a,float b,float c){float r;asm("v_max3_f32 %0, %1, %2, %3":"=v"(r):"v"(a),"v"(b),"v"(c));return r;}
__device__ __forceinline__ float max2f(float a,float b){float r;asm("v_max_f32_e32 %0, %1, %2":"=v"(r):"v"(a),"v"(b));return r;}
__device__ __forceinline__ float fadd_s(float a,float b){float r;asm("v_add_f32_e32 %0, %1, %2":"=v"(r):"v"(a),"v"(b));return r;}
__device__ __forceinline__ float fsub_s(float a,float b){float r;asm("v_sub_f32_e32 %0, %1, %2":"=v"(r):"v"(a),"v"(b));return r;}
typedef float f32x2_t __attribute__((ext_vector_type(2))); typedef __bf16 bf16x2_t __attribute__((ext_vector_type(2)));
__device__ __forceinline__ unsigned cvtpk_s(float lo,float hi){f32x2_t v={lo,hi};bf16x2_t b=__builtin_convertvector(v,bf16x2_t);return __builtin_bit_cast(unsigned,b);}
#define WAIT_BAR(N) asm volatile("s_waitcnt vmcnt(" #N ") lgkmcnt(0)\n\ts_barrier":::"memory")

__device__ __forceinline__ void qkt(f32x16&p0,f32x16&p1,const char*Kslot,const bf16x8*qr,const f32x16&negm,int r32,int hi){
  const char*kb=Kslot+hi*1024+r32*16;
  #pragma unroll
  for(int d0=0;d0<4;++d0){
    const bf16x8 b0=*reinterpret_cast<const bf16x8*>(kb+d0*2048);
    const bf16x8 b1=*reinterpret_cast<const bf16x8*>(kb+d0*2048+512);
    if(d0==0){p0=__builtin_amdgcn_mfma_f32_32x32x16_bf16(b0,qr[0],negm,0,0,0);p1=__builtin_amdgcn_mfma_f32_32x32x16_bf16(b1,qr[0],negm,0,0,0);}
    else{p0=__builtin_amdgcn_mfma_f32_32x32x16_bf16(b0,qr[d0],p0,0,0,0);p1=__builtin_amdgcn_mfma_f32_32x32x16_bf16(b1,qr[d0],p1,0,0,0);}}
}
typedef __attribute__((address_space(3))) const char* lds_cptr;
typedef short v4i16_t __attribute__((ext_vector_type(4)));
__device__ __forceinline__ void kload8(bf16x8*kf,lds_cptr kp){
  kf[0]=*(const __attribute__((address_space(3))) bf16x8*)(kp);      kf[1]=*(const __attribute__((address_space(3))) bf16x8*)(kp+512);
  kf[2]=*(const __attribute__((address_space(3))) bf16x8*)(kp+2048); kf[3]=*(const __attribute__((address_space(3))) bf16x8*)(kp+2560);
  kf[4]=*(const __attribute__((address_space(3))) bf16x8*)(kp+4096); kf[5]=*(const __attribute__((address_space(3))) bf16x8*)(kp+4608);
  kf[6]=*(const __attribute__((address_space(3))) bf16x8*)(kp+6144); kf[7]=*(const __attribute__((address_space(3))) bf16x8*)(kp+6656);
}
__device__ __forceinline__ void kload2(bf16x8*kf,lds_cptr kp,int j){ kf[2*j]=*(const __attribute__((address_space(3))) bf16x8*)(kp+j*2048); kf[2*j+1]=*(const __attribute__((address_space(3))) bf16x8*)(kp+j*2048+512); }
__device__ __forceinline__ s16x4 vtr(lds_cptr p){ return __builtin_bit_cast(s16x4,__builtin_amdgcn_ds_read_tr16_b64_v4i16((__attribute__((address_space(3))) v4i16_t*)p)); }
__device__ __forceinline__ float rowmax(const f32x16&p0,const f32x16&p1){
  float a=max3f(p0[0],p0[1],p1[0]),b=max3f(p0[2],p0[3],p1[1]);a=max3f(a,p1[2],p1[3]);
  #pragma unroll
  for(int r=4;r<16;r+=4){a=max3f(a,p0[r],p0[r+1]);b=max3f(b,p0[r+2],p0[r+3]);a=max3f(a,p1[r],p1[r+1]);b=max3f(b,p1[r+2],p1[r+3]);}
  const float m=max2f(a,b);
  auto rr=__builtin_amdgcn_permlane32_swap(__float_as_uint(m),__float_as_uint(m),false,false);
  return max2f(__uint_as_float(rr[0]),__uint_as_float(rr[1]));
}
__device__ __forceinline__ void pv(f32x16*o,int vb,bf16x8 pa0,bf16x8 pa1,bf16x8 pa2,bf16x8 pa3){
  #pragma unroll
  for(int d0=0;d0<2;++d0){s16x4 lo[4],hi[4];
    #pragma unroll
    for(int ks=0;ks<4;++ks){
      asm volatile("ds_read_b64_tr_b16 %0,%1 offset:%c2":"=&v"(lo[ks]):"v"(vb),"i"(d0*4096+ks*1024):"memory");
      asm volatile("ds_read_b64_tr_b16 %0,%1 offset:%c2":"=&v"(hi[ks]):"v"(vb),"i"(d0*4096+ks*1024+512):"memory");}
    asm volatile("s_waitcnt lgkmcnt(0)":::"memory");SBAR();
    #define PK(k) (bf16x8){lo[k][0],lo[k][1],lo[k][2],lo[k][3],hi[k][0],hi[k][1],hi[k][2],hi[k][3]}
    o[d0]=__builtin_amdgcn_mfma_f32_32x32x16_bf16(pa0,PK(0),o[d0],0,0,0);
    o[d0]=__builtin_amdgcn_mfma_f32_32x32x16_bf16(pa1,PK(1),o[d0],0,0,0);
    o[d0]=__builtin_amdgcn_mfma_f32_32x32x16_bf16(pa2,PK(2),o[d0],0,0,0);
    o[d0]=__builtin_amdgcn_mfma_f32_32x32x16_bf16(pa3,PK(3),o[d0],0,0,0);
    #undef PK
  }
}

#ifndef ATTN_STORE16
#define ATTN_STORE16(p,v) (*(u32x4*)(p)=(v))
#endif
template<int THRL,int MODE> __device__ __forceinline__ void attn_unit(const bf16*Qu,const bf16*__restrict__ Kh,const bf16*__restrict__ Vh,bf16*Ou,const int NT,const int kgap,const int qoff,const float sink2,char*shm,const int tid){
  const int lane=tid&63,r32=lane&31,hi=lane>>5; const int wid=__builtin_amdgcn_readfirstlane(tid>>6);
  const bf16*Qw=Qu+(long)(wid*QBLK)*QKP;
  const unsigned lds0=(unsigned)(uintptr_t)shm;
  float*wsf=(float*)(shm+LDS_WS)+wid*64;
  const bf16*ksrc=Kh+(long)lane*QKP+wid*8;
  const bf16*vsrc=Vh+(long)(16*(wid&3)+(lane>>2))*QKP+(wid>>2)*32+(lane&3)*8;
  const unsigned kdst=lds0+LDS_K+wid*1024, vdst=lds0+LDS_V+wid*1024;
  #define ROWOFF(t) ((long)((t)*KVBLK+(((t)>=4)?kgap:0))*QKP)
  #define DMA_K(t,slot) glds16(ksrc+ROWOFF(t),(unsigned)__builtin_amdgcn_readfirstlane(kdst+(slot)))
  #define DMA_V(t,slot) glds16(vsrc+ROWOFF(t),(unsigned)__builtin_amdgcn_readfirstlane(vdst+(slot)))
  const int vb0=(int)(lds0+LDS_V)+((lane>>4)&1)*32+(lane&3)*8+(4*hi+((lane&15)>>2))*64;
  const char*Kbase=shm+LDS_K; bf16x8 kf[8];
  const lds_cptr shm3=(lds_cptr)shm; const lds_cptr kp0=shm3+LDS_K+hi*1024+r32*16; const lds_cptr vp0=shm3+LDS_V+((lane>>4)&1)*32+(lane&3)*8+(4*hi+((lane&15)>>2))*64;
  DMA_K(0,0);DMA_V(0,0);DMA_K(1,SLOTB);
  bf16x8 qr[4];
  #pragma unroll
  for(int d0=0;d0<4;++d0)qr[d0]=*reinterpret_cast<const bf16x8*>(&Qw[(long)r32*QKP+d0*16+hi*8]);
  float mhat=0.f,l_reg=0.f;f32x16 o[2];o[0]=f32x16{};o[1]=f32x16{};f32x16 negm=f32x16{};asm volatile("":"+v"(negm));
  const int qrel=wid*QBLK+r32;
  #define CMASK(P0,P1,t) do{ if(MODE==1&&(t)>=4)wmask(P0,P1,(t),qrel,hi,qoff); }while(0)
  bool resc=false;
  #define START(P0,P1) do{ const float rm=rowmax(P0,P1); resc=false; \
    { const float dl=rm; mhat=fadd_s(mhat,dl); \
      _Pragma("unroll") for(int r=0;r<16;++r){P0[r]=fsub_s(P0[r],dl);P1[r]=fsub_s(P1[r],dl);} \
      _Pragma("unroll") for(int r=0;r<16;++r)negm[r]=-mhat; asm volatile("":"+v"(negm)); } \
    _Pragma("unroll") for(int r=0;r<16;++r)P0[r]=__builtin_amdgcn_exp2f(P0[r]); }while(0)
  #define RESC() do{ if(resc){ asm volatile("s_waitcnt lgkmcnt(0)":::"memory"); \
      _Pragma("unroll") for(int d_=0;d_<2;++d_) _Pragma("unroll") for(int r=0;r<16;++r)o[d_][r]*=wsf[crow(r,hi)]; } }while(0)
  f32x16 pA0,pA1,pB0,pB1;
  int sl_prev=0,sl_cur=0,sl_next=SLOTB;
  #define ROT() do{sl_prev=sl_cur;sl_cur=sl_next;sl_next=(sl_next==(NSLOT-1)*SLOTB)?0:sl_next+SLOTB;}while(0)
  DMA_K(2,2*SLOTB);
  WAIT_BAR(3);
  qkt(pA0,pA1,Kbase,qr,negm,r32,hi);asm volatile("s_nop 15\n\ts_nop 7":"+v"(pA0),"+v"(pA1));CMASK(pA0,pA1,0);
  START(pA0,pA1);
  _Pragma("unroll") for(int r=0;r<16;++r)pA1[r]=__builtin_amdgcn_exp2f(pA1[r]);
  WAIT_BAR(0);
  DMA_K(3,0);DMA_V(1,SLOTB);
  ROT();
  kload8(kf,kp0+sl_cur);
  WAIT_BAR(2);
  s16x4 vlo[8],vhi[8]; u32x4 pw0,pw1,pw2,pw3;
  #define PKW(P,B) cvtpk_s(P[B],P[B+1])
  #define PAF(k) __builtin_bit_cast(bf16x8,pw##k)
  #define VFR(i) (bf16x8){vlo[i][0],vlo[i][1],vlo[i][2],vlo[i][3],vhi[i][0],vhi[i][1],vhi[i][2],vhi[i][3]}
  #define PIN(x) asm volatile("":"+v"(x))
  #define MX3(a,b,c) __builtin_fmaxf(__builtin_fmaxf((a),(b)),(c))
  #define GAPA(MF,A0,A1,A2,A3,W0,W1,PW) do{ MF; sacc+=A0; sacc+=A1; sacc+=A2; sacc+=A3; PIN(sacc); W0; W1; PIN(PW); SBAR(); }while(0)
  #define EX(v) __builtin_amdgcn_exp2f(v)
  #define GAPB(MF,X,B) do{ MF; X[B]=EX(X[B]); X[B+1]=EX(X[B+1]); X[B+2]=EX(X[B+2]); X[B+3]=EX(X[B+3]); PIN(X); SBAR(); }while(0)
  #define VRD(i) do{ vlo[i]=vtr(vp_+(((i)>>2)*4096+((i)&3)*1024)); vhi[i]=vtr(vp_+(((i)>>2)*4096+((i)&3)*1024+512)); }while(0)
  #define KRD(G,j) do{ if(G){ kload2(kf,kp0+sl_next,j); SBAR(); } }while(0)
  #define STEP(C0,C1,P0,P1,t,GK,GV,GL) do{ SBAR(); \
    const lds_cptr vp_=vp0+sl_prev; \
    VRD(0); SBAR(); float sacc=(P0[0]+P0[1]); \
    GAPA(C0=__builtin_amdgcn_mfma_f32_32x32x16_bf16(kf[0],qr[0],negm,0,0,0), P0[2],P0[3],P0[4],P0[5],     pw0[0]=PKW(P0,0), pw0[1]=PKW(P0,2), pw0); \
    VRD(4); SBAR(); GAPA(C1=__builtin_amdgcn_mfma_f32_32x32x16_bf16(kf[1],qr[0],negm,0,0,0), P0[6],P0[7],P0[8],P0[9],     pw0[2]=PKW(P0,4), pw0[3]=PKW(P0,6), pw0); \
    VRD(1); SBAR(); GAPA(C0=__builtin_amdgcn_mfma_f32_32x32x16_bf16(kf[2],qr[1],C0,0,0,0),   P0[10],P0[11],P0[12],P0[13], pw1[0]=PKW(P0,8), pw1[1]=PKW(P0,10), pw1); \
    VRD(5); SBAR(); GAPA(C1=__builtin_amdgcn_mfma_f32_32x32x16_bf16(kf[3],qr[1],C1,0,0,0),   P0[14],P0[15],P1[0],P1[1],   pw1[2]=PKW(P0,12),pw1[3]=PKW(P0,14), pw1); \
    VRD(2); SBAR(); GAPA(C0=__builtin_amdgcn_mfma_f32_32x32x16_bf16(kf[4],qr[2],C0,0,0,0),   P1[2],P1[3],P1[4],P1[5],     pw2[0]=PKW(P1,0), pw2[1]=PKW(P1,2), pw2); \
    VRD(6); SBAR(); GAPA(C1=__builtin_amdgcn_mfma_f32_32x32x16_bf16(kf[5],qr[2],C1,0,0,0),   P1[6],P1[7],P1[8],P1[9],     pw2[2]=PKW(P1,4), pw2[3]=PKW(P1,6), pw2); \
    VRD(3); SBAR(); GAPA(C0=__builtin_amdgcn_mfma_f32_32x32x16_bf16(kf[6],qr[3],C0,0,0,0),   P1[10],P1[11],P1[12],P1[13], pw3[0]=PKW(P1,8), pw3[1]=PKW(P1,10), pw3); \
    VRD(7); SBAR(); GAPA(C1=__builtin_amdgcn_mfma_f32_32x32x16_bf16(kf[7],qr[3],C1,0,0,0),   P1[14],P1[15],0.f,0.f,       pw3[2]=PKW(P1,12),pw3[3]=PKW(P1,14), pw3); \
    l_reg+=sacc; \
    if(GK){DMA_K((t)+3,sl_cur);} if(GV){DMA_V((t)+1,sl_next);} \
    CMASK(C0,C1,t); \
    { float a=MX3(C0[0],C0[1],C1[0]),b=MX3(C0[2],C0[3],C1[1]); a=MX3(a,C1[2],C1[3]); \
      _Pragma("unroll") for(int r=4;r<16;r+=4){a=MX3(a,C0[r],C0[r+1]);b=MX3(b,C0[r+2],C0[r+3]);a=MX3(a,C1[r],C1[r+1]);b=MX3(b,C1[r+2],C1[r+3]);} \
      float rm=__builtin_fmaxf(a,b); { auto rr=__builtin_amdgcn_permlane32_swap(__float_as_uint(rm),__float_as_uint(rm),false,false); rm=__builtin_fmaxf(__uint_as_float(rr[0]),__uint_as_float(rr[1])); } \
      resc=false; \
      if(__builtin_expect(__any(rm>(float)THRL),0)){ const float dl=__builtin_fmaxf(rm,0.f); mhat+=dl; \
        _Pragma("unroll") for(int r=0;r<16;++r){C0[r]-=dl;C1[r]-=dl;} \
        _Pragma("unroll") for(int r=0;r<16;++r)negm[r]=-mhat; asm volatile("":"+v"(negm)); \
        const float f=__builtin_amdgcn_exp2f(-dl); l_reg*=f; if(hi==0)wsf[r32]=f; resc=true; } } \
    SBAR(); \
    GAPB(o[0]=__builtin_amdgcn_mfma_f32_32x32x16_bf16(PAF(0),VFR(0),o[0],0,0,0), C0,0); \
    GAPB(o[1]=__builtin_amdgcn_mfma_f32_32x32x16_bf16(PAF(0),VFR(4),o[1],0,0,0), C0,4); \
    KRD(GL,0); GAPB(o[0]=__builtin_amdgcn_mfma_f32_32x32x16_bf16(PAF(1),VFR(1),o[0],0,0,0), C0,8); \
    KRD(GL,1); GAPB(o[1]=__builtin_amdgcn_mfma_f32_32x32x16_bf16(PAF(1),VFR(5),o[1],0,0,0), C0,12); \
    KRD(GL,2); GAPB(o[0]=__builtin_amdgcn_mfma_f32_32x32x16_bf16(PAF(2),VFR(2),o[0],0,0,0), C1,0); \
    KRD(GL,3); GAPB(o[1]=__builtin_amdgcn_mfma_f32_32x32x16_bf16(PAF(2),VFR(6),o[1],0,0,0), C1,4); \
    GAPB(o[0]=__builtin_amdgcn_mfma_f32_32x32x16_bf16(PAF(3),VFR(3),o[0],0,0,0), C1,8); \
    GAPB(o[1]=__builtin_amdgcn_mfma_f32_32x32x16_bf16(PAF(3),VFR(7),o[1],0,0,0), C1,12); \
    }while(0)
  int t=1;
  for(;t+5<NT;t+=2){
    STEP(pB0,pB1,pA0,pA1,t,true,true,true);     WAIT_BAR(2); RESC(); ROT();
    STEP(pA0,pA1,pB0,pB1,t+1,true,true,true);   WAIT_BAR(2); RESC(); ROT();
  }
  #define ENDW(tt) do{ if((tt)+3<NT){WAIT_BAR(2);} else if((tt)+2<NT){WAIT_BAR(1);} else {WAIT_BAR(0);} }while(0)
  for(;t+1<NT;t+=2){
    STEP(pB0,pB1,pA0,pA1,t,(t+3<NT),(t+1<NT),(t+1<NT));       ENDW(t);   RESC(); ROT();
    STEP(pA0,pA1,pB0,pB1,t+1,(t+4<NT),(t+2<NT),(t+2<NT));     ENDW(t+1); RESC(); ROT();
  }
  STEP(pB0,pB1,pA0,pA1,NT-1,false,false,false); RESC();
  { float sacc=pB0[0]+pB0[1]; _Pragma("unroll") for(int r=2;r<16;++r)sacc+=pB0[r]; _Pragma("unroll") for(int r=0;r<16;++r)sacc+=pB1[r]; l_reg+=sacc;
    pw0=(u32x4){PKW(pB0,0),PKW(pB0,2),PKW(pB0,4),PKW(pB0,6)};pw1=(u32x4){PKW(pB0,8),PKW(pB0,10),PKW(pB0,12),PKW(pB0,14)};pw2=(u32x4){PKW(pB1,0),PKW(pB1,2),PKW(pB1,4),PKW(pB1,6)};pw3=(u32x4){PKW(pB1,8),PKW(pB1,10),PKW(pB1,12),PKW(pB1,14)};
    SBAR(); pv(o,vb0+sl_cur,PAF(0),PAF(1),PAF(2),PAF(3)); }
  #undef PKW
  #undef PAF
  #undef VFR
  #undef PIN
  #undef MX3
  #undef GAPA
  #undef GAPB
  #undef EX
  #undef VRD
  #undef KRD
  #undef STEP
  #undef ENDW
  {auto rr=__builtin_amdgcn_permlane32_swap(__float_as_uint(l_reg),__float_as_uint(l_reg),false,false);l_reg=__uint_as_float(rr[0])+__uint_as_float(rr[1]);}
  l_reg+=__builtin_amdgcn_exp2f(sink2-mhat);
  if(hi==0)wsf[32+r32]=l_reg;asm volatile("s_waitcnt lgkmcnt(0)":::"memory");
  float rli[16];
  #pragma unroll
  for(int r=0;r<16;++r)rli[r]=__builtin_amdgcn_rcpf(wsf[32+crow(r,hi)]);
  bf16*Ow=Ou+(long)(wid*QBLK)*OPITCH;
  { bf16*stg=(bf16*)(shm+LDS_OST)+wid*2048;
    #pragma unroll
    for(int r=0;r<16;++r){const int orow=crow(r,hi);
      #pragma unroll
      for(int d0=0;d0<2;++d0)stg[orow*64+d0*32+r32]=(bf16)f2bf(o[d0][r]*rli[r]);}
    asm volatile("s_waitcnt lgkmcnt(0)":::"memory");
    #pragma unroll
    for(int i=0;i<4;++i){const int row=i*8+(lane>>3),ch=lane&7; const u32x4 v=*(const u32x4*)(stg+row*64+ch*8); ATTN_STORE16(Ow+(long)row*OPITCH+ch*8,v);} }
  asm volatile("s_waitcnt lgkmcnt(0)\n\ts_barrier":::"memory");
  #undef ROWOFF
  #undef DMA_K
  #undef DMA_V
  #undef CMASK
  #undef START
  #undef RESC
  #undef ROT
}
constexpr int ATTN_LDS_BYTES=LDS_BYTES;
#undef SBAR
#undef WAIT_BAR
}
__device__ __forceinline__ void wait_panel(unsigned* cnt, unsigned* tmo, int pm, int wave_s, unsigned need);
namespace ret {
constexpr int RSV = 136, RSK = 72;
constexpr int NCH = TPB / 128;
typedef short v4i16_t __attribute__((ext_vector_type(4)));
__device__ __forceinline__ s16x4 trd(const LAS char* p) { return __builtin_bit_cast(s16x4, __builtin_amdgcn_ds_read_tr16_b64_v4i16((LAS v4i16_t*)p)); }
#define RET_FRAG(lo, hi) (bf16x8){lo[0], lo[1], lo[2], lo[3], hi[0], hi[1], hi[2], hi[3]}
__device__ __forceinline__ size_t kvs_index(int dir, int b, int cidx, int hd) { return ((((size_t)dir * NB + b) * NCH + cidx) * 4 + hd) * 8192; }

__device__ __forceinline__ void stage_v(const bf16_t* P, int row0, int hd, LAS char* vimg, int tid) {
#pragma unroll
    for (int i = 0; i < 4; ++i) { const int c = tid + 512 * i, j = c >> 4, ch = c & 15;
        const u32x4 v = *(const u32x4*)(P + (size_t)(row0 + j) * PC + 1280 + 128 * hd + 8 * ch);
        *(LAS u32x4*)(vimg + (j * RSV + 8 * ch) * 2) = v; }
}

struct KvLoad { u32x4 kw[2], vv[4]; };
__device__ __forceinline__ void kvinc_load(const bf16_t* P, int u, const int tid, KvLoad& L) {
    const int b = u / (4 * NCH), hd = (u / NCH) & 3, cidx = u % NCH, row0 = b * TPB + 128 * cidx;
#pragma unroll
    for (int i = 0; i < 2; ++i) { const int c = tid + 512 * i, j = c >> 3, ch = c & 7; L.kw[i] = *(const u32x4*)(P + (size_t)(row0 + j) * PC + 1024 + 64 * hd + 8 * ch); }
#pragma unroll
    for (int i = 0; i < 4; ++i) { const int c = tid + 512 * i, j = c >> 4, ch = c & 15; L.vv[i] = *(const u32x4*)(P + (size_t)(row0 + j) * PC + 1280 + 128 * hd + 8 * ch); }
}
__device__ __forceinline__ void kvinc_units(const bf16_t* P, float* KVS, const float* rc, int u0, int ustep, int nU, unsigned* cnt, unsigned* tmo, int wave_s, LAS char* lds, const int tid) {
    const int lane = tid & 63, wid = __builtin_amdgcn_readfirstlane(tid >> 6), r = lane & 31, hh = lane >> 5;
    LAS char* kimg0 = lds; LAS char* kimg1 = lds + 128 * RSK * 2; LAS char* vimg = lds + 2 * 128 * RSK * 2;
    int u = u0; if (u >= nU) return;
    ::wait_panel(cnt, tmo, 17 * (u / (4 * NCH)) + ((u % NCH) >> 1), wave_s, 24u);
    KvLoad L; kvinc_load(P, u, tid, L);
#pragma unroll 1
    for (;;) {
        const int b = u / (4 * NCH), hd = (u / NCH) & 3, cidx = u % NCH;
        const float lgf2 = rc[2 * hd], lgb2 = rc[8 + 2 * hd];
#pragma unroll
        for (int i = 0; i < 2; ++i) { const int c = tid + 512 * i, j = c >> 3, ch = c & 7;
            const float wf = __builtin_amdgcn_exp2f((float)(127 - j) * lgf2), wb = __builtin_amdgcn_exp2f((float)j * lgb2);
            f32x4 a, bq; pg8::unpack8(L.kw[i], a, bq);
            *(LAS u32x4*)(kimg0 + (j * RSK + 8 * ch) * 2) = pg8::pack8(a * wf, bq * wf);
            *(LAS u32x4*)(kimg1 + (j * RSK + 8 * ch) * 2) = pg8::pack8(a * wb, bq * wb); }
#pragma unroll
        for (int i = 0; i < 4; ++i) { const int c = tid + 512 * i, j = c >> 4, ch = c & 15; *(LAS u32x4*)(vimg + (j * RSV + 8 * ch) * 2) = L.vv[i]; }
        LDS_WAIT(); __syncthreads();
        const int un = u + ustep;
        if (un < nU) { ::wait_panel(cnt, tmo, 17 * (un / (4 * NCH)) + ((un % NCH) >> 1), wave_s, 24u); kvinc_load(P, un, tid, L); }
        const int dir = wid >> 2, eb = wid & 3;
        const LAS char* kimg = dir ? kimg1 : kimg0;
        const int q = (lane & 15) >> 2, p = lane & 3, c16 = 16 * ((lane >> 4) & 1) + 4 * p;
        f32x16 acc[2]; acc[0] = f32x16{}; acc[1] = f32x16{};
#pragma unroll
        for (int ks = 0; ks < 8; ++ks) {
            const int j0 = 16 * ks + 8 * hh + q;
            const s16x4 vlo = trd(vimg + (j0 * RSV + 32 * eb + c16) * 2), vhi = trd(vimg + ((j0 + 4) * RSV + 32 * eb + c16) * 2);
            const bf16x8 vf = RET_FRAG(vlo, vhi);
#pragma unroll
            for (int db = 0; db < 2; ++db) {
                const s16x4 klo = trd(kimg + (j0 * RSK + 32 * db + c16) * 2), khi = trd(kimg + ((j0 + 4) * RSK + 32 * db + c16) * 2);
                acc[db] = __builtin_amdgcn_mfma_f32_32x32x16_bf16(RET_FRAG(klo, khi), vf, acc[db], 0, 0, 0);
            }
        }
        float* out = KVS + kvs_index(dir, b, cidx, hd);
#pragma unroll
        for (int db = 0; db < 2; ++db)
#pragma unroll
            for (int reg = 0; reg < 16; ++reg) { const int d = 32 * db + (reg & 3) + 8 * (reg >> 2) + 4 * hh; out[d * 128 + 32 * eb + r] = acc[db][reg]; }
        __syncthreads();
        if (un >= nU) break;
        u = un;
    }
}

__device__ __forceinline__ void scan_phase(const float* KVS, bf16_t* KVB, const float* retc_l, int gtid, int gthreads) {
    for (int idx = gtid; idx < 2 * NB * 4 * 4096; idx += gthreads) {
        const int el = (idx & 4095) * 2, seq = idx >> 12, hd = seq & 3, b = (seq >> 2) & 3, dir = seq >> 4;
        const float dec = retc_l[(dir * 4 + hd) * 2 + 1];
        const size_t off = kvs_index(dir, b, 0, hd) + el;
        f32x2 v[NCH];
#pragma unroll
        for (int n = 0; n < NCH; ++n) { const int cidx = dir == 0 ? n : (n < 2 ? 1 - n : 35 - n); v[n] = *(const f32x2*)(KVS + off + (size_t)cidx * 4 * 8192); }
        f32x2 st = (f32x2){0.f, 0.f};
#pragma unroll
        for (int n = 0; n < NCH; ++n) { const int cidx = dir == 0 ? n : (n < 2 ? 1 - n : 35 - n); *(unsigned*)(KVB + off + (size_t)cidx * 4 * 8192) = pk2(st[0], st[1]); st = st * dec + v[n]; }
    }
}

struct RetLoad { u32x4 vv[4], kk[2]; u32x2 hv[2][4]; bf16x8 qr[4]; };
__device__ __forceinline__ void retout_load(const bf16_t* P, const bf16_t* KVS, int u, const int tid, RetLoad& L) {
    const int b = u / (4 * NCH), hd = (u / NCH) & 3, cidx = u % NCH;
    const int lane = tid & 63, wid = __builtin_amdgcn_readfirstlane(tid >> 6), r = lane & 31, hh = lane >> 5;
    const int row0 = b * TPB + 128 * cidx, ib = wid & 3;
#pragma unroll
    for (int i = 0; i < 4; ++i) { const int c = tid + 512 * i, j = c >> 4, ch = c & 15; L.vv[i] = *(const u32x4*)(P + (size_t)(row0 + j) * PC + 1280 + 128 * hd + 8 * ch); }
#pragma unroll
    for (int i = 0; i < 2; ++i) { const int c = tid + 512 * i, j = c >> 3, ch = c & 7; L.kk[i] = *(const u32x4*)(P + (size_t)(row0 + j) * PC + 1024 + 64 * hd + 8 * ch); }
#pragma unroll
    for (int dir = 0; dir < 2; ++dir) { const bf16_t* H = KVS + kvs_index(dir, b, cidx, hd);
#pragma unroll
        for (int i = 0; i < 4; ++i) { const int c = tid + 512 * i; L.hv[dir][i] = *(const u32x2*)(H + (c >> 5) * 128 + (c & 31) * 4); } }
    const int iloc = 32 * ib + r;
#pragma unroll
    for (int d0 = 0; d0 < 4; ++d0) L.qr[d0] = *(const bf16x8*)(P + (size_t)(row0 + iloc) * PC + 768 + 64 * hd + 16 * d0 + 8 * hh);
}
__device__ __forceinline__ void retout_units(const bf16_t* P, const bf16_t* KVS, bf16_t* Y3, const float* gainl, const float* rc, int u0, int ustep, int nU, bool skip_ctx, LAS char* lds, const int tid) {
    const int lane = tid & 63, wid = __builtin_amdgcn_readfirstlane(tid >> 6), r = lane & 31, hh = lane >> 5;
    const int ib = wid & 3, eh = wid >> 2;
    LAS char* vimg = lds; LAS char* himg0 = lds + 128 * RSV * 2; LAS char* himg1 = himg0 + 64 * RSV * 2; LAS char* kimg = himg1 + 64 * RSV * 2;
    LAS float* part1 = (LAS float*)(kimg + 128 * RSK * 2); LAS float* part2 = part1 + 256;
    const int nV = skip_ctx ? (nU / NCH) * (NCH - 2) : nU;
#define RET_UNIT_OF(v) (skip_ctx ? ((v) / (NCH - 2)) * NCH + 2 + (v) % (NCH - 2) : (v))
    int vi = u0; if (vi >= nV) return;
    int u = RET_UNIT_OF(vi);
    RetLoad L; retout_load(P, KVS, u, tid, L);
#pragma unroll 1
    for (;;) {
    const int b = u / (4 * NCH), hd = (u / NCH) & 3, cidx = u % NCH;
    const float lgf2 = rc[2 * hd], lgb2 = rc[8 + 2 * hd];
    const int row0 = b * TPB + 128 * cidx;
    const int iloc = 32 * ib + r;
    bf16x8 qr[4];
#pragma unroll
    for (int d0 = 0; d0 < 4; ++d0) qr[d0] = L.qr[d0];
#pragma unroll
    for (int i = 0; i < 4; ++i) { const int c = tid + 512 * i, j = c >> 4, ch = c & 15; *(LAS u32x4*)(vimg + (j * RSV + 8 * ch) * 2) = L.vv[i]; }
#pragma unroll
    for (int i = 0; i < 2; ++i) { const int c = tid + 512 * i, j = c >> 3, ch = c & 7; *(LAS u32x4*)(kimg + (j * RSK + 8 * ch) * 2) = L.kk[i]; }
#pragma unroll
    for (int dir = 0; dir < 2; ++dir) { LAS char* himg = dir ? himg1 : himg0;
#pragma unroll
        for (int i = 0; i < 4; ++i) { const int c = tid + 512 * i, d = c >> 5, e4 = (c & 31) * 4; *(LAS u32x2*)(himg + (d * RSV + e4) * 2) = L.hv[dir][i]; } }
    LDS_WAIT(); __syncthreads();
    const int vn = vi + ustep, un = RET_UNIT_OF(vn);
    if (vn < nV) retout_load(P, KVS, un, tid, L);
    const int q = (lane & 15) >> 2, p = lane & 3, c16 = 16 * ((lane >> 4) & 1) + 4 * p;
    f32x16 O[2]; O[0] = f32x16{}; O[1] = f32x16{};
#pragma unroll 2
    for (int jb = 0; jb < 4; ++jb) {
        f32x16 X = f32x16{};
#pragma unroll
        for (int d0 = 0; d0 < 4; ++d0) { const bf16x8 kf = *(const LAS bf16x8*)(kimg + ((32 * jb + r) * RSK + 16 * d0 + 8 * hh) * 2);
            X = __builtin_amdgcn_mfma_f32_32x32x16_bf16(kf, qr[d0], X, 0, 0, 0); }
#pragma unroll
        for (int reg = 0; reg < 16; ++reg) { const int jloc = 32 * jb + (reg & 3) + 8 * (reg >> 2) + 4 * hh, dl = iloc - jloc;
            const float w0 = __builtin_amdgcn_exp2f((float)dl * (dl > 0 ? lgf2 : -lgb2));
            X[reg] *= (dl == 0) ? 2.0f : w0; }
        u32x4 pw[2];
        pw[0] = (u32x4){pk2(X[0], X[1]), pk2(X[2], X[3]), pk2(X[4], X[5]), pk2(X[6], X[7])};
        pw[1] = (u32x4){pk2(X[8], X[9]), pk2(X[10], X[11]), pk2(X[12], X[13]), pk2(X[14], X[15])};
#pragma unroll
        for (int s = 0; s < 2; ++s) { const int j0 = 32 * jb + 16 * s + 4 * hh + q;
#pragma unroll
            for (int eb = 0; eb < 2; ++eb) { const int ec = 32 * (2 * eh + eb) + c16;
                const s16x4 lo = trd(vimg + (j0 * RSV + ec) * 2), hi = trd(vimg + ((j0 + 8) * RSV + ec) * 2);
                O[eb] = __builtin_amdgcn_mfma_f32_32x32x16_bf16(__builtin_bit_cast(bf16x8, pw[s]), RET_FRAG(lo, hi), O[eb], 0, 0, 0); } }
    }
#pragma unroll
    for (int dir = 0; dir < 2; ++dir) {
        const float fac = dir == 0 ? __builtin_amdgcn_exp2f((float)(iloc + 1) * lgf2) : __builtin_amdgcn_exp2f((float)(128 - iloc) * lgb2);
        const LAS char* himg = dir ? himg1 : himg0;
#pragma unroll
        for (int d0 = 0; d0 < 4; ++d0) {
            f32x4 a, bq; pg8::unpack8(__builtin_bit_cast(u32x4, qr[d0]), a, bq);
            const u32x4 qs = (u32x4){pk2(a[0] * fac, a[1] * fac), pk2(a[2] * fac, a[3] * fac), pk2(bq[0] * fac, bq[1] * fac), pk2(bq[2] * fac, bq[3] * fac)};
            const int dd0 = 16 * d0 + 8 * hh + q;
#pragma unroll
            for (int eb = 0; eb < 2; ++eb) { const int ec = 32 * (2 * eh + eb) + c16;
                const s16x4 lo = trd(himg + (dd0 * RSV + ec) * 2), hi = trd(himg + ((dd0 + 4) * RSV + ec) * 2);
                O[eb] = __builtin_amdgcn_mfma_f32_32x32x16_bf16(__builtin_bit_cast(bf16x8, qs), RET_FRAG(lo, hi), O[eb], 0, 0, 0); } }
    }
    u32x4 sgv[4]; f32x4 gn0[4], gn1[4];
#pragma unroll
    for (int i = 0; i < 4; ++i) { const int c = tid + 512 * i, row = c >> 4, ch = c & 15;
        sgv[i] = *(const u32x4*)(P + (size_t)(row0 + row) * PC + 1792 + 128 * hd + 8 * ch);
        gn0[i] = *(const f32x4*)(gainl + 128 * hd + 8 * ch); gn1[i] = *(const f32x4*)(gainl + 128 * hd + 8 * ch + 4); }
    float mean[16], rstd[16];
#pragma unroll
    for (int reg = 0; reg < 16; ++reg) mean[reg] = half_sum(O[0][reg] + O[1][reg]);
    if (r == 0) {
#pragma unroll
        for (int reg = 0; reg < 16; ++reg) part1[eh * 128 + 32 * ib + (reg & 3) + 8 * (reg >> 2) + 4 * hh] = mean[reg]; }
    LDS_WAIT(); __syncthreads();
#pragma unroll
    for (int reg = 0; reg < 16; ++reg) { const int i = 32 * ib + (reg & 3) + 8 * (reg >> 2) + 4 * hh; mean[reg] = (part1[i] + part1[128 + i]) * (1.0f / 128.0f); }
#pragma unroll
    for (int reg = 0; reg < 16; ++reg) { const float d0 = O[0][reg] - mean[reg], d1 = O[1][reg] - mean[reg]; rstd[reg] = half_sum(d0 * d0 + d1 * d1); }
    if (r == 0) {
#pragma unroll
        for (int reg = 0; reg < 16; ++reg) part2[eh * 128 + 32 * ib + (reg & 3) + 8 * (reg >> 2) + 4 * hh] = rstd[reg]; }
    LDS_WAIT(); __syncthreads();
#pragma unroll
    for (int reg = 0; reg < 16; ++reg) { const int i = 32 * ib + (reg & 3) + 8 * (reg >> 2) + 4 * hh; rstd[reg] = rsqrtf((part2[i] + part2[128 + i]) * (1.0f / 128.0f) + EPS); }
    LAS bf16_t* yimg = (LAS bf16_t*)vimg;
#pragma unroll
    for (int eb = 0; eb < 2; ++eb) { const int e = 32 * (2 * eh + eb) + r;
#pragma unroll
        for (int reg = 0; reg < 16; ++reg) { const int i = 32 * ib + (reg & 3) + 8 * (reg >> 2) + 4 * hh; yimg[i * RSV + e] = (bf16_t)f2bf((O[eb][reg] - mean[reg]) * rstd[reg]); } }
    LDS_WAIT(); __syncthreads();
#pragma unroll
    for (int i = 0; i < 4; ++i) { const int c = tid + 512 * i, row = c >> 4, ch = c & 15;
        const u32x4 yv = *(const LAS u32x4*)(vimg + (row * RSV + 8 * ch) * 2);
        f32x4 ya, yb, sa, sb; pg8::unpack8(yv, ya, yb); pg8::unpack8(sgv[i], sa, sb);
        *(u32x4*)(Y3 + (size_t)(row0 + row) * 1536 + 512 + 128 * hd + 8 * ch) = pg8::pack8(ya * gn0[i] * sa, yb * gn1[i] * sb); }
    LDS_WAIT(); __syncthreads();
    if (vn >= nV) break;
    vi = vn; u = un;
    }
#undef RET_UNIT_OF
}
}
struct MatD { const float* src; bf16_t* dst; int K, N, mode, nitems, ldd; float q8; };
__device__ __forceinline__ MatD mat_desc(int id, unsigned char* ws) {
    MatD m;
    if (id < 4) { m.src = KIN(I_w_in) + (size_t)id * D * INC; m.K = D; m.N = INC; m.dst = WSP(bf16_t, WS_WIN) + (size_t)id * INC * D; m.mode = 1; }
    else if (id < 16) { const int q = id - 4, l = q / 3, br = q - 3 * l; m.src = KIN(I_w_br_a + br) + (size_t)l * 512 * D; m.K = 512; m.N = D; m.dst = WSP(bf16_t, WS_WBR) + (size_t)l * D * 1536 + br * 512; m.mode = 0; }
    else if (id < 20) { const int l = id - 16; m.src = KIN(I_w_out) + (size_t)l * D * D; m.K = D; m.N = D; m.dst = WSP(bf16_t, WS_WOUT) + (size_t)l * D * D; m.mode = 0; }
    else if (id < 24) { const int q = id - 20, j = q >> 1, wh = q & 1; m.src = KIN(wh ? I_ffn_w3 : I_ffn_w1) + (size_t)j * D * DFF; m.K = D; m.N = DFF; m.dst = WSP(bf16_t, WS_W13) + (size_t)j * 2 * DFF * D; m.mode = 2 + wh; }
    else if (id < 26) { const int j = id - 24; m.src = KIN(I_ffn_w2) + (size_t)j * DFF * D; m.K = DFF; m.N = D; m.dst = WSP(bf16_t, WS_W2) + (size_t)j * D * DFF; m.mode = 0; }
    else if (id < 58) { const int q = id - 26, je = q >> 1, wh = q & 1; m.src = KIN(wh ? I_exp_w3 : I_exp_w1) + (size_t)je * D * DFE; m.K = D; m.N = DFE; m.dst = (bf16_t*)(ws + WS_E13 + (size_t)je * 2 * DFE * D); m.mode = 2 + wh; }
    else { const int je = id - 58; m.src = KIN(I_exp_w2) + (size_t)je * DFE * D; m.K = DFE; m.N = D; m.dst = (bf16_t*)(ws + WS_E2 + (size_t)je * D * DFE); m.mode = 0; }
    m.nitems = (m.K / 64) * (m.N / 32); m.ldd = (id >= 4 && id < 16) ? 1536 : m.K; m.q8 = id >= 58 ? FP8_SC_W2 : (id >= 26 ? FP8_SC_W13 : 0.f);
    return m;
}
struct ItemRef { const float* src; bf16_t* dst; int K, N, ldd; float q8; };
struct ItemIt { int id, id_end, base, g, W; };
__device__ __forceinline__ bool item_next(ItemIt& it, unsigned char* ws, ItemRef& r) {
    while (it.id < it.id_end) { const MatD m = mat_desc(it.id, ws);
        if (it.g < it.base + m.nitems) { const int item = it.g - it.base; it.g += it.W;
            const int nblk = m.N / 32, kb = item / nblk, nb = item - kb * nblk, k0 = 64 * kb, n0 = 32 * nb;
            int drow0 = n0;
            if (m.mode == 1) { const int T = n0 >> 8, cl = n0 & 255; const bool head = (T <= 4) || (T >= 9 && T <= 11); if (head) drow0 = 256 * T + 128 * ((cl >> 5) & 1) + 32 * (cl >> 6); }
            else if (m.mode >= 2) { drow0 = 256 * (n0 >> 7) + 128 * (m.mode - 2) + (n0 & 127); }
            r.src = m.src + (size_t)k0 * m.N + n0; r.q8 = m.q8; r.dst = m.q8 > 0.f ? (bf16_t*)((unsigned char*)m.dst + (size_t)drow0 * m.ldd + k0) : m.dst + (size_t)drow0 * m.ldd + k0; r.K = m.K; r.N = m.N; r.ldd = m.ldd;
            if (m.mode == 1 && ((g1_mask(it.id) >> (n0 >> 8)) & 1u)) { r.q8 = FP8_SC_WG; r.dst = (bf16_t*)((unsigned char*)m.dst + WG8_OFF + (size_t)drow0 * D + k0); }
            return true; }
        it.base += m.nitems; ++it.id; }
    return false;
}
__device__ __forceinline__ void tr_load(const ItemRef& r, float (&v)[32], int lane) {
    const float* p = r.src + (size_t)(lane >> 5) * r.N + (lane & 31);
#pragma unroll
    for (int i = 0; i < 32; ++i) v[i] = __builtin_nontemporal_load(p + (size_t)(2 * i) * r.N);
}
__device__ __forceinline__ void tr_store(const ItemRef& r, const float (&v)[32], LAS float* scr, int lane) {
#pragma unroll
    for (int i = 0; i < 32; ++i) { const int kk = 2 * i + (lane >> 5); scr[kk * 33 + (lane & 31)] = v[i]; }
    LDS_WAIT(); asm volatile("" ::: "memory");
    if (r.q8 > 0.f) {
#pragma unroll
        for (int jj = 0; jj < 2; ++jj) { const int ch = lane + 64 * jj, n = ch >> 2, c4 = ch & 3; const LAS float* s = scr + (16 * c4) * 33 + n; float e[16];
#pragma unroll
            for (int x = 0; x < 16; ++x) e[x] = s[x * 33] * r.q8;
            u32x4 o; o.x = pk4_fp8(e[0], e[1], e[2], e[3]); o.y = pk4_fp8(e[4], e[5], e[6], e[7]); o.z = pk4_fp8(e[8], e[9], e[10], e[11]); o.w = pk4_fp8(e[12], e[13], e[14], e[15]);
            *(u32x4*)((unsigned char*)r.dst + (size_t)n * r.ldd + 16 * c4) = o; }
        LDS_WAIT(); asm volatile("" ::: "memory");
        return;
    }
    const int c = lane & 7;
#pragma unroll
    for (int j = 0; j < 4; ++j) { const int n = (lane >> 3) + 8 * j; const LAS float* s = scr + (8 * c) * 33 + n;
        u32x4 o; o.x = pg8::cvt_pk_bf16(s[0 * 33], s[1 * 33]); o.y = pg8::cvt_pk_bf16(s[2 * 33], s[3 * 33]); o.z = pg8::cvt_pk_bf16(s[4 * 33], s[5 * 33]); o.w = pg8::cvt_pk_bf16(s[6 * 33], s[7 * 33]);
        *(u32x4*)(r.dst + (size_t)n * r.ldd + 8 * c) = o; }
    LDS_WAIT(); asm volatile("" ::: "memory");
}
__device__ __forceinline__ void convert_mats(unsigned char* ws, LAS unsigned char* lds, int rank, int nrank, int wave, int lane, int id0, int id1) {
    LAS float* scr = (LAS float*)(lds + wave * 8704);
    ItemIt it{id0, id1, 0, rank * NWAVES + wave, nrank * NWAVES};
    ItemRef ra, rb; float va[32], vb[32];
    bool ha = item_next(it, ws, ra);
    if (ha) tr_load(ra, va, lane);
#pragma unroll 1
    while (ha) {
        const bool hb = item_next(it, ws, rb);
        if (hb) tr_load(rb, vb, lane);
        tr_store(ra, va, scr, lane);
        if (!hb) break;
        ha = item_next(it, ws, ra);
        if (ha) tr_load(ra, va, lane);
        tr_store(rb, vb, scr, lane);
    }
}

struct Ptrs {
    const float *x, *c, *ctx, *c_ctx, *w_ada, *b_ada, *norm1_g, *norm2_g, *final_g, *w_in, *b_gate, *qn_a, *kn_a, *ret_a, *ret_g, *sink_c,
                *w_br_a, *w_br_b, *w_br_c, *w_out, *ffn_w1, *ffn_w3, *ffn_w2, *router_w, *router_b, *exp_w1, *exp_w3, *exp_w2;
};

__device__ __forceinline__ void prologue_phase(const Ptrs& I, unsigned char* ws, LAS unsigned char* lds, int tid, int lane, int wave, int G) {
    LAS float* sv = (LAS float*)(lds + 69632);
    LAS float* part = (LAS float*)(lds + 69632 + 20480);
    for (int i = tid; i < 5 * 1024; i += NTHR) { const int who = i >> 10, k = i & 1023; const float cv = who < 4 ? I.c[who * 1024 + k] : I.c_ctx[k]; sv[i] = siluf_(cv); }
    LDS_WAIT(); __syncthreads();
    float* MODS = (float*)(ws + WS_MODS);
#ifdef DUP_MODS
    for (int rep = 0; rep < 2; ++rep)
#endif
    for (int it = blockIdx.x; it < DEPTH * 48; it += G) {
        const int l = it / 48, cg = it % 48, col = cg * 128 + 2 * lane;
        const float* wp = I.w_ada + ((size_t)l * 1024 + wave * 128) * INC + col;
        f32x2 a0 = {0.f, 0.f}, a1 = a0, a2 = a0, a3 = a0, a4 = a0;
#pragma unroll 16
        for (int k = 0; k < 128; ++k) { const f32x2 w = *(const f32x2*)(wp + (size_t)k * INC); const int kk = wave * 128 + k;
            a0 += sv[kk] * w; a1 += sv[1024 + kk] * w; a2 += sv[2048 + kk] * w; a3 += sv[3072 + kk] * w; a4 += sv[4096 + kk] * w; }
        *(LAS f32x2*)(part + (wave * 5 + 0) * 128 + 2 * lane) = a0; *(LAS f32x2*)(part + (wave * 5 + 1) * 128 + 2 * lane) = a1; *(LAS f32x2*)(part + (wave * 5 + 2) * 128 + 2 * lane) = a2;
        *(LAS f32x2*)(part + (wave * 5 + 3) * 128 + 2 * lane) = a3; *(LAS f32x2*)(part + (wave * 5 + 4) * 128 + 2 * lane) = a4;
        LDS_WAIT(); __syncthreads();
        for (int o = tid; o < 640; o += NTHR) { const int who = o >> 7, ln = o & 127; float s = I.b_ada[(size_t)l * INC + cg * 128 + ln];
#pragma unroll
            for (int w = 0; w < 8; ++w) s += part[(w * 5 + who) * 128 + ln];
            MODS[((size_t)l * 5 + who) * INC + cg * 128 + ln] = s; }
        __syncthreads();
    }
    if (blockIdx.x == G - 1) { float* R = (float*)(ws + WS_ROPE);
        for (int i = tid; i < 1024; i += NTHR) { const int pos = i >> 4, f = i & 15; const float inv = powf(10000.0f, -(float)f / 16.0f); const float ang = (float)pos * inv; R[2 * i] = cosf(ang); R[2 * i + 1] = sinf(ang); } }
    if (blockIdx.x == (G > 1 ? G - 2 : 0) && tid < DEPTH * 8) { float* RC = (float*)(ws + WS_RETC); const float a = I.ret_a[tid]; const float lg = -log1pf(expf(-a)); RC[2 * tid] = lg * LOG2E; RC[2 * tid + 1] = expf(128.0f * lg); }
    convert_mats(ws, lds, blockIdx.x, G, wave, lane, 0, 74);
}

struct NormArgs {
    const float* g; const float* shift; const float* scale;
    const float* gate2p; const bf16_t* Y; const int* DST;
    const LAS float* rw; const float* rb; LAS int* route; int* PE; float* PW;
    unsigned char* hn8;
};
struct RowJob { const float* src; const bf16_t* srcb; bf16_t* xs_out; bf16_t* hn; int row; NormArgs A; };
struct RowData { u32x4 x[4]; u32x2 y0[4], y1[4]; };
struct NormStat { f32x4 am[4], sh[4], gt[4]; const float* key; };
template <bool COMB> __device__ __forceinline__ void norm_idx(const RowJob& J, int (&d)[2]) { if constexpr (COMB) { d[0] = J.A.DST[2 * J.row]; d[1] = J.A.DST[2 * J.row + 1]; } }
template <bool SRC32, bool COMB> __device__ __forceinline__ void norm_load(const RowJob& J, const int (&d)[2], RowData& R, int lane) {
#pragma unroll
    for (int j = 0; j < 4; ++j) { const int c = 4 * lane + 256 * j;
        if constexpr (SRC32) R.x[j] = *(const u32x4*)(J.src + c); else { const u32x2 t = *(const u32x2*)(J.srcb + c); R.x[j].x = t.x; R.x[j].y = t.y; } }
    if constexpr (COMB) {
#pragma unroll
        for (int j = 0; j < 4; ++j) { const int c = 4 * lane + 256 * j; R.y0[j] = *(const u32x2*)(J.A.Y + (size_t)d[0] * D + c); R.y1[j] = *(const u32x2*)(J.A.Y + (size_t)d[1] * D + c); } }
}
template <bool COMB> __device__ __forceinline__ void norm_stat_build(const RowJob& J, const f32x4 (&gq)[4], NormStat& S, int lane) {
#pragma unroll
    for (int j = 0; j < 4; ++j) { const int c = 4 * lane + 256 * j; const f32x4 sc = *(const f32x4*)(J.A.scale + c); S.sh[j] = *(const f32x4*)(J.A.shift + c); S.am[j] = gq[j] * (sc + 1.0f);
        if constexpr (COMB) S.gt[j] = *(const f32x4*)(J.A.gate2p + c); }
    S.key = J.A.shift;
}
template <bool SRC32, bool COMB> __device__ __forceinline__ void norm_finish(const RowJob& J, const RowData& R, const NormStat& S, int lane) {
    const NormArgs& A = J.A; const int row = J.row; bf16_t* xs_out = J.xs_out; bf16_t* hn = J.hn;
    f32x4 v[4]; float ss = 0.f;
#pragma unroll
    for (int j = 0; j < 4; ++j) { if constexpr (SRC32) v[j] = __builtin_bit_cast(f32x4, R.x[j]); else v[j] = (f32x4){bflo(R.x[j].x), bfhi(R.x[j].x), bflo(R.x[j].y), bfhi(R.x[j].y)}; }
    if constexpr (COMB) {
#pragma unroll
        for (int j = 0; j < 4; ++j) { const u32x2 y0 = R.y0[j], y1 = R.y1[j]; const f32x4 gt = S.gt[j];
            v[j][0] += gt[0] * (bflo(y0.x) + bflo(y1.x)); v[j][1] += gt[1] * (bfhi(y0.x) + bfhi(y1.x)); v[j][2] += gt[2] * (bflo(y0.y) + bflo(y1.y)); v[j][3] += gt[3] * (bfhi(y0.y) + bfhi(y1.y)); } }
    if (xs_out) {
#pragma unroll
        for (int j = 0; j < 4; ++j) { u32x2 w; w.x = pk2(v[j][0], v[j][1]); w.y = pk2(v[j][2], v[j][3]); *(u32x2*)(xs_out + 4 * lane + 256 * j) = w; } }
#pragma unroll
    for (int j = 0; j < 4; ++j) ss += (v[j][0] * v[j][0] + v[j][1] * v[j][1]) + (v[j][2] * v[j][2] + v[j][3] * v[j][3]);
    const float rs = rsqrtf(wave_sum(ss) * (1.0f / D) + EPS);
    float lg[8];
#pragma unroll
    for (int e = 0; e < 8; ++e) lg[e] = 0.f;
#pragma unroll
    for (int j = 0; j < 4; ++j) { const int c = 4 * lane + 256 * j;
        f32x4 h = v[j] * rs * S.am[j] + S.sh[j];
        if (hn) { u32x2 w; w.x = pk2(h[0], h[1]); w.y = pk2(h[2], h[3]); *(u32x2*)(hn + c) = w; }
        if (A.hn8) { const f32x4 q = h * FP8_SC_X; *(unsigned*)(A.hn8 + c) = pk4_fp8(q[0], q[1], q[2], q[3]); }
        if (A.rw) {
#pragma unroll
            for (int e = 0; e < 8; ++e) { const f32x4 r = *(const LAS f32x4*)(A.rw + e * 1024 + c); lg[e] += (h[0] * r[0] + h[1] * r[1]) + (h[2] * r[2] + h[3] * r[3]); } } }
    if (A.rw) {
#pragma unroll
        for (int e = 0; e < 8; ++e) lg[e] = wave_sum(lg[e]) + A.rb[e];
        int i1 = 0; float v1 = lg[0];
#pragma unroll
        for (int e = 1; e < 8; ++e) if (lg[e] > v1) { v1 = lg[e]; i1 = e; }
        int i2 = -1; float v2 = -INFINITY;
#pragma unroll
        for (int e = 0; e < 8; ++e) if (e != i1 && lg[e] > v2) { v2 = lg[e]; i2 = e; }
        if (i2 < 0) i2 = (i1 + 1) & 7;
        if (lane == 0) { const float w1 = 1.0f / (1.0f + __expf(v2 - v1));
            A.route[0] = i1; A.route[1] = i2;
            A.PE[2 * row] = i1; A.PE[2 * row + 1] = i2; A.PW[2 * row] = w1; A.PW[2 * row + 1] = 1.0f - w1; }
    }
}
template <bool SRC32, bool COMB, class F> __device__ __forceinline__ void norm_rows(int first, int stride, int end, const F& f, int lane) {
    if (first >= end) return;
    RowJob J, Jt; RowData A, B, C; NormStat S; int dn[2] = {0, 0};
    f(first, J);
    f32x4 gq[4];
#pragma unroll
    for (int j = 0; j < 4; ++j) gq[j] = *(const f32x4*)(J.A.g + 4 * lane + 256 * j);
    norm_stat_build<COMB>(J, gq, S, lane);
    norm_idx<COMB>(J, dn); norm_load<SRC32, COMB>(J, dn, A, lane);
    if (first + stride < end) { f(first + stride, Jt); norm_idx<COMB>(Jt, dn); norm_load<SRC32, COMB>(Jt, dn, B, lane); }
    { const int ri = first + 2 * stride < end ? first + 2 * stride : end - 1; f(ri, Jt); norm_idx<COMB>(Jt, dn); }
    int r = first;
#define NR_STEP(LD, FIN, k) { const int rl = r + ((k) + 2) * stride, rf = r + (k) * stride; \
        if (rl < end) { f(rl, Jt); norm_load<SRC32, COMB>(Jt, dn, LD, lane); } \
        if constexpr (COMB) { const int ri = rl + stride < end ? rl + stride : end - 1; f(ri, Jt); norm_idx<COMB>(Jt, dn); }     \
        f(rf, J); if (J.A.shift != S.key) norm_stat_build<COMB>(J, gq, S, lane); norm_finish<SRC32, COMB>(J, FIN, S, lane); \
        if (rf + stride >= end) break; }
#pragma unroll 1
    for (;;) {
        NR_STEP(C, A, 0)
        NR_STEP(A, B, 1)
        NR_STEP(B, C, 2)
        r += 3 * stride;
    }
#undef NR_STEP
}
struct SchedPlain {
    const char* A; const char* B; size_t aTile, bTile; int nM, nN, G, c; bool latOnly; int ntk, lda, ldb;
    __device__ __forceinline__ void a_ready(const pg8::Unit&) const {}
    __device__ __forceinline__ void done(const pg8::Unit&, int) const {}
    __device__ __forceinline__ bool next(int i, pg8::Unit& u) const {
        int pm, pn; if (!pg8::tile_of((long)i * G + c, nM, nN, pm, pn)) return false;
        if (latOnly) pm = pm + pm / 16 + 1;
        u.pm = pm; u.pn = pn; u.aux = 0; u.ntk = ntk; u.mode = 0; u.peer = 0; u.kt0 = 0; u.kind = 0; u.lda = lda; u.ldb = ldb; u.A = A + (size_t)pm * aTile; u.B = B + (size_t)pn * bTile; return true; }
};
template <int KIND> struct SchedG1 {
    const char* A; const char* B; int nM, G, c; unsigned mask; unsigned* cnt;
    __device__ __forceinline__ bool next(int i, pg8::Unit& u) const {
        const unsigned mk = KIND ? mask : (~mask & 0xFFFFFFu), mkA = mk & 0x70u, mkB = mk & ~0x70u;
        const int nA = __builtin_popcount(mkA), nB = __builtin_popcount(mkB); const long L = (long)i * G + (KIND ? G - 1 - c : c), LA = (long)nM * nA;
        int pm, j, pn;
        if (L < LA) { pg8::tile_of(L, nM, nA, pm, j); pn = nth_bit(mkA, j); }
        else { if (nB == 0 || !pg8::tile_of(L - LA, nM, nB, pm, j)) return false; pn = nth_bit(mkB, j); }
        u.pm = pm; u.pn = pn; u.aux = 0; u.mode = 0; u.peer = 0; u.kt0 = 0; u.kind = 0;
        if (KIND) { u.ntk = D / 128; u.lda = D / 2; u.ldb = D / 2; u.A = A + (size_t)pm * (256 * D); u.B = B + (size_t)pn * (256 * D); }
        else { u.ntk = D / 64; u.lda = D; u.ldb = D; u.A = A + (size_t)pm * (256 * D * 2); u.B = B + (size_t)pn * (256 * D * 2); }
        return true; }
    __device__ __forceinline__ void a_ready(const pg8::Unit&) const {}
    __device__ __forceinline__ void done(const pg8::Unit& u, int lane) const {
        if (u.pn >= 4 && u.pn <= 6) { asm volatile("s_waitcnt vmcnt(0)" ::: "memory"); if (lane == 0) __hip_atomic_fetch_add(cnt + 32 * u.pm, 1u, __ATOMIC_RELAXED, __HIP_MEMORY_SCOPE_AGENT); } }
};
struct SchedMoE {
    const char* A; const char* B; size_t aTile, bTile, eStride; int nM, nN, G, c; int ts1, ts2, ts3, ts4, ts5, ts6, ts7; int ntk, lda, ldb;
    __device__ __forceinline__ void a_ready(const pg8::Unit&) const {}
    __device__ __forceinline__ void done(const pg8::Unit&, int) const {}
    __device__ __forceinline__ bool next(int i, pg8::Unit& u) const {
        int pm, pn; if (!pg8::tile_of((long)i * G + c, nM, nN, pm, pn)) return false;
        const int e = (pm >= ts1) + (pm >= ts2) + (pm >= ts3) + (pm >= ts4) + (pm >= ts5) + (pm >= ts6) + (pm >= ts7);
        u.pm = pm; u.pn = pn; u.aux = e; u.ntk = ntk; u.mode = 0; u.peer = 0; u.kt0 = 0; u.kind = 0; u.lda = lda; u.ldb = ldb; u.A = A + (size_t)pm * aTile; u.B = B + (size_t)e * eStride + (size_t)pn * bTile; return true; }
};
template <int P> struct SchedSK {
    const char* A; const char* B; size_t aTile, bTile, eStride; int U, G, vc; bool latOnly; int ts1, ts2, ts3, ts4, ts5, ts6, ts7; int s, e; int lda, ldb;
    __device__ __forceinline__ void a_ready(const pg8::Unit&) const {}
    __device__ __forceinline__ void done(const pg8::Unit&, int) const {}
    __device__ __forceinline__ int bound(int c) const { const unsigned b = (unsigned)c * (unsigned)(U * P) / (unsigned)G; int u = (int)(b / (unsigned)P), o = (int)b - u * P; if (o < 2) o = 0; else if (o > P - 2) { o = 0; ++u; } return u * P + o; }
    __device__ __forceinline__ void init() { s = bound(vc); e = bound(vc + 1); }
    __device__ __forceinline__ bool next(int i, pg8::Unit& u) const {
        const int u0 = s / P, un = u0 + i, st = (i == 0) ? s : un * P; if (st >= e) return false;
        const int uend = (un + 1) * P, en = e < uend ? e : uend, o = st - un * P, oe = en - un * P;
        u.mode = (o > 0) ? 2 : (oe < P ? 1 : 0); u.peer = vc + 1; u.ntk = 2 * (oe - o); u.kt0 = 2 * o; u.kind = 0; u.lda = lda; u.ldb = ldb;
        const int nP = U >> 2; const int pn = un / nP; int pm = un - pn * nP;
        const int ex = (pm >= ts1) + (pm >= ts2) + (pm >= ts3) + (pm >= ts4) + (pm >= ts5) + (pm >= ts6) + (pm >= ts7);
        if (latOnly) pm = pm + pm / 16 + 1;
        u.pm = pm; u.pn = pn; u.aux = ex; u.A = A + (size_t)pm * aTile + (size_t)o * 256; u.B = B + (size_t)ex * eStride + (size_t)pn * bTile + (size_t)o * 256; return true; }
};

template <int P> struct SchedWR {
    const char* A; const char* B; size_t aTile, bTile, eStride; int nP  , G, c; bool latOnly; int ts1, ts2, ts3, ts4, ts5, ts6, ts7; int lda, ldb;
    __device__ __forceinline__ void a_ready(const pg8::Unit&) const {}
    __device__ __forceinline__ void done(const pg8::Unit&, int) const {}
    __device__ __forceinline__ bool next(int i, pg8::Unit& u) const {
        const int U = nP * 4, R = U / G, rem = U - R * G; int p, q = -1;
        const int S = (P >= 16 && 4 * rem <= G) ? 4 : 2;
        if (i < R) p = i * G + c;
        else if (i == R && 2 * rem <= G) { if (c >= S * rem) return false; p = R * G + c / S; q = c % S; }
        else if (i == R) { p = R * G + c; if (p >= U) return false; }
        else return false;
        int pm, pn; pg8::tile_of((long)p, nP, 4, pm, pn);
        const int ex = (pm >= ts1) + (pm >= ts2) + (pm >= ts3) + (pm >= ts4) + (pm >= ts5) + (pm >= ts6) + (pm >= ts7);
        if (latOnly) pm = pm + pm / 16 + 1;
        const int base = P / S, extra = P % S;
        const int o = q < 0 ? 0 : q * base + (q < extra ? q : extra), np = q < 0 ? P : base + (q < extra ? 1 : 0);
        u.pm = pm; u.pn = pn; u.aux = ex; u.kind = 0; u.lda = lda; u.ldb = ldb; u.peer = c + 1; u.mode = q < 0 ? 0 : (q == 0 ? (S == 2 ? 1 : S) : 2); u.kt0 = 2 * o; u.ntk = 2 * np;
        u.A = A + (size_t)pm * aTile + (size_t)o * 256; u.B = B + (size_t)ex * eStride + (size_t)pn * bTile + (size_t)o * 256; return true; }
};
struct SchedM1 {
    const char* Y3; const char* WBR; unsigned* cnt; int c; bool ctx;
    __device__ __forceinline__ bool next(int i, pg8::Unit& u) const {
        int pm, pn;
        if (i == 0) { if (!pg8::tile_of((long)c, 64, 4, pm, pn)) return false; pm = pm + pm / 16 + 1; u.mode = 0; u.kt0 = 0; u.ntk = 24; }
        else if (i == 1 && ctx && c < 48) { const int e = c / 3, br = c - 3 * e; pm = 17 * (e >> 2); pn = e & 3; u.mode = br == 0 ? 3 : 2; u.kt0 = 8 * br; u.ntk = 8; }
        else return false;
        u.pm = pm; u.pn = pn; u.aux = 0; u.kind = 0; u.lda = 1536; u.ldb = 1536; u.peer = c + 1;
        u.A = Y3 + (size_t)pm * (256 * 1536 * 2) + (size_t)u.kt0 * 128; u.B = WBR + (size_t)pn * (256 * 1536 * 2) + (size_t)u.kt0 * 128; return true; }
    __device__ __forceinline__ void a_ready(const pg8::Unit&) const {}
    __device__ __forceinline__ void done(const pg8::Unit& u, int lane) const {
        asm volatile("s_waitcnt vmcnt(0)" ::: "memory"); if (lane == 0) __hip_atomic_fetch_add(cnt + 32 * u.pm, 1u, __ATOMIC_RELAXED, __HIP_MEMORY_SCOPE_AGENT); }
};
struct SchedM2One {
    const char* MB; const char* WOUT; int c; bool ctx; int which;
    __device__ __forceinline__ bool unit(pg8::Unit& u) const {
        int pm, pn;
        if (which == 1) { if (!pg8::tile_of((long)((c + 32) & 255), 64, 4, pm, pn)) return false; pm = pm + pm / 16 + 1; u.mode = 0; u.kt0 = 0; u.ntk = 16; }
        else if (ctx && c >= 224 && c < 256) { const int q = c - 224, e = q >> 1, half = q & 1; pm = 17 * (e >> 2); pn = e & 3; u.mode = half == 0 ? 1 : 2; u.kt0 = 8 * half; u.ntk = 8; }
        else return false;
        u.pm = pm; u.pn = pn; u.aux = 0; u.peer = c + 1; u.kind = 0; u.lda = 1024; u.ldb = 1024;
        u.A = MB + (size_t)pm * (256 * 1024 * 2) + (size_t)u.kt0 * 128; u.B = WOUT + (size_t)pn * (256 * 1024 * 2) + (size_t)u.kt0 * 128; return true; }
    __device__ __forceinline__ bool next(int i, pg8::Unit& u) const { return i == 0 && unit(u); }
    __device__ __forceinline__ void a_ready(const pg8::Unit&) const {}
    __device__ __forceinline__ void done(const pg8::Unit&, int) const {}
};
__device__ __forceinline__ void wait_panel(unsigned* cnt, unsigned* tmo, int pm, int wave_s, unsigned need) {
    if (wave_s == 0) { unsigned spins = 0;
        while ((unsigned)__builtin_amdgcn_readfirstlane(__hip_atomic_load(cnt + 32 * pm, __ATOMIC_RELAXED, __HIP_MEMORY_SCOPE_AGENT)) < need) {
            __builtin_amdgcn_s_sleep(1);
            if (++spins > (1u << 18)) { __hip_atomic_store(tmo, 1u, __ATOMIC_RELAXED, __HIP_MEMORY_SCOPE_AGENT); break; } }
        __builtin_amdgcn_fence(__ATOMIC_ACQUIRE, "agent");
        asm volatile("s_waitcnt vmcnt(0)" ::: "memory"); }
    __syncthreads();
}

struct Args { Ptrs in; float* out; unsigned char* ws; };
static_assert(sizeof(Args) == 30 * 8, "Args layout");
__global__ void __launch_bounds__(NTHR, 2) fwd_kernel(Args) {
    extern __shared__ __attribute__((aligned(16))) unsigned char lds_raw[];
    LAS unsigned char* lds = (LAS unsigned char*)lds_raw;
    volatile LAS unsigned* MISC = (volatile LAS unsigned*)(lds + MISC_OFF);
    const int G = gridDim.x, bx = blockIdx.x, wave_s = __builtin_amdgcn_readfirstlane((int)threadIdx.x >> 6);
#define PHASE_IDS() const int tid = fresh_tid(wave_s), lane = tid & 63, wave = __builtin_amdgcn_readfirstlane(tid >> 6), gw = bx * NWAVES + wave, NGW = G * NWAVES; (void)lane; (void)gw; (void)NGW
    const int vcu = (G % 8 == 0) ? (bx % 8) * (G / 8) + bx / 8 : bx;
    for (int u = threadIdx.x; u < (LDS_BYTES - LDSCTL_OFF) / 4; u += NTHR) ((LAS unsigned*)(lds + LDSCTL_OFF))[u] = 0u;
    __syncthreads();
    (void)xcd_barrier_post((unsigned*)(KWS() + WS_CTL) + CW_BAR, MISC + 8);
#ifdef TPROBE
#ifndef TPROBE_L0
#define TPROBE_L0 -1
#define TPROBE_L1 99
#endif
    int tp_l = -1;
#define TP(type) do { if (bx == 0 && fresh_tid(wave_s) == 0) { const unsigned now_ = (unsigned)__builtin_amdgcn_s_memrealtime(); if (tp_l >= TPROBE_L0 && tp_l <= TPROBE_L1) MISC[16 + (type)] += now_ - MISC[15]; MISC[15] = now_; } } while (0)
#else
#define TP(type) do {} while (0)
#endif
#define GRID_BAR() do { XcdBarrier b_; b_.bar = (unsigned*)(KWS() + WS_CTL) + CW_BAR; b_.x = xb_xcc_id(); b_.st = MISC + 8; xcd_barrier(b_); } while (0)

#ifdef TPROBE
    if (bx == 0 && fresh_tid(wave_s) == 0) MISC[15] = (unsigned)__builtin_amdgcn_s_memrealtime();
#endif
#ifndef SKIP_P0
    {
        PHASE_IDS(); Ptrs I; { const float** pp = (const float**)&I; kargp_t kp = kfresh();
#pragma unroll
            for (int i = 0; i < 28; ++i) pp[i] = ((const float* const __attribute__((address_space(4)))*)kp)[i]; }
        prologue_phase(I, KWS(), lds, tid, lane, wave, G);
#ifdef DUP_P0
        __syncthreads(); prologue_phase(I, KWS(), lds, tid, lane, wave, G);
#endif
    }
#endif
    GRID_BAR(); TP(0);

#pragma unroll 1
    for (int l = 0; l < DEPTH; ++l) {
        const bool need_ctx = (l < DEPTH - 1), moe = (l & 1) != 0; const int jf = l >> 1;
#ifdef TPROBE
        tp_l = l;
#endif
#ifndef SKIP_N1
        {
            PHASE_IDS(); unsigned char* ws = KWS(); bf16_t* XS = WSP(bf16_t, WS_XS); bf16_t* HN = WSP(bf16_t, WS_HN); const float* MODS = WSP(float, WS_MODS);
            const float* modl = MODS + (size_t)l * 5 * INC;
            const bool comb = (l == 2);
            const float* xin = KIN(I_x); const float* cin = KIN(I_ctx); const float* g1 = KIN(I_norm1_g) + (size_t)l * D;
            const bf16_t* YYp = WSP(bf16_t, WS_R2); const int* DSTp = (const int*)(ws + WS_META + MT_DST);
            struct N1Job { int l; bool comb, hn16; bf16_t* XS; bf16_t* HN; unsigned char* HN8; const float* MODS; const float* modl; const float* xin; const float* cin; const float* g1; const bf16_t* Y; const int* DST;
                __device__ __forceinline__ void operator()(int row, RowJob& J) const {
                    const int b = row / TPB, tq = row - b * TPB, who = tq < CTXL ? 4 : b;
                    J.src = (l == 0) ? (tq < CTXL ? cin + ((size_t)b * CTXL + tq) * D : xin + ((size_t)b * SEQ + (tq - CTXL)) * D) : nullptr; J.srcb = XS + (size_t)row * D;
                    J.xs_out = (l == 0 || comb) ? XS + (size_t)row * D : nullptr; J.hn = hn16 ? HN + (size_t)row * D : nullptr; J.row = row;
                    J.A = NormArgs{}; J.A.g = g1; J.A.shift = modl + (size_t)who * INC; J.A.scale = modl + (size_t)who * INC + D; J.A.hn8 = HN8 + (size_t)row * D;
                    if (comb) { J.A.gate2p = MODS + ((size_t)(l - 1) * 5 + who) * INC + 5 * D; J.A.Y = Y; J.A.DST = DST; } } };
            const N1Job job{l, comb, (g1_mask(l) & 0xFFFFFFu) != 0xFFFFFFu  , XS, HN, ws + WS_HN8, MODS, modl, xin, cin, g1, YYp, DSTp};
            { const int RPB = (M + G - 1) / G, r0 = bx * RPB, r1 = (r0 + RPB < M) ? r0 + RPB : M; if (l == 0) norm_rows<true, false>(r0 + wave, NWAVES, r1, job, lane); else if (comb) norm_rows<false, true>(r0 + wave, NWAVES, r1, job, lane); else norm_rows<false, false>(r0 + wave, NWAVES, r1, job, lane); }
        }
#endif
        GRID_BAR(); TP(1);
#ifdef DUP_BAR
        for (int r_ = 0; r_ < 8; ++r_) GRID_BAR();
#endif
#ifndef SKIP_G1
        {
            unsigned char* ws = KWS();
            unsigned* cnt = WSP(unsigned, WS_CTL) + CW_PAN + (4 + l) * 68 * 32;
            {
                SchedG1<0> S{(const char*)WSP(bf16_t, WS_HN), (const char*)(WSP(bf16_t, WS_WIN) + (size_t)l * INC * D), NMT, G, bx, g1_mask(l), cnt};
                pg8::EpiInProj E{WSP(bf16_t, WS_P), WSP(bf16_t, WS_G), KIN(I_qn_a) + l * 64, KIN(I_kn_a) + l * 64, KIN(I_b_gate) + (size_t)l * 3 * D, WSP(float, WS_ROPE), 1.0f};
                pg8::gemm_phase<pg8::EpiInProj, SchedG1<0>, true>(lds, fresh_tid(wave_s), S, E);
            }
            {
                unsigned char* ws2 = KWS();
                SchedG1<1> S{(const char*)(ws2 + WS_HN8), (const char*)(ws2 + WS_WIN + (size_t)l * INC * D * 2 + WG8_OFF), NMT, G, bx, g1_mask(l), (unsigned*)(ws2 + WS_CTL) + CW_PAN + (4 + l) * 68 * 32};
                pg8::EpiInProj E{(bf16_t*)(ws2 + WS_P), (bf16_t*)(ws2 + WS_G), KIN(I_qn_a) + l * 64, KIN(I_kn_a) + l * 64, KIN(I_b_gate) + (size_t)l * 3 * D, (const float*)(ws2 + WS_ROPE), 1.0f / (FP8_SC_X * FP8_SC_WG)};
                pg8::gemm_phase<pg8::EpiInProj, SchedG1<1>, true, true>(lds, fresh_tid(wave_s), S, E);
            }
            TP(3);
            {
                const int nf = __builtin_popcount(g1_mask(l)), remb = (NMT * (24 - nf)) % G, remf = (NMT * nf) % G; const bool mid = remb + remf < G; const int nidle = mid ? G - remb - remf : G, rank = mid ? bx - remb : bx;
                if (rank >= 0 && rank < nidle)
                    ret::kvinc_units(WSP(bf16_t, WS_P), WSP(float, WS_KVS), WSP(float, WS_RETC) + l * 16, rank, nidle, NB * 4 * ret::NCH, cnt, WSP(unsigned, WS_CTL) + CW_TMO, wave_s, (LAS char*)lds, fresh_tid(wave_s));
            }
        }
#endif
        GRID_BAR(); TP(2);
#ifndef SKIP_A2
        { PHASE_IDS(); unsigned char* ws = KWS(); ret::scan_phase(WSP(float, WS_KVS), WSP(bf16_t, WS_KVB), WSP(float, WS_RETC) + l * 16, bx * NTHR + tid, G * NTHR); }
#endif
        GRID_BAR(); TP(4);
#ifndef SKIP_RO
        {
            unsigned char* ws = KWS(); const float* rc = WSP(float, WS_RETC) + l * 16; const float* rg = KIN(I_ret_g) + (size_t)l * 512;
            ret::retout_units(WSP(bf16_t, WS_P), WSP(bf16_t, WS_KVB), WSP(bf16_t, WS_Y3), rg, rc, bx, G, NB * 4 * ret::NCH, !need_ctx, (LAS char*)lds, fresh_tid(wave_s));
        }
#endif
        TP(7);
#ifndef SKIP_AT0
        {
            unsigned char* ws = KWS(); const bf16_t* P = WSP(bf16_t, WS_P); bf16_t* Y3 = WSP(bf16_t, WS_Y3); const float* snk = KIN(I_sink_c) + l * 8;
            const int nU0 = 512 + (need_ctx ? 64 : 0);
#pragma unroll 1
            for (int k = 0;; ++k) {
                int uu;
                if (G == 256) { if (k < 2) uu = (vcu >> 5) * 64 + (vcu & 31) * 2 + k; else if (k == 2 && bx >= 32 && bx < 96 && need_ctx) uu = 512 + (bx - 32); else break; }
                else { uu = bx + k * G; if (uu >= nU0) break; }
                const bf16_t *Qu, *Kh, *Vh; bf16_t* Ou; int NT; float sk = -INFINITY;
                if (uu < 512) {
                    const int xs = uu >> 6, b = xs >> 1, kvh = xs & 1, h = 4 * kvh + ((uu >> 4) & 3), qb = uu & 15;
                    const size_t rb = (size_t)b * TPB, rq = rb + 256 + 256 * qb;
                    Qu = P + rq * PC + 64 * h; Kh = P + rb * PC + 512 + 64 * kvh; Vh = P + rb * PC + 640 + 64 * kvh; Ou = Y3 + rq * 1536 + 64 * h; NT = 68;
                } else {
                    const int v = uu - 512, type = v >> 5, b = (v >> 3) & 3, h = v & 7, kvh = h >> 2; const size_t rb = (size_t)b * TPB;
                    if (type) sk = snk[h] * LOG2E;
                    Qu = P + rb * PC + (type ? 2304 : 0) + 64 * h; Kh = P + rb * PC + (type ? 2816 : 512) + 64 * kvh; Vh = P + rb * PC + (type ? 2944 : 640) + 64 * kvh; Ou = Y3 + rb * 1536 + (type ? 1024 : 0) + 64 * h; NT = 4;
                }
                attn_body::attn_unit<8, 0>(Qu, Kh, Vh, Ou, NT, 0, 0, sk, (char*)lds_raw, fresh_tid(wave_s));
            }
        }
#endif
#ifndef SKIP_AT1
        {
            unsigned char* ws = KWS(); const bf16_t* P = WSP(bf16_t, WS_P); bf16_t* Y3 = WSP(bf16_t, WS_Y3); const float* snk = KIN(I_sink_c) + l * 8;
#pragma unroll 1
            for (int k = 0;; ++k) {
                int uu;
                if (G == 256) { if (k < 2) uu = (vcu >> 5) * 64 + (vcu & 31) * 2 + k; else break;
                    const int j = uu & 63; const int hq = j < 8 ? (j >> 1) : (j - 8) / 14, qq = j < 8 ? ((j & 1) ? 15 : 0) : 1 + (j - 8) % 14; uu = (uu & ~63) | (hq << 4) | qq; }
                else { uu = bx + k * G; if (uu >= 512) break; }
                const int xs = uu >> 6, b = xs >> 1, kvh = xs & 1, h = 4 * kvh + ((uu >> 4) & 3), qb = uu & 15;
                const size_t rb = (size_t)b * TPB, rq = rb + 256 + 256 * qb;
                const int q0 = 256 * qb, kstart = q0 >= 128 ? q0 - 128 : 0, kend = q0 + 384 <= SEQ ? q0 + 384 : SEQ;
                attn_body::attn_unit<8, 1>(P + rq * PC + 2304 + 64 * h, P + rb * PC + 2816 + 64 * kvh, P + rb * PC + 2944 + 64 * kvh, Y3 + rq * 1536 + 1024 + 64 * h, 4 + (kend - kstart) / 64, kstart, q0 - kstart, snk[h] * LOG2E, (char*)lds_raw, fresh_tid(wave_s));
            }
        }
#endif
        GRID_BAR(); TP(5);
#ifndef SKIP_M1
        {
            unsigned char* ws = KWS();
            unsigned* cnt = WSP(unsigned, WS_CTL) + CW_PAN + l * 68 * 32;
            {
                SchedM1 S{(const char*)WSP(bf16_t, WS_Y3), (const char*)(WSP(bf16_t, WS_WBR) + (size_t)l * D * 1536), cnt, bx, need_ctx};
                pg8::EpiBranch E{WSP(bf16_t, WS_G), WSP(bf16_t, WS_MB)};
                pg8::SKCtx X{ws + WS_PART, WSP(unsigned, WS_CTL) + CW_FLG + 8192 * (8 + l), WSP(unsigned, WS_CTL) + CW_TMO, bx};
                pg8::gemm_phase<pg8::EpiBranch, SchedM1, true>(lds, fresh_tid(wave_s), S, E, X);
            }
#pragma unroll 1
            for (int i = 1; i < 3; ++i) {
                unsigned char* ws2 = KWS();
                SchedM2One S{(const char*)(ws2 + WS_MB), (const char*)((bf16_t*)(ws2 + WS_WOUT) + (size_t)l * D * D), bx, need_ctx, i};
                pg8::Unit u;
                if (S.unit(u)) {
                    wait_panel(cnt, (unsigned*)(ws2 + WS_CTL) + CW_TMO, u.pm, wave_s, 32u);
                    pg8::EpiResid E{(bf16_t*)(ws2 + WS_XS), (float*)(ws2 + WS_MODS) + (size_t)l * 5 * INC + 2 * D};
                    pg8::SKCtx X{ws2 + WS_PART, (unsigned*)(ws2 + WS_CTL) + CW_FLG + 8192 * (12 + l), (unsigned*)(ws2 + WS_CTL) + CW_TMO, bx};
                    pg8::gemm_phase<pg8::EpiResid, SchedM2One, true>(lds, fresh_tid(wave_s), S, E, X);
                }
            }
        }
#endif
        GRID_BAR(); TP(6);
#ifndef SKIP_N2
        {
            PHASE_IDS(); unsigned char* ws = KWS(); const bf16_t* XS = WSP(bf16_t, WS_XS); bf16_t* HN = WSP(bf16_t, WS_HN); const float* modl = WSP(float, WS_MODS) + (size_t)l * 5 * INC;
            const float* g2 = KIN(I_norm2_g) + (size_t)l * D;
            const int nrows = need_ctx ? M : NB * SEQ;
            if (!moe) {
                struct N2Job { bool need_ctx; const bf16_t* XS; bf16_t* HN; const float* modl; const float* g2;
                    __device__ __forceinline__ void operator()(int rr, RowJob& J) const {
                        const int row = need_ctx ? rr : (rr / SEQ) * TPB + CTXL + (rr % SEQ);
                        const int b = row / TPB, tq = row - b * TPB, who = tq < CTXL ? 4 : b;
                        J.src = nullptr; J.srcb = XS + (size_t)row * D; J.xs_out = nullptr; J.hn = HN + (size_t)row * D; J.row = row;
                        J.A = NormArgs{}; J.A.g = g2; J.A.shift = modl + (size_t)who * INC + 3 * D; J.A.scale = modl + (size_t)who * INC + 4 * D; } };
                const N2Job job{need_ctx, XS, HN, modl, g2};
                { const int RPB = (nrows + G - 1) / G, r0 = bx * RPB, r1 = (r0 + RPB < nrows) ? r0 + RPB : nrows; norm_rows<false, false>(r0 + wave, NWAVES, r1, job, lane); }
            } else {
                const int RPB = (nrows + G - 1) / G, r0 = bx * RPB, r1 = (r0 + RPB < nrows) ? r0 + RPB : nrows;
                LAS int* route = (LAS int*)lds;
                const float* rw = KIN(I_router_w) + (size_t)jf * D * NEXP; const float* rb = KIN(I_router_b) + jf * NEXP;
                int* PE = (int*)(ws + WS_META + MT_PE); int* PPOS = (int*)(ws + WS_META + MT_PPOS); float* PW = (float*)(ws + WS_META + MT_PW); int* BC = (int*)(ws + WS_META + MT_BC);
                LAS float* rwl = (LAS float*)(lds + 4096);
                for (int i = tid; i < D * NEXP; i += NTHR) rwl[(i & 7) * 1024 + (i >> 3)] = rw[i];
                LDS_WAIT(); __syncthreads();
                struct N2MJob { bool need_ctx; const bf16_t* XS; bf16_t* HN; const float* modl; const float* g2; const LAS float* rw; const float* rb; LAS int* route; int r0; int* PE; float* PW;
                    __device__ __forceinline__ void operator()(int rr, RowJob& J) const {
                        const int row = need_ctx ? rr : (rr / SEQ) * TPB + CTXL + (rr % SEQ);
                        const int b = row / TPB, tq = row - b * TPB, who = tq < CTXL ? 4 : b;
                        J.src = nullptr; J.srcb = XS + (size_t)row * D; J.xs_out = nullptr; J.hn = nullptr; J.row = row;
                        J.A = NormArgs{}; J.A.g = g2; J.A.shift = modl + (size_t)who * INC + 3 * D; J.A.scale = modl + (size_t)who * INC + 4 * D; J.A.hn8 = (unsigned char*)HN + (size_t)row * D;
                        J.A.rw = rw; J.A.rb = rb; J.A.route = route + 2 * (rr - r0); J.A.PE = PE; J.A.PW = PW; } };
                const N2MJob job{need_ctx, XS, HN, modl, g2, rwl, rb, route, r0, PE, PW};
                norm_rows<false, false>(r0 + wave, NWAVES, r1, job, lane);
                LDS_WAIT(); __syncthreads();
                {
                    const int npair = 2 * (r1 - r0 > 0 ? r1 - r0 : 0); int cnt = 0;
                    for (int k0 = 0; k0 < npair; k0 += 64) { const int k = k0 + lane; const bool mine = (k < npair) && (route[k] == wave);
                        const unsigned long long bal = __ballot(mine);
                        if (mine) { const int rr = r0 + (k >> 1); const int row = need_ctx ? rr : (rr / SEQ) * TPB + CTXL + (rr % SEQ);
                            PPOS[2 * row + (k & 1)] = cnt + __popcll(bal & ((1ull << lane) - 1ull)); }
                        cnt += __popcll(bal); }
                    if (lane == 0) BC[bx * 8 + wave] = cnt;
                }
                __syncthreads();
            }
        }
#endif
        GRID_BAR(); TP(8);
        if (!moe) {
#ifndef SKIP_F1
            {
                unsigned char* ws = KWS();
                SchedPlain S{(const char*)WSP(bf16_t, WS_HN), (const char*)(WSP(bf16_t, WS_W13) + (size_t)jf * 2 * DFF * D), (size_t)256 * D * 2, (size_t)256 * D * 2, need_ctx ? NMT : 64, 2 * DFF / 256, G, bx, !need_ctx, D / 64, D, D};
                pg8::EpiSwiGLU E{WSP(bf16_t, WS_H), DFF};
                pg8::gemm_phase<pg8::EpiSwiGLU, SchedPlain, true>(lds, fresh_tid(wave_s), S, E);
            }
#endif
            GRID_BAR(); TP(9);
#ifndef SKIP_F2
            {
                unsigned char* ws = KWS();
                SchedWR<DFF / 128> S{(const char*)WSP(bf16_t, WS_H), (const char*)(WSP(bf16_t, WS_W2) + (size_t)jf * D * DFF), (size_t)256 * DFF * 2, (size_t)256 * DFF * 2, 0, need_ctx ? NMT : 64, G, bx, !need_ctx, 1 << 30, 1 << 30, 1 << 30, 1 << 30, 1 << 30, 1 << 30, 1 << 30, DFF, DFF};
                pg8::EpiResid E{WSP(bf16_t, WS_XS), WSP(float, WS_MODS) + (size_t)l * 5 * INC + 5 * D};
                pg8::SKCtx X{ws + WS_PART, WSP(unsigned, WS_CTL) + CW_FLG + 8192 * (4 + jf), WSP(unsigned, WS_CTL) + CW_TMO, bx};
                pg8::gemm_phase<pg8::EpiResid, SchedWR<DFF / 128>, true>(lds, fresh_tid(wave_s), S, E, X);
            }
#endif
            GRID_BAR(); TP(10);
        } else {
#ifndef SKIP_GA
            {
                PHASE_IDS(); unsigned char* ws = KWS(); const bf16_t* HN = WSP(bf16_t, WS_HN); bf16_t* HS = WSP(bf16_t, WS_R2);
                const int* PE = (const int*)(ws + WS_META + MT_PE); const int* PPOS = (const int*)(ws + WS_META + MT_PPOS); const float* PW = (const float*)(ws + WS_META + MT_PW);
                int* DST = (int*)(ws + WS_META + MT_DST); float* CW = (float*)(ws + WS_META + MT_CW); const int* BC = (const int*)(ws + WS_META + MT_BC);
                const int nrows = need_ctx ? M : NB * SEQ, RPB = (nrows + G - 1) / G;
                LAS int* PRE = (LAS int*)lds; LAS int* LT = PRE + 8 * 256; LAS int* TOT = LT + 8 * 64;
                if (G <= 256) {
                    int c4[4], sum = 0;
#pragma unroll
                    for (int q = 0; q < 4; ++q) { const int b = 4 * lane + q; c4[q] = (b < G) ? BC[b * 8 + wave] : 0; sum += c4[q]; }
                    LT[wave * 64 + lane] = sum;
                    LDS_WAIT();
                    int pre = 0; for (int q = 0; q < lane; ++q) pre += LT[wave * 64 + q];
                    if (lane == 63) TOT[wave] = pre + sum;
#pragma unroll
                    for (int q = 0; q < 4; ++q) { PRE[(4 * lane + q) * 8 + wave] = pre; pre += c4[q]; }
                }
                LDS_WAIT(); __syncthreads();
                int ts[9]; ts[0] = 0;
#pragma unroll
                for (int e = 0; e < 8; ++e) ts[e + 1] = ts[e] + ((TOT[e] + 255) >> 8);
                if (bx == 0 && tid < 8) __hip_atomic_store(WSP(unsigned, WS_CTL) + CW_CNT + 1024 * jf + 64 * tid, (unsigned)TOT[tid], RLX_AGENT);
                unsigned char* HS8 = (unsigned char*)HS;
#pragma unroll 1
                for (int rr0 = gw; rr0 < nrows; rr0 += 4 * NGW) {
                    int row[4], pe[4][2], pp[4][2]; float pw[4][2]; u32x4 q[4]; bool ok[4];
#pragma unroll
                    for (int k = 0; k < 4; ++k) { const int rr = rr0 + k * NGW; ok[k] = rr < nrows; const int rc = ok[k] ? rr : rr0; row[k] = need_ctx ? rc : (rc / SEQ) * TPB + CTXL + (rc % SEQ); }
#pragma unroll
                    for (int k = 0; k < 4; ++k) { q[k] = *(const u32x4*)((const unsigned char*)HN + (size_t)row[k] * D + 16 * lane);
#pragma unroll
                        for (int s = 0; s < 2; ++s) { pe[k][s] = PE[2 * row[k] + s]; pp[k][s] = PPOS[2 * row[k] + s]; pw[k][s] = PW[2 * row[k] + s]; } }
#pragma unroll
                    for (int k = 0; k < 4; ++k) { const int rr = rr0 + k * NGW, blk = (ok[k] ? rr : rr0) / RPB;
                        if (ok[k]) {
#pragma unroll
                            for (int s = 0; s < 2; ++s) { const int e = pe[k][s], pos = pp[k][s] + PRE[blk * 8 + e];
                                int t0 = 0;
#pragma unroll
                                for (int kk = 1; kk < 8; ++kk) t0 = (e == kk) ? ts[kk] : t0;
                                const int d = 256 * t0 + pos;
                                *(u32x4*)(HS8 + (size_t)d * D + 16 * lane) = q[k];
                                if (lane == 0) { CW[d] = pw[k][s]; DST[2 * row[k] + s] = d; } } } }
                }
            }
#endif
            GRID_BAR(); TP(11);
#ifndef SKIP_E1
            {
                unsigned char* ws = KWS();
                int ts[9]; ts[0] = 0;
#pragma unroll
                for (int e = 0; e < 8; ++e) { const unsigned c = __hip_atomic_load(WSP(unsigned, WS_CTL) + CW_CNT + 1024 * jf + 64 * e, RLX_AGENT); ts[e + 1] = ts[e] + (int)((c + 255u) >> 8); }
                SchedMoE S{(const char*)(ws + WS_R2), (const char*)(ws + WS_E13 + (size_t)jf * 8 * 2 * DFE * D), (size_t)256 * D, (size_t)256 * D, (size_t)2 * DFE * D, ts[8], 2 * DFE / 256, G, bx, ts[1], ts[2], ts[3], ts[4], ts[5], ts[6], ts[7], D / 128, D / 2, D / 2};
                pg8::EpiSwiGLU8 E{ws + WS_H, DFE, 1.0f / (FP8_SC_X * FP8_SC_W13), FP8_SC_H};
                pg8::gemm_phase<pg8::EpiSwiGLU8, SchedMoE, true, true>(lds, fresh_tid(wave_s), S, E);
            }
#endif
            GRID_BAR(); TP(12);
#ifndef SKIP_E2
            {
                unsigned char* ws = KWS();
                int ts[9]; ts[0] = 0;
#pragma unroll
                for (int e = 0; e < 8; ++e) { const unsigned c = __hip_atomic_load(WSP(unsigned, WS_CTL) + CW_CNT + 1024 * jf + 64 * e, RLX_AGENT); ts[e + 1] = ts[e] + (int)((c + 255u) >> 8); }
                SchedWR<DFE / 256> S{(const char*)(ws + WS_H), (const char*)(ws + WS_E2 + (size_t)jf * 8 * D * DFE), (size_t)256 * DFE, (size_t)256 * DFE, (size_t)D * DFE, ts[8], G, bx, false, ts[1], ts[2], ts[3], ts[4], ts[5], ts[6], ts[7], DFE / 2, DFE / 2};
                pg8::EpiMoEDown E{WSP(bf16_t, WS_R2), (const float*)(ws + WS_META + MT_CW), 1.0f / (FP8_SC_H * FP8_SC_W2)};
                pg8::SKCtx X{ws + WS_PART, WSP(unsigned, WS_CTL) + CW_FLG + 8192 * (6 + jf), WSP(unsigned, WS_CTL) + CW_TMO, bx};
                pg8::gemm_phase<pg8::EpiMoEDown, SchedWR<DFE / 256>, true, true>(lds, fresh_tid(wave_s), S, E, X);
            }
#endif
            GRID_BAR(); TP(13);
        }
    }
#ifdef TPROBE
    { unsigned char* ws = KWS(); if (bx == 0 && fresh_tid(wave_s) < 16) WSP(unsigned, WS_RETC + 4096)[fresh_tid(wave_s)] = MISC[16 + fresh_tid(wave_s)]; }
    GRID_BAR();
#endif
    {
        PHASE_IDS(); unsigned char* ws = KWS(); const bf16_t* XS = WSP(bf16_t, WS_XS); const float* MODS = WSP(float, WS_MODS); const bf16_t* YY = WSP(bf16_t, WS_R2); const int* DST = (const int*)(ws + WS_META + MT_DST);
        const float* fgp = KIN(I_final_g); float* outp = KOUT();
        const unsigned tmo = __hip_atomic_load(WSP(unsigned, WS_CTL) + CW_BAR + XB_TMO, RLX_AGENT) | __hip_atomic_load(WSP(unsigned, WS_CTL) + CW_TMO, RLX_AGENT);
#pragma unroll 1
        for (int rr0 = gw; rr0 < NB * SEQ; rr0 += 4 * NGW) {
            int rrk[4], rowk[4], dk[4][2]; const float* gtk[4]; bool ok[4];
#pragma unroll
            for (int k = 0; k < 4; ++k) { const int rr = rr0 + k * NGW; ok[k] = rr < NB * SEQ; rrk[k] = ok[k] ? rr : rr0; const int b = rrk[k] / SEQ; rowk[k] = b * TPB + CTXL + (rrk[k] % SEQ);
                gtk[k] = MODS + ((size_t)3 * 5 + b) * INC + 5 * D; dk[k][0] = DST[2 * rowk[k]]; dk[k][1] = DST[2 * rowk[k] + 1]; }
            u32x2 xb[4][4], y0[4][4], y1[4][4]; f32x4 g4[4][4];
#pragma unroll
            for (int k = 0; k < 4; ++k)
#pragma unroll
                for (int j = 0; j < 4; ++j) { const int c = 4 * lane + 256 * j; xb[k][j] = *(const u32x2*)(XS + (size_t)rowk[k] * D + c);
                    y0[k][j] = *(const u32x2*)(YY + (size_t)dk[k][0] * D + c); y1[k][j] = *(const u32x2*)(YY + (size_t)dk[k][1] * D + c); g4[k][j] = *(const f32x4*)(gtk[k] + c); }
#pragma unroll
            for (int k = 0; k < 4; ++k) {
                const int rr = rrk[k];
                f32x4 v[4]; float ss = 0.f;
#pragma unroll
                for (int j = 0; j < 4; ++j) { v[j] = (f32x4){bflo(xb[k][j].x), bfhi(xb[k][j].x), bflo(xb[k][j].y), bfhi(xb[k][j].y)};
                    v[j][0] += g4[k][j][0] * (bflo(y0[k][j].x) + bflo(y1[k][j].x)); v[j][1] += g4[k][j][1] * (bfhi(y0[k][j].x) + bfhi(y1[k][j].x)); v[j][2] += g4[k][j][2] * (bflo(y0[k][j].y) + bflo(y1[k][j].y)); v[j][3] += g4[k][j][3] * (bfhi(y0[k][j].y) + bfhi(y1[k][j].y));
                    ss += (v[j][0] * v[j][0] + v[j][1] * v[j][1]) + (v[j][2] * v[j][2] + v[j][3] * v[j][3]); }
                float rs = rsqrtf(wave_sum(ss) * (1.0f / D) + EPS);
                if (tmo) rs = __builtin_nanf("");
                if (ok[k]) {
#pragma unroll
                    for (int j = 0; j < 4; ++j) { const int c = 4 * lane + 256 * j; const f32x4 fg = *(const f32x4*)(fgp + c); *(f32x4*)(outp + (size_t)rr * D + c) = v[j] * rs * fg; }
#ifdef TPROBE
            { const unsigned* T = WSP(unsigned, WS_RETC + 4096); const float c2 = (TPROBE_B >= 0 ? (float)T[TPROBE_B < 0 ? 0 : TPROBE_B] : (float)(T[0] + T[1] + T[2] + T[3] + T[4] + T[5] + T[6] + T[7] + T[8] + T[9] + T[10] + T[11] + T[12] + T[13])) * 0.01f * TPROBE_SB;
#pragma unroll
              for (int j = 0; j < 4; ++j) { const int c = 4 * lane + 256 * j; f32x4 o = (f32x4){100.f, 100.f, 100.f, 100.f}; if (rr == 0 && c == 0) o[0] = c2; *(f32x4*)(outp + (size_t)rr * D + c) = o; } }
#endif
                }
            }
        }
    }
#undef GRID_BAR
}

extern "C" void kernel_launch(void* const* d_in, const int* in_sizes, int n_in, void* d_out, int out_size, void* d_ws, size_t ws_size, hipStream_t stream) {
    static int grid = 0;
    if (grid == 0) {
        if (n_in != 28 || out_size != NB * SEQ * D || ws_size < WS_END) { fprintf(stderr, "kernel_launch: unexpected shapes: n_in %d out %d ws %zu (need %zu)\n", n_in, out_size, ws_size, (size_t)WS_END); grid = -1; return; }
        int dev = 0, cus = 0, per_cu = 0;
        if (hipGetDevice(&dev) != hipSuccess || hipDeviceGetAttribute(&cus, hipDeviceAttributeMultiprocessorCount, dev) != hipSuccess) { grid = -1; return; }
        if (hipFuncSetAttribute((const void*)fwd_kernel, hipFuncAttributeMaxDynamicSharedMemorySize, LDS_BYTES) != hipSuccess) { fprintf(stderr, "kernel_launch: hipFuncSetAttribute failed\n"); grid = -1; return; }
        if (hipOccupancyMaxActiveBlocksPerMultiprocessor(&per_cu, (const void*)fwd_kernel, NTHR, LDS_BYTES) != hipSuccess || per_cu < 1) fprintf(stderr, "kernel_launch: occupancy query reports %d\n", per_cu);
        (void)hipGetLastError();
        grid = cus < 256 ? cus : 256;
    }
    if (grid < 0) return;
    if (hipMemsetAsync((char*)d_ws + WS_CTL, 0, CTL_ZERO_BYTES, stream) != hipSuccess) return;
    Args a{};
    const float** pp = (const float**)&a.in;
    for (int i = 0; i < 28; ++i) pp[i] = (const float*)d_in[i];
    a.out = (float*)d_out; a.ws = (unsigned char*)d_ws;
    hipLaunchKernelGGL(fwd_kernel, dim3(grid), dim3(NTHR), LDS_BYTES, stream, a);
}
```

```cpp
#include <hip/hip_runtime.h>
#include <cstdio>
#include <cstdint>
#include <cmath>

constexpr int NB = 4, SEQ = 4096, CTXL = 256, TPB = SEQ + CTXL, M = NB * TPB, D = 1024, DEPTH = 4;
constexpr int INC = 6144, PC = 3072, DFF = 2816, DFE = 3584, NEXP = 8;
constexpr int NMT = M / 256;
constexpr int MOE_ROWS = 2 * M + NEXP * 256;
constexpr float EPS = 1e-6f;
constexpr float LOG2E = 1.4426950408889634f;
constexpr float C2 = 0.125f * LOG2E;

constexpr size_t MiB = 1u << 20;
constexpr size_t WS_CTL = 0, CTL_ZERO_BYTES = 1 * MiB;
constexpr size_t WS_MODS = 1 * MiB;
constexpr size_t WS_ROPE = WS_MODS + 512 * 1024;
constexpr size_t WS_RETC = WS_ROPE + 16 * 1024;
constexpr size_t WS_META = 2 * MiB;
constexpr size_t WS_WIN = 3 * MiB;
constexpr size_t WS_WBR = WS_WIN + 48 * MiB;
constexpr size_t WS_WOUT = WS_WBR + 12 * MiB;
constexpr size_t WS_W13 = WS_WOUT + 8 * MiB;
constexpr size_t WS_W2 = WS_W13 + 22 * MiB;
constexpr size_t WS_E13 = WS_W2 + 11 * MiB;
constexpr size_t WS_E2 = WS_E13 + 224 * MiB;
constexpr size_t WS_XS = WS_E2 + 112 * MiB;
constexpr size_t WS_HN = WS_XS + 68 * MiB;
constexpr size_t WS_P = WS_HN + 34 * MiB;
constexpr size_t WS_G = WS_P + 102 * MiB;
constexpr size_t WS_Y3 = WS_G + 102 * MiB;
constexpr size_t WS_R2 = WS_Y3 + 51 * MiB;
constexpr size_t WS_MB = WS_R2, WS_KVS = WS_R2 + 34 * MiB;
constexpr size_t WS_KVB = WS_HN;
constexpr size_t WS_HN8 = WS_Y3;
#ifndef G1M0
#define G1M0 0xFFF000u
#define G1M1 0xFFF000u
#define G1M2 0xFFFFFFu
#define G1M3 0xFFFFFFu
#endif
__device__ __forceinline__ unsigned g1_mask(int l) { return (l == 0 ? G1M0 : l == 1 ? G1M1 : l == 2 ? G1M2 : G1M3) | 0xFFF000u; }
__device__ __forceinline__ int nth_bit(unsigned m, int j) { for (int t = 0; t < j; ++t) m &= m - 1u; return __builtin_ctz(m); }
constexpr size_t WG8_OFF = (size_t)3072 * D * 2;
constexpr size_t WS_PART = WS_R2 + 72 * MiB;
constexpr size_t WS_END = WS_PART + 64 * MiB;
constexpr size_t WS_H = WS_P;
static_assert((size_t)MOE_ROWS * DFE * 2 <= WS_R2 - WS_P, "HM overlay");
static_assert((size_t)MOE_ROWS * D * 2 <= 72 * MiB, "HS overlay");
constexpr size_t MT_PE = 0, MT_PPOS = MT_PE + (size_t)M * 8, MT_PW = MT_PPOS + (size_t)M * 8, MT_DST = MT_PW + (size_t)M * 8, MT_CW = MT_DST + (size_t)M * 8, MT_BC = MT_CW + (size_t)MOE_ROWS * 4, MT_END = MT_BC + 256 * 8 * 4;
static_assert(MT_END <= 1 * MiB, "meta");
constexpr int CW_TMO = 0, CW_CODE = 1, CW_BAR = 4096, CW_CNT = 8192, CW_FLG = 65536, CW_PAN = 200000;

constexpr int RING_BYTES = 131072, LDSCTL_OFF = RING_BYTES, MISC_OFF = LDSCTL_OFF + 320, LDS_BYTES = 147456;
constexpr int NWAVES = 8, NTHR = 512;

#define GAS __attribute__((address_space(1)))
#define LAS __attribute__((address_space(3)))
typedef unsigned short bf16_t;
typedef unsigned u32x4 __attribute__((ext_vector_type(4)));
typedef unsigned u32x2 __attribute__((ext_vector_type(2)));
typedef float f32x4 __attribute__((ext_vector_type(4)));
typedef float f32x2 __attribute__((ext_vector_type(2)));
typedef float f32x16 __attribute__((ext_vector_type(16)));
typedef short bf16x8 __attribute__((ext_vector_type(8)));
typedef short s16x4 __attribute__((ext_vector_type(4)));
#define RLX_AGENT __ATOMIC_RELAXED, __HIP_MEMORY_SCOPE_AGENT
#define LDS_WAIT() asm volatile("s_waitcnt lgkmcnt(0)" ::: "memory")
#define VM_WAIT() asm volatile("s_waitcnt vmcnt(0)" ::: "memory")
typedef float f32x2v_t __attribute__((ext_vector_type(2))); typedef __bf16 bf16x2v_t __attribute__((ext_vector_type(2)));
__device__ __forceinline__ unsigned pk2(float lo, float hi) { const f32x2v_t v = {lo, hi}; return __builtin_bit_cast(unsigned, __builtin_convertvector(v, bf16x2v_t)); }
__device__ __forceinline__ unsigned f2bf(float f) { return pk2(f, f) & 0xffffu; }
__device__ __forceinline__ float bflo(unsigned w) { return __builtin_bit_cast(float, w << 16); }
__device__ __forceinline__ float bfhi(unsigned w) { return __builtin_bit_cast(float, w & 0xffff0000u); }
typedef int i32x8 __attribute__((ext_vector_type(8)));
typedef int i32x4 __attribute__((ext_vector_type(4)));
__device__ __forceinline__ unsigned pk4_fp8(float a, float b, float c, float d) { int p = __builtin_amdgcn_cvt_pk_fp8_f32(a, b, 0, false); p = __builtin_amdgcn_cvt_pk_fp8_f32(c, d, p, true); return (unsigned)p; }
constexpr float FP8_SC_X = 4.0f, FP8_SC_H = 2.0f, FP8_SC_W13 = 32.0f, FP8_SC_W2 = 64.0f, FP8_SC_WG = 32.0f;
__device__ __forceinline__ float sigmoidf_(float x) { return __builtin_amdgcn_rcpf(1.0f + __builtin_amdgcn_exp2f(x * -LOG2E)); }
__device__ __forceinline__ float siluf_(float x) { return x * sigmoidf_(x); }
__device__ __forceinline__ int fresh_lane() { int l; asm volatile("v_mbcnt_lo_u32_b32 %0, -1, 0\n\tv_mbcnt_hi_u32_b32 %0, -1, %0" : "=v"(l)); return l; }
__device__ __forceinline__ int fresh_tid(int wave_s) { int l; asm volatile("v_mbcnt_lo_u32_b32 %0, -1, 0\n\tv_mbcnt_hi_u32_b32 %0, -1, %0" : "=v"(l)); return wave_s * 64 + l; }
template <int MSK> __device__ __forceinline__ float swz_xor(float v) { return __builtin_bit_cast(float, __builtin_amdgcn_ds_swizzle(__builtin_bit_cast(int, v), (MSK << 10) | 0x1f)); }
__device__ __forceinline__ float xor32_sum(float v) { const unsigned u = __builtin_bit_cast(unsigned, v); auto rr = __builtin_amdgcn_permlane32_swap(u, u, false, false); return __builtin_bit_cast(float, (unsigned)rr[0]) + __builtin_bit_cast(float, (unsigned)rr[1]); }
template <int CTRL> __device__ __forceinline__ float dpp_f(float v) { return __builtin_bit_cast(float, __builtin_amdgcn_update_dpp(0, __builtin_bit_cast(int, v), CTRL, 0xf, 0xf, true)); }
__device__ __forceinline__ float half_sum(float v) { v += dpp_f<0xB1>(v); v += dpp_f<0x4E>(v); v += dpp_f<0x141>(v); v += dpp_f<0x140>(v); v += swz_xor<16>(v); return v; }
__device__ __forceinline__ float wave_sum(float v) { return xor32_sum(half_sum(v)); }

typedef const __attribute__((address_space(4))) unsigned char* kargp_t;
__device__ __forceinline__ kargp_t kfresh() { kargp_t p = (kargp_t)__builtin_amdgcn_kernarg_segment_ptr(); asm volatile("" : "+s"(p)); return p; }
#define KIN(idx) (((const float* const __attribute__((address_space(4)))*)kfresh())[idx])
#define KOUT() (((float* const __attribute__((address_space(4)))*)kfresh())[28])
#define KWS() (((unsigned char* const __attribute__((address_space(4)))*)kfresh())[29])
enum { I_x, I_c, I_ctx, I_c_ctx, I_w_ada, I_b_ada, I_norm1_g, I_norm2_g, I_final_g, I_w_in, I_b_gate, I_qn_a, I_kn_a, I_ret_a, I_ret_g, I_sink_c, I_w_br_a, I_w_br_b, I_w_br_c, I_w_out, I_ffn_w1, I_ffn_w3, I_ffn_w2, I_router_w, I_router_b, I_exp_w1, I_exp_w3, I_exp_w2 };
#define WSP(T, off) ((T*)(ws + (off)))

#define XB_TMO      128
#define XB_XCNT(j)  (256  + 64 * (j))
#define XB_XSUB(j)  (1280 + 64 * (j))
#define XB_XGEN(j)  (2304 + 64 * (j))
#define XB_TOP      3328
#define XB_TOPGEN   3392
#define XCD_BAR_WORDS 3456
#define XB_SPIN_CAP (1u << 20)
__device__ __forceinline__ unsigned xb_ld(unsigned* p)              { return __hip_atomic_load(p, __ATOMIC_RELAXED, __HIP_MEMORY_SCOPE_AGENT); }
__device__ __forceinline__ unsigned xb_add(unsigned* p, unsigned v) { return __hip_atomic_fetch_add(p, v, __ATOMIC_RELAXED, __HIP_MEMORY_SCOPE_AGENT); }
__device__ __forceinline__ unsigned xb_xcc_id() { return (unsigned)__builtin_amdgcn_s_getreg((3 << 11) | 20) & 0xFu; }
#define XB_SPIN(cond, bar) do { unsigned _sp = 0; while (cond) { __builtin_amdgcn_s_sleep(1); \
    if ((++_sp & 255u) == 0u) { if (xb_ld(&(bar)[XB_TMO])) break; if (_sp > XB_SPIN_CAP) { atomicAdd(&(bar)[XB_TMO], 1u); break; } } } } while (0)
struct XcdBarrier { unsigned* bar; unsigned x; volatile LAS unsigned* st; };
__device__ __forceinline__ XcdBarrier xcd_barrier_post(unsigned* bar, volatile LAS unsigned* st) {
    XcdBarrier b; b.bar = bar; b.x = xb_xcc_id(); b.st = st;
    if (threadIdx.x == 0) (void)xb_add(&bar[XB_XCNT(b.x)], 1u);
    return b;
}
__device__ __forceinline__ void xcd_barrier_complete(unsigned* bar, unsigned x, unsigned& nloc, unsigned& nx) {
    const unsigned G = gridDim.x * gridDim.y * gridDim.z;
    unsigned sum, cnt, mine, sp = 0u;
    for (;;) {
        sum = 0u; cnt = 0u; mine = 0u;
#pragma unroll
        for (unsigned j = 0; j < 16; ++j) { const unsigned c = xb_ld(&bar[XB_XCNT(j)]); sum += c; cnt += (c > 0u) ? 1u : 0u; mine = (j == x) ? c : mine; }
        if (sum == G) break;
        __builtin_amdgcn_s_sleep(1);
        if ((++sp & 255u) == 0u) { if (xb_ld(&bar[XB_TMO])) break; if (sp > XB_SPIN_CAP) { atomicAdd(&bar[XB_TMO], 1u); break; } }
    }
    nloc = mine > 0u ? mine : 1u; nx = cnt > 0u ? cnt : 1u;
}
__device__ __forceinline__ void xcd_barrier(const XcdBarrier& b) {
    asm volatile("s_waitcnt vmcnt(0)" ::: "memory");
    __syncthreads();
    if (threadIdx.x == 0) {
        unsigned* bar = b.bar;
        __builtin_amdgcn_s_waitcnt(0);
        unsigned nloc = b.st[0], nx = b.st[1];
        if (nloc == 0u) { xcd_barrier_complete(bar, b.x, nloc, nx); b.st[0] = nloc; b.st[1] = nx; }
        const unsigned old = xb_add(&bar[XB_XSUB(b.x)], 1u);
        const unsigned gen = old / nloc;
        if (old + 1u == (gen + 1u) * nloc) {
            __builtin_amdgcn_fence(__ATOMIC_RELEASE, "agent");
            asm volatile("s_waitcnt vmcnt(0)" ::: "memory");
            const unsigned og = xb_add(&bar[XB_TOP], 1u);
            const unsigned tg = og / nx;
            if (og + 1u == (tg + 1u) * nx) xb_add(&bar[XB_TOPGEN], 1u);
            else XB_SPIN(xb_ld(&bar[XB_TOPGEN]) == tg, bar);
            __builtin_amdgcn_fence(__ATOMIC_ACQUIRE, "agent");
            xb_add(&bar[XB_XGEN(b.x)], 1u);
            asm volatile("s_waitcnt vmcnt(0)" ::: "memory");
        } else {
            XB_SPIN(xb_ld(&bar[XB_XGEN(b.x)]) == gen, bar);
            __builtin_amdgcn_fence(__ATOMIC_ACQUIRE, "agent");
            asm volatile("s_waitcnt vmcnt(0)" ::: "memory");
        }
    }
    __syncthreads();
}
namespace pg8 {
constexpr int BM = 256, BK = 64, HALF = 128, HTB = HALF * BK * 2, STAGE_BYTES = 8 * HTB;
__device__ __forceinline__ int lds_byte(int r, int c) { const int st = (r >> 4) * 2 + (c >> 5), rr = r & 15, cc = c & 31, ob = rr * 64 + cc * 2; return st * 1024 + (ob ^ (((ob >> 9) & 1) << 5)); }
__device__ __forceinline__ void stage_rc(int b, int& R, int& C) { const int st = b / 1024, sb = b % 1024, swz = sb ^ (((sb >> 9) & 1) << 5); R = (st >> 1) * 16 + swz / 64; C = (st & 1) * 32 + (swz % 64) / 2; }
__device__ __forceinline__ int perm32(int rho) { const int n = rho >> 4, i = rho & 15; return 8 * (i >> 2) + 4 * n + (i & 3); }

struct Unit { int pm, pn, aux, ntk, mode, peer, kt0, kind, lda, ldb; const char* A; const char* B; };
struct SKCtx { unsigned char* part; unsigned* flags; unsigned* tmo; int self; };
constexpr unsigned SK_SLOT = 262144u, SK_SPIN_CAP = 1u << 20;
#ifndef SKB
#define SKB 16
#endif
__device__ __forceinline__ void sk_store_partial(const f32x4 (&acc)[2][2][4][2], const SKCtx& X, int wid) {
    const int tid = wid * 64 + fresh_lane();
    const __amdgpu_buffer_rsrc_t rs = __builtin_amdgcn_make_buffer_rsrc(X.part + (size_t)X.self * SK_SLOT, 0, SK_SLOT, 0x00020000);
#pragma unroll
    for (int r = 0; r < 32; ++r) __builtin_amdgcn_raw_buffer_store_b128(__builtin_bit_cast(u32x4, acc[r >> 4][(r >> 3) & 1][(r >> 1) & 3][r & 1]), rs, (unsigned)((r * 512 + tid) * 16), 0, 16);
    asm volatile("s_waitcnt vmcnt(0)" ::: "memory");
    if ((tid & 63) == 0) __hip_atomic_fetch_add(X.flags + 32 * X.self, 1u, __ATOMIC_RELAXED, __HIP_MEMORY_SCOPE_AGENT);
}
__device__ __forceinline__ void sk_add_partial(f32x4 (&acc)[2][2][4][2], const SKCtx& X, int peer, int wid) {
    const int tid = wid * 64 + fresh_lane();
    unsigned spins = 0;
    while ((unsigned)__builtin_amdgcn_readfirstlane(__hip_atomic_load(X.flags + 32 * peer, __ATOMIC_RELAXED, __HIP_MEMORY_SCOPE_AGENT)) < 8u) {
        __builtin_amdgcn_s_sleep(1);
        if (++spins > SK_SPIN_CAP) { if ((tid & 63) == 0) __hip_atomic_store(X.tmo, 1u, __ATOMIC_RELAXED, __HIP_MEMORY_SCOPE_AGENT); break; } }
    __builtin_amdgcn_fence(__ATOMIC_ACQUIRE, "agent");
    asm volatile("s_waitcnt vmcnt(0)" ::: "memory");
    const int t2 = tid;
    const f32x4* p = (const f32x4*)(X.part + (size_t)peer * SK_SLOT) + t2;
#pragma unroll
    for (int r0 = 0; r0 < 32; r0 += SKB) {
        f32x4 v[SKB];
#pragma unroll
        for (int k = 0; k < SKB; ++k) asm volatile("global_load_dwordx4 %0, %1, off sc1" : "=v"(v[k]) : "v"(p + (r0 + k) * 512) : "memory");
        asm volatile("s_waitcnt vmcnt(0)" ::: "memory");
#pragma unroll
        for (int k = 0; k < SKB; ++k) asm volatile("" : "+v"(v[k]));
#pragma unroll
        for (int k = 0; k < SKB; ++k) { const int r = r0 + k; acc[r >> 4][(r >> 3) & 1][(r >> 1) & 3][r & 1] += v[k]; }
    }
}

__device__ __forceinline__ bool tile_of(long L, int nM, int nN, int& pm, int& pn) {
    const int nwg = nM * nN; if (L >= nwg) return false;
    int wgid = (int)L; { const int q = nwg / 8, r = nwg % 8, xcd = wgid % 8, off = wgid / 8; wgid = (xcd < r ? xcd * (q + 1) : r * (q + 1) + (xcd - r) * q) + off; }
    const int nig = 8 * nN, gid = wgid / nig, fm = gid * 8, gsz = (nM - fm) < 8 ? (nM - fm) : 8;
    pm = fm + ((wgid % nig) % gsz); pn = (wgid % nig) / gsz; return true;
}
__device__ __forceinline__ unsigned cvt_pk_bf16(float lo, float hi) { return pk2(lo, hi); }

template <class Epi, class Sched, bool ALIGN_EPI, bool FP8 = false>
__device__ __forceinline__ void gemm_phase(LAS unsigned char* lds, const int tid, const Sched& S, const Epi& E, const SKCtx X = SKCtx{nullptr, nullptr, nullptr, 0}) {
    const int wid = __builtin_amdgcn_readfirstlane(tid >> 6), lane = tid & 63, wr = wid >> 2, wc = wid & 3, fr = lane & 15, fq = lane >> 4;
    unsigned RA2[2], RB2[2], C2[2];
#pragma unroll
    for (int i = 0; i < 2; ++i) { int R, C; stage_rc(tid * 16 + i * 8192, R, C); const int Rb = Epi::PERM ? ((R & ~31) + perm32(R & 31)) : R;
        RA2[i] = (unsigned)R * 2u; RB2[i] = (unsigned)Rb * 2u; C2[i] = (unsigned)C * 2u; }
    const size_t kstep = (size_t)(BK * 2);
    const unsigned ldsw = (unsigned)wid * 1024u;
    const int aoff = lds_byte(wr * 64 + fr, fq * 8), boff = lds_byte(wc * 32 + fr, fq * 8);
#define PG8_SA(b, h) (((b) * 2 + (h)) * HTB)
#define PG8_SB(b, h) ((4 + (b) * 2 + (h)) * HTB)
#define PG8_STAGE(bufoff, gbase, R2, ld) do { _Pragma("unroll") for (int _i = 0; _i < 2; ++_i) \
        __builtin_amdgcn_global_load_lds((const unsigned*)((const char*)(gbase) + ((R2)[_i] * (unsigned)(ld) + C2[_i])), (LAS unsigned*)(lds + (bufoff) + ldsw + _i * 8192), 16, 0, 0); } while (0)
#define PG8_HS(ld) ((size_t)HALF * (size_t)(ld) * 2)
#define PG8_STAGE_A(bufoff, gbase, ld, kd) do { if ((kd) == 1) { _Pragma("unroll") for (int _i = 0; _i < 2; ++_i) \
        __builtin_amdgcn_global_load_lds((const unsigned*)((const char*)(gbase) + (RA2[_i] * (unsigned)(ld) + C2[_i])), (LAS unsigned*)(lds + (bufoff) + ldsw + _i * 8192), 16, 0, 16); } \
    else { PG8_STAGE(bufoff, gbase, RA2, ld); } } while (0)
#define PG8_LDA(dst, b, h) do { if constexpr (FP8) { _Pragma("unroll") for (int m = 0; m < 4; ++m) dst##8[m] = __builtin_shufflevector(*(const LAS i32x4*)(lds + PG8_SA(b, h) + aoff + m * 2048), *(const LAS i32x4*)(lds + PG8_SA(b, h) + aoff + m * 2048 + 1024), 0, 1, 2, 3, 4, 5, 6, 7); } \
    else { _Pragma("unroll") for (int m = 0; m < 4; ++m) _Pragma("unroll") for (int k = 0; k < 2; ++k) dst[m][k] = *(const LAS bf16x8*)(lds + PG8_SA(b, h) + aoff + m * 2048 + k * 1024); } } while (0)
#define PG8_LDB(dst, b, h) do { if constexpr (FP8) { _Pragma("unroll") for (int n = 0; n < 2; ++n) dst##8[n] = __builtin_shufflevector(*(const LAS i32x4*)(lds + PG8_SB(b, h) + boff + n * 2048), *(const LAS i32x4*)(lds + PG8_SB(b, h) + boff + n * 2048 + 1024), 0, 1, 2, 3, 4, 5, 6, 7); } \
    else { _Pragma("unroll") for (int n = 0; n < 2; ++n) _Pragma("unroll") for (int k = 0; k < 2; ++k) dst[n][k] = *(const LAS bf16x8*)(lds + PG8_SB(b, h) + boff + n * 2048 + k * 1024); } } while (0)
#define PG8_MMA(ai, bj, At, Bt) do { __builtin_amdgcn_s_setprio(1); _Pragma("unroll") for (int m = 0; m < 4; ++m) _Pragma("unroll") for (int n = 0; n < 2; ++n) { \
        if constexpr (FP8) asm volatile("v_mfma_scale_f32_16x16x128_f8f6f4 %0, %1, %2, %0, %3, %3 op_sel_hi:[0,0,0]" : "+v"(acc[ai][bj][m][n]) : "v"(Bt##8[n]), "v"(At##8[m]), "v"(one8));   \
        else { _Pragma("unroll") for (int k = 0; k < 2; ++k) acc[ai][bj][m][n] = __builtin_amdgcn_mfma_f32_16x16x32_bf16(Bt[n][k], At[m][k], acc[ai][bj][m][n], 0, 0, 0); } } \
        __builtin_amdgcn_s_setprio(0); } while (0)
#define PG8_WAIT_V(n) asm volatile("s_waitcnt vmcnt(" #n ")" ::: "memory")
#define PG8_WAIT_L(n) asm volatile("s_waitcnt lgkmcnt(" #n ")" ::: "memory")
#define PG8_BAR __builtin_amdgcn_s_barrier()
#define PG8_SCHED __builtin_amdgcn_sched_barrier(0)
    Unit cur, nxt; int ui = 0;
    if (!S.next(0, cur)) return;
    f32x4 acc[2][2][4][2];
#pragma unroll
    for (int a = 0; a < 2; ++a)
#pragma unroll
        for (int b = 0; b < 2; ++b)
#pragma unroll
            for (int m = 0; m < 4; ++m)
#pragma unroll
                for (int n = 0; n < 2; ++n) acc[a][b][m][n] = (f32x4){0.f, 0.f, 0.f, 0.f};
    const int one8 = 0x7f7f7f7f;
    bf16x8 At[4][2], B0[2][2], B1[2][2]; i32x8 At8[4], B08[2], B18[2];
    const char* cA = cur.A; const char* cB = cur.B;
    S.a_ready(cur);
    PG8_STAGE(PG8_SB(0, 0), cB, RB2, cur.ldb); PG8_STAGE(PG8_SB(0, 1), cB + PG8_HS(cur.ldb), RB2, cur.ldb); PG8_STAGE(PG8_SA(0, 0), cA, RA2, cur.lda); PG8_STAGE(PG8_SA(0, 1), cA + PG8_HS(cur.lda), RA2, cur.lda);
    if (wr == 1) PG8_BAR;
    PG8_WAIT_V(2); PG8_BAR;
    PG8_STAGE(PG8_SB(1, 0), cB + kstep, RB2, cur.ldb); PG8_STAGE(PG8_SA(1, 0), cA + kstep, RA2, cur.lda); PG8_STAGE(PG8_SB(1, 1), cB + PG8_HS(cur.ldb) + kstep, RB2, cur.ldb);
    PG8_WAIT_V(6); PG8_BAR;
    for (;;) {
        const bool has_next = S.next(ui + 1, nxt);
        const char* nA = has_next ? nxt.A : cA; const char* nB = has_next ? nxt.B : cB;
        const int nt = cur.ntk;
        for (int t = 0; t < nt; t += 2) {
            const bool last = (t == nt - 2);
            const char* a1 = cA + (size_t)(t + 1) * kstep;
            const char* a2 = last ? nA : cA + (size_t)(t + 2) * kstep; const char* b2 = last ? nB : cB + (size_t)(t + 2) * kstep;
            const char* a3 = a2 + kstep; const char* b3 = b2 + kstep;
            const int lda1 = cur.lda, lda2 = (last && has_next) ? nxt.lda : cur.lda, ldb2 = (last && has_next) ? nxt.ldb : cur.ldb, kd1 = cur.kind, kd2 = (last && has_next) ? nxt.kind : cur.kind;
            if (last && has_next) S.a_ready(nxt);
            if constexpr (Epi::RESCALE) { const int ka = cur.kt0 + t; if (cur.kind == 0 && t > 0 && (ka == 8 || ka == 16)) { const int l2 = fresh_lane(); E.rescale(acc, cur, ka >> 3, wr, wc, l2 & 15, l2 >> 4); asm volatile("s_waitcnt vmcnt(0)" ::: "memory"); } }
            PG8_LDB(B0, 0, 0); PG8_LDB(B1, 0, 1); PG8_SCHED; PG8_LDA(At, 0, 0); PG8_STAGE_A(PG8_SA(1, 1), a1 + PG8_HS(lda1), lda1, kd1);
            PG8_WAIT_V(8); PG8_WAIT_L(0); PG8_BAR; PG8_MMA(0, 0, At, B0); PG8_MMA(0, 1, At, B1); PG8_BAR; PG8_SCHED;
            PG8_LDA(At, 0, 1); PG8_STAGE(PG8_SB(0, 0), b2, RB2, ldb2); PG8_STAGE(PG8_SB(0, 1), b2 + PG8_HS(ldb2), RB2, ldb2); PG8_STAGE_A(PG8_SA(0, 0), a2, lda2, kd2);
            PG8_WAIT_V(8); PG8_WAIT_L(0); PG8_BAR; PG8_MMA(1, 0, At, B0); PG8_MMA(1, 1, At, B1); PG8_BAR; PG8_SCHED;
            PG8_LDB(B0, 1, 0); PG8_LDB(B1, 1, 1); PG8_SCHED; PG8_LDA(At, 1, 0); PG8_STAGE_A(PG8_SA(0, 1), a2 + PG8_HS(lda2), lda2, kd2);
            PG8_WAIT_V(8); PG8_WAIT_L(0); PG8_BAR; PG8_MMA(0, 0, At, B0); PG8_MMA(0, 1, At, B1); PG8_BAR; PG8_SCHED;
            PG8_LDA(At, 1, 1); PG8_STAGE(PG8_SB(1, 0), b3, RB2, ldb2); PG8_STAGE(PG8_SB(1, 1), b3 + PG8_HS(ldb2), RB2, ldb2); PG8_STAGE_A(PG8_SA(1, 0), a3, lda2, kd2);
            PG8_WAIT_V(8); PG8_WAIT_L(0); PG8_BAR; PG8_MMA(1, 0, At, B0); PG8_MMA(1, 1, At, B1); PG8_BAR; PG8_SCHED;
        }
        if constexpr (ALIGN_EPI) { if (wr == 0) PG8_BAR; }
        if constexpr (FP8) asm volatile("s_nop 15\n\ts_nop 15" ::: "memory");
        if constexpr (Epi::RESCALE) { if (cur.kind == 0) { const int l2 = fresh_lane(); E.finalize(acc, cur, (cur.kt0 + nt - 1) >> 3, wr, wc, l2 & 15, l2 >> 4); } }
        if (cur.mode == 2) sk_store_partial(acc, X, wid);
        else { if (cur.mode != 0) {
#pragma unroll 1
                for (int pq = cur.peer, pe = cur.peer + (cur.mode == 1 ? 1 : cur.mode - 1); pq < pe; ++pq) sk_add_partial(acc, X, pq, wid); }
            const int l2 = fresh_lane(); E(acc, cur, wr, wc, l2 & 15, l2 >> 4); S.done(cur, l2); }
        if (!has_next) break;
#pragma unroll
        for (int a = 0; a < 2; ++a)
#pragma unroll
            for (int b = 0; b < 2; ++b)
#pragma unroll
                for (int m = 0; m < 4; ++m)
#pragma unroll
                    for (int n = 0; n < 2; ++n) acc[a][b][m][n] = (f32x4){0.f, 0.f, 0.f, 0.f};
        cur = nxt; cA = nA; cB = nB; ++ui;
        if constexpr (ALIGN_EPI) { if (wr == 1) PG8_BAR; }
    }
    PG8_WAIT_V(0);
    if constexpr (!ALIGN_EPI) { if (wr == 0) PG8_BAR; }
    PG8_BAR;
#undef PG8_SA
#undef PG8_SB
#undef PG8_STAGE
#undef PG8_HS
#undef PG8_STAGE_A
#undef PG8_LDA
#undef PG8_LDB
#undef PG8_MMA
#undef PG8_WAIT_V
#undef PG8_WAIT_L
#undef PG8_BAR
#undef PG8_SCHED
}

__device__ __forceinline__ u32x4 pack8(const f32x4& a, const f32x4& b) { u32x4 w; w.x = cvt_pk_bf16(a[0], a[1]); w.y = cvt_pk_bf16(a[2], a[3]); w.z = cvt_pk_bf16(b[0], b[1]); w.w = cvt_pk_bf16(b[2], b[3]); return w; }
__device__ __forceinline__ void unpack8(const u32x4& w, f32x4& a, f32x4& b) { a = (f32x4){bflo(w.x), bfhi(w.x), bflo(w.y), bfhi(w.y)}; b = (f32x4){bflo(w.z), bfhi(w.z), bflo(w.w), bfhi(w.w)}; }

struct EpiInProj {
    static constexpr bool PERM = true, RESCALE = false;
    bf16_t* P; bf16_t* G; const float* qn; const float* kn; const float* bgate; const float* rope; float isc;
    __device__ __forceinline__ void operator()(const f32x4 (&acc)[2][2][4][2], const Unit& u, int wr, int wc, int fr, int fq) const {
        const int T = u.pn, jt = u.pm % 17; const bool lat = (jt != 0);
        const int row0 = u.pm * BM + wr * 64 + fr;
        if (T >= 12) {
            const int c0 = (T - 12) * 256 + wc * 32 + 8 * fq;
            f32x4 bv[2][2];
#pragma unroll
            for (int bj = 0; bj < 2; ++bj)
#pragma unroll
                for (int n = 0; n < 2; ++n) bv[bj][n] = *(const f32x4*)(bgate + c0 + bj * HALF + 4 * n) * -LOG2E;
            const float ke = -isc * LOG2E;
            unsigned char* G8 = (unsigned char*)G + (T - 12) * 256 + wc * 64 + fq * 16;
#pragma unroll
            for (int ai = 0; ai < 2; ++ai)
#pragma unroll
                for (int m = 0; m < 4; ++m) { u32x4 w;
#pragma unroll
                    for (int bj = 0; bj < 2; ++bj)
#pragma unroll
                        for (int n = 0; n < 2; ++n) { const f32x4 z = acc[ai][bj][m][n] * ke + bv[bj][n]; unsigned d = 0;
#pragma unroll
                            for (int x = 0; x < 4; ++x) d |= (unsigned)(255.999f * __builtin_amdgcn_rcpf(1.0f + __builtin_amdgcn_exp2f(z[x]))) << (8 * x);
                            w[2 * bj + n] = d; }
                    *(u32x4*)(G8 + (size_t)(row0 + ai * HALF + m * 16) * PC) = w; }
            return;
        }
        if (T >= 5 && T <= 8) {
            const int c0 = T * 256 + wc * 32 + 8 * fq; const bool sl = (T >= 7);
#pragma unroll
            for (int ai = 0; ai < 2; ++ai)
#pragma unroll
                for (int m = 0; m < 4; ++m) { bf16_t* rowp = P + (size_t)(row0 + ai * HALF + m * 16) * PC + c0;
#pragma unroll
                    for (int bj = 0; bj < 2; ++bj) { f32x4 v0 = acc[ai][bj][m][0] * isc, v1 = acc[ai][bj][m][1] * isc;
                        if (sl) {
#pragma unroll
                            for (int x = 0; x < 4; ++x) { v0[x] = siluf_(v0[x]); v1[x] = siluf_(v1[x]); } }
                        const u32x4 w = pack8(v0, v1);
                        if (T <= 6) asm volatile("global_store_dwordx4 %0, %1, off sc1\n\ts_nop 1" :: "v"(rowp + bj * HALF), "v"(w) : "memory");
                        else *(u32x4*)(rowp + bj * HALF) = w; } }
            return;
        }
        const bool isv = ((T == 2 || T == 11) && wc >= 2);
        const bool donorm = (T <= 1) || (T == 2 && wc < 2);
        const bool dorope = lat && !isv;
        const float scale = (T <= 1 || T == 9 || T == 10) ? C2 : (T == 3 ? 0.125f : 1.0f);
        const float* gain = (T <= 1) ? qn : kn;
        f32x4 g1[2], g2[2];
        if (donorm) {
#pragma unroll
            for (int n = 0; n < 2; ++n) { g1[n] = *(const f32x4*)(gain + 8 * fq + 4 * n); g2[n] = *(const f32x4*)(gain + 32 + 8 * fq + 4 * n); }
        }
        const int cbase = T * 256 + 64 * wc + 8 * fq;
#pragma unroll
        for (int ai = 0; ai < 2; ++ai)
#pragma unroll
            for (int m = 0; m < 4; ++m) {
                f32x4 t1[2], t2[2];
#pragma unroll
                for (int n = 0; n < 2; ++n) { t1[n] = acc[ai][0][m][n] * isc; t2[n] = acc[ai][1][m][n] * isc; }
                if (donorm) {
                    float ss = 0.f;
#pragma unroll
                    for (int n = 0; n < 2; ++n)
#pragma unroll
                        for (int x = 0; x < 4; ++x) ss += t1[n][x] * t1[n][x] + t2[n][x] * t2[n][x];
                    ss += swz_xor<16>(ss); ss = xor32_sum(ss);
                    const float inv = rsqrtf(ss * (1.0f / 64.0f) + EPS);
#pragma unroll
                    for (int n = 0; n < 2; ++n) { t1[n] = t1[n] * inv * g1[n]; t2[n] = t2[n] * inv * g2[n]; }
                }
                if (dorope) {
                    const int grow = 4 * (jt - 1) + 2 * ai + wr, gcol = 16 * m + fr;
                    const int pos = (fq < 2) ? grow : gcol;
                    const float* rp = rope + ((size_t)pos * 16 + 8 * (fq & 1)) * 2;
#pragma unroll
                    for (int n = 0; n < 2; ++n) {
                        const f32x4 cs0 = *(const f32x4*)(rp + 8 * n), cs1 = *(const f32x4*)(rp + 8 * n + 4);
                        const f32x4 c = (f32x4){cs0[0], cs0[2], cs1[0], cs1[2]}, s = (f32x4){cs0[1], cs0[3], cs1[1], cs1[3]};
                        const f32x4 a = t1[n], b = t2[n];
                        t1[n] = a * c - b * s; t2[n] = a * s + b * c;
                    }
                }
#pragma unroll
                for (int n = 0; n < 2; ++n) { t1[n] = t1[n] * scale; t2[n] = t2[n] * scale; }
                bf16_t* rowp = P + (size_t)(row0 + ai * HALF + m * 16) * PC + cbase;
                const u32x4 w1 = pack8(t1[0], t1[1]), w2 = pack8(t2[0], t2[1]);
                if (T == 4) { asm volatile("global_store_dwordx4 %0, %1, off sc1\n\ts_nop 1" :: "v"(rowp), "v"(w1) : "memory"); asm volatile("global_store_dwordx4 %0, %1, off sc1\n\ts_nop 1" :: "v"(rowp + 32), "v"(w2) : "memory"); }
                else { *(u32x4*)(rowp) = w1; *(u32x4*)(rowp + 32) = w2; }
            }
    }
};

struct EpiBranch {
    static constexpr bool PERM = true, RESCALE = true;
    const bf16_t* G; bf16_t* MB;
    static __device__ __forceinline__ f32x4 dec4(unsigned w) { return (f32x4){(float)(w & 0xffu) + 0.5f, (float)((w >> 8) & 0xffu) + 0.5f, (float)((w >> 16) & 0xffu) + 0.5f, (float)(w >> 24) + 0.5f}; }
    __device__ __forceinline__ void rescale(f32x4 (&acc)[2][2][4][2], const Unit& u, int bnd, int wr, int wc, int fr, int fq) const {
        const int row0 = u.pm * BM + wr * 64 + fr; const unsigned char* gb = (const unsigned char*)G + (4 * (bnd - 1) + u.pn) * 256 + wc * 64 + fq * 16;
#pragma unroll
        for (int ai = 0; ai < 2; ++ai) {
            u32x4 gp[4], gc[4];
#pragma unroll
            for (int m = 0; m < 4; ++m) { const unsigned char* p = gb + (size_t)(row0 + ai * HALF + m * 16) * PC; gp[m] = *(const u32x4*)p; gc[m] = *(const u32x4*)(p + 1024); }
#pragma unroll
            for (int m = 0; m < 4; ++m)
#pragma unroll
                for (int bj = 0; bj < 2; ++bj)
#pragma unroll
                    for (int n = 0; n < 2; ++n) { const f32x4 a = dec4(gp[m][2 * bj + n]), b = dec4(gc[m][2 * bj + n]);
#pragma unroll
                        for (int x = 0; x < 4; ++x) acc[ai][bj][m][n][x] *= a[x] * __builtin_amdgcn_rcpf(b[x]); }
        }
    }
    __device__ __forceinline__ void finalize(f32x4 (&acc)[2][2][4][2], const Unit& u, int br, int wr, int wc, int fr, int fq) const {
        const int row0 = u.pm * BM + wr * 64 + fr; const unsigned char* gb = (const unsigned char*)G + (4 * br + u.pn) * 256 + wc * 64 + fq * 16;
#pragma unroll
        for (int ai = 0; ai < 2; ++ai) {
            u32x4 g2[4];
#pragma unroll
            for (int m = 0; m < 4; ++m) g2[m] = *(const u32x4*)(gb + (size_t)(row0 + ai * HALF + m * 16) * PC);
#pragma unroll
            for (int m = 0; m < 4; ++m)
#pragma unroll
                for (int bj = 0; bj < 2; ++bj)
#pragma unroll
                    for (int n = 0; n < 2; ++n) acc[ai][bj][m][n] = acc[ai][bj][m][n] * (dec4(g2[m][2 * bj + n]) * (1.0f / 256.0f));
        }
    }
    __device__ __forceinline__ void operator()(const f32x4 (&acc)[2][2][4][2], const Unit& u, int wr, int wc, int fr, int fq) const {
        const int row0 = u.pm * BM + wr * 64 + fr, c0 = u.pn * BM + wc * 32 + 8 * fq;
#pragma unroll
        for (int ai = 0; ai < 2; ++ai)
#pragma unroll
            for (int m = 0; m < 4; ++m)
#pragma unroll
                for (int bj = 0; bj < 2; ++bj) { const u32x4 w = pack8(acc[ai][bj][m][0], acc[ai][bj][m][1]); asm volatile("global_store_dwordx4 %0, %1, off sc1\n\ts_nop 1" :: "v"(MB + (size_t)(row0 + ai * HALF + m * 16) * D + c0 + bj * HALF), "v"(w) : "memory"); }
    }
};

struct EpiResid {
    static constexpr bool PERM = true, RESCALE = false;
    bf16_t* XS; const float* gate;
    __device__ __forceinline__ void operator()(const f32x4 (&acc)[2][2][4][2], const Unit& u, int wr, int wc, int fr, int fq) const {
        const int who = (u.pm % 17 == 0) ? 4 : (u.pm / 17);
        const float* gp = gate + (size_t)who * INC;
        const int row0 = u.pm * BM + wr * 64 + fr, c0 = u.pn * BM + wc * 32 + 8 * fq;
        f32x4 gv[2][2];
#pragma unroll
        for (int bj = 0; bj < 2; ++bj)
#pragma unroll
            for (int n = 0; n < 2; ++n) gv[bj][n] = *(const f32x4*)(gp + c0 + bj * HALF + n * 4);
#pragma unroll
        for (int ai = 0; ai < 2; ++ai) {
            u32x4 old[4][2];
#pragma unroll
            for (int m = 0; m < 4; ++m)
#pragma unroll
                for (int bj = 0; bj < 2; ++bj) old[m][bj] = *(const u32x4*)(XS + (size_t)(row0 + ai * HALF + m * 16) * D + c0 + bj * HALF);
#pragma unroll
            for (int m = 0; m < 4; ++m)
#pragma unroll
                for (int bj = 0; bj < 2; ++bj) { f32x4 oa, ob; unpack8(old[m][bj], oa, ob);
                    *(u32x4*)(XS + (size_t)(row0 + ai * HALF + m * 16) * D + c0 + bj * HALF) = pack8(oa + gv[bj][0] * acc[ai][bj][m][0], ob + gv[bj][1] * acc[ai][bj][m][1]); }
            asm volatile("" ::: "memory");
        }
    }
};

struct EpiSwiGLU {
    static constexpr bool PERM = true, RESCALE = false;
    bf16_t* H; int ldh;
    __device__ __forceinline__ void operator()(const f32x4 (&acc)[2][2][4][2], const Unit& u, int wr, int wc, int fr, int fq) const {
        const int row0 = u.pm * BM + wr * 64 + fr, c0 = u.pn * HALF + wc * 32 + 8 * fq;
#pragma unroll
        for (int ai = 0; ai < 2; ++ai)
#pragma unroll
            for (int m = 0; m < 4; ++m) { f32x4 v[2];
#pragma unroll
                for (int n = 0; n < 2; ++n)
#pragma unroll
                    for (int x = 0; x < 4; ++x) v[n][x] = siluf_(acc[ai][0][m][n][x]) * acc[ai][1][m][n][x];
                *(u32x4*)(H + (size_t)(row0 + ai * HALF + m * 16) * ldh + c0) = pack8(v[0], v[1]); }
    }
};

struct EpiSwiGLU8 {
    static constexpr bool PERM = true, RESCALE = false;
    unsigned char* H; int ldh; float isc, osc;
    __device__ __forceinline__ void operator()(const f32x4 (&acc)[2][2][4][2], const Unit& u, int wr, int wc, int fr, int fq) const {
        const int row0 = u.pm * BM + wr * 64 + fr, c0 = u.pn * HALF + wc * 32 + 8 * fq;
        const float ke = -isc * LOG2E, kk = isc * isc * osc;
#pragma unroll
        for (int ai = 0; ai < 2; ++ai)
#pragma unroll
            for (int m = 0; m < 4; ++m) { f32x4 v[2];
#pragma unroll
                for (int n = 0; n < 2; ++n)
#pragma unroll
                    for (int x = 0; x < 4; ++x) { const float a = acc[ai][0][m][n][x];
                        v[n][x] = (a * acc[ai][1][m][n][x]) * (kk * __builtin_amdgcn_rcpf(1.0f + __builtin_amdgcn_exp2f(a * ke))); }
                u32x2 w; w.x = pk4_fp8(v[0][0], v[0][1], v[0][2], v[0][3]); w.y = pk4_fp8(v[1][0], v[1][1], v[1][2], v[1][3]);
                *(u32x2*)(H + (size_t)(row0 + ai * HALF + m * 16) * ldh + c0) = w; }
    }
};

struct EpiMoEDown {
    static constexpr bool PERM = true, RESCALE = false;
    bf16_t* Y; const float* cw; float sc;
    __device__ __forceinline__ void operator()(const f32x4 (&acc)[2][2][4][2], const Unit& u, int wr, int wc, int fr, int fq) const {
        const int row0 = u.pm * BM + wr * 64 + fr, c0 = u.pn * BM + wc * 32 + 8 * fq;
#pragma unroll
        for (int ai = 0; ai < 2; ++ai)
#pragma unroll
            for (int m = 0; m < 4; ++m) { const int row = row0 + ai * HALF + m * 16; const float w = cw[row] * sc;
#pragma unroll
                for (int bj = 0; bj < 2; ++bj) *(u32x4*)(Y + (size_t)row * D + c0 + bj * HALF) = pack8(acc[ai][bj][m][0] * w, acc[ai][bj][m][1] * w); }
    }
};
template <class E0, class E1> struct EpiDual {
    static constexpr bool PERM = true, RESCALE = E0::RESCALE; static_assert(E0::PERM && E1::PERM, "dual phases stage B rows permuted for both kinds");
    E0 e0; E1 e1;
    __device__ __forceinline__ void rescale(f32x4 (&acc)[2][2][4][2], const Unit& u, int bnd, int wr, int wc, int fr, int fq) const { e0.rescale(acc, u, bnd, wr, wc, fr, fq); }
    __device__ __forceinline__ void finalize(f32x4 (&acc)[2][2][4][2], const Unit& u, int br, int wr, int wc, int fr, int fq) const { e0.finalize(acc, u, br, wr, wc, fr, fq); }
    __device__ __forceinline__ void operator()(const f32x4 (&acc)[2][2][4][2], const Unit& u, int wr, int wc, int fr, int fq) const { if (u.kind == 0) e0(acc, u, wr, wc, fr, fq); else e1(acc, u, wr, wc, fr, fq); }
};
}
namespace attn_body {
using bf16=unsigned short;
constexpr int D=64, QKP=3072  , OPITCH=1536  ;
constexpr int NW=8,QBLK=32,QB=QBLK*NW,KVBLK=64;
__device__ __forceinline__ int crow(int r,int hi){return (r&3)+8*(r>>2)+4*hi;}
#define SBAR() __builtin_amdgcn_sched_barrier(0)
__device__ __forceinline__ void wmask(f32x16&p0,f32x16&p1,int t,int qrel,int hi,int qoff){
  const float NEG=-INFINITY; const unsigned base=(unsigned)(64*(t-4)+4*hi-qrel-qoff+128);
  #pragma unroll
  for(int r=0;r<16;++r){const unsigned u=base+(unsigned)((r&3)+8*(r>>2)); if(u>256u)p0[r]=NEG; if(u+32u>256u)p1[r]=NEG;}
}

constexpr int NSLOT=3, SLOTB=8192;
constexpr int LDS_K=0, LDS_V=NSLOT*SLOTB, LDS_WS=2*NSLOT*SLOTB, LDS_OST=LDS_WS+NW*64*4, LDS_BYTES=LDS_OST+NW*4096;
__device__ __forceinline__ void glds16(const void*gsrc,unsigned lds_dst){unsigned keep;
  asm volatile("s_mov_b32 %0, m0\n\ts_mov_b32 m0, %2\n\ts_nop 0\n\tglobal_load_lds_dwordx4 %1, off\n\ts_mov_b32 m0, %0":"=&s"(keep):"v"(gsrc),"s"(lds_dst):"memory");}
__device__ __forceinline__ float max3f(float a,float b,float c){float r;asm("v_max3_f32 %0, %1, %2, %3":"=v"(r):"v"(a),"v"(b),"v"(c));return r;}
__device__ __forceinline__ float max2f(float a,float b){float r;asm("v_max_f32_e32 %0, %1, %2":"=v"(r):"v"(a),"v"(b));return r;}
__device__ __forceinline__ float fadd_s(float a,float b){float r;asm("v_add_f32_e32 %0, %1, %2":"=v"(r):"v"(a),"v"(b));return r;}
__device__ __forceinline__ float fsub_s(float a,float b){float r;asm("v_sub_f32_e32 %0, %1, %2":"=v"(r):"v"(a),"v"(b));return r;}
typedef float f32x2_t __attribute__((ext_vector_type(2))); typedef __bf16 bf16x2_t __attribute__((ext_vector_type(2)));
__device__ __forceinline__ unsigned cvtpk_s(float lo,float hi){f32x2_t v={lo,hi};bf16x2_t b=__builtin_convertvector(v,bf16x2_t);return __builtin_bit_cast(unsigned,b);}
#define WAIT_BAR(N) asm volatile("s_waitcnt vmcnt(" #N ") lgkmcnt(0)\n\ts_barrier":::"memory")

__device__ __forceinline__ void qkt(f32x16&p0,f32x16&p1,const char*Kslot,const bf16x8*qr,const f32x16&negm,int r32,int hi){
  const char*kb=Kslot+hi*1024+r32*16;
  #pragma unroll
  for(int d0=0;d0<4;++d0){
    const bf16x8 b0=*reinterpret_cast<const bf16x8*>(kb+d0*2048);
    const bf16x8 b1=*reinterpret_cast<const bf16x8*>(kb+d0*2048+512);
    if(d0==0){p0=__builtin_amdgcn_mfma_f32_32x32x16_bf16(b0,qr[0],negm,0,0,0);p1=__builtin_amdgcn_mfma_f32_32x32x16_bf16(b1,qr[0],negm,0,0,0);}
    else{p0=__builtin_amdgcn_mfma_f32_32x32x16_bf16(b0,qr[d0],p0,0,0,0);p1=__builtin_amdgcn_mfma_f32_32x32x16_bf16(b1,qr[d0],p1,0,0,0);}}
}
typedef __attribute__((address_space(3))) const char* lds_cptr;
typedef short v4i16_t __attribute__((ext_vector_type(4)));
__device__ __forceinline__ void kload8(bf16x8*kf,lds_cptr kp){
  kf[0]=*(const __attribute__((address_space(3))) bf16x8*)(kp);      kf[1]=*(const __attribute__((address_space(3))) bf16x8*)(kp+512);
  kf[2]=*(const __attribute__((address_space(3))) bf16x8*)(kp+2048); kf[3]=*(const __attribute__((address_space(3))) bf16x8*)(kp+2560);
  kf[4]=*(const __attribute__((address_space(3))) bf16x8*)(kp+4096); kf[5]=*(const __attribute__((address_space(3))) bf16x8*)(kp+4608);
  kf[6]=*(const __attribute__((address_space(3))) bf16x8*)(kp+6144); kf[7]=*(const __attribute__((address_space(3))) bf16x8*)(kp+6656);
}
__device__ __forceinline__ void kload2(bf16x8*kf,lds_cptr kp,int j){ kf[2*j]=*(const __attribute__((address_space(3))) bf16x8*)(kp+j*2048); kf[2*j+1]=*(const __attribute__((address_space(3))) bf16x8*)(kp+j*2048+512); }
__device__ __forceinline__ s16x4 vtr(lds_cptr p){ return __builtin_bit_cast(s16x4,__builtin_amdgcn_ds_read_tr16_b64_v4i16((__attribute__((address_space(3))) v4i16_t*)p)); }
__device__ __forceinline__ float rowmax(const f32x16&p0,const f32x16&p1){
  float a=max3f(p0[0],p0[1],p1[0]),b=max3f(p0[2],p0[3],p1[1]);a=max3f(a,p1[2],p1[3]);
  #pragma unroll
  for(int r=4;r<16;r+=4){a=max3f(a,p0[r],p0[r+1]);b=max3f(b,p0[r+2],p0[r+3]);a=max3f(a,p1[r],p1[r+1]);b=max3f(b,p1[r+2],p1[r+3]);}
  const float m=max2f(a,b);
  auto rr=__builtin_amdgcn_permlane32_swap(__float_as_uint(m),__float_as_uint(m),false,false);
  return max2f(__uint_as_float(rr[0]),__uint_as_float(rr[1]));
}
__device__ __forceinline__ void pv(f32x16*o,int vb,bf16x8 pa0,bf16x8 pa1,bf16x8 pa2,bf16x8 pa3){
  #pragma unroll
  for(int d0=0;d0<2;++d0){s16x4 lo[4],hi[4];
    #pragma unroll
    for(int ks=0;ks<4;++ks){
      asm volatile("ds_read_b64_tr_b16 %0,%1 offset:%c2":"=&v"(lo[ks]):"v"(vb),"i"(d0*4096+ks*1024):"memory");
      asm volatile("ds_read_b64_tr_b16 %0,%1 offset:%c2":"=&v"(hi[ks]):"v"(vb),"i"(d0*4096+ks*1024+512):"memory");}
    asm volatile("s_waitcnt lgkmcnt(0)":::"memory");SBAR();
    #define PK(k) (bf16x8){lo[k][0],lo[k][1],lo[k][2],lo[k][3],hi[k][0],hi[k][1],hi[k][2],hi[k][3]}
    o[d0]=__builtin_amdgcn_mfma_f32_32x32x16_bf16(pa0,PK(0),o[d0],0,0,0);
    o[d0]=__builtin_amdgcn_mfma_f32_32x32x16_bf16(pa1,PK(1),o[d0],0,0,0);
    o[d0]=__builtin_amdgcn_mfma_f32_32x32x16_bf16(pa2,PK(2),o[d0],0,0,0);
    o[d0]=__builtin_amdgcn_mfma_f32_32x32x16_bf16(pa3,PK(3),o[d0],0,0,0);
    #undef PK
  }
}

#ifndef ATTN_STORE16
#define ATTN_STORE16(p,v) (*(u32x4*)(p)=(v))
#endif
template<int THRL,int MODE> __device__ __forceinline__ void attn_unit(const bf16*Qu,const bf16*__restrict__ Kh,const bf16*__restrict__ Vh,bf16*Ou,const int NT,const int kgap,const int qoff,const float sink2,char*shm,const int tid){
  const int lane=tid&63,r32=lane&31,hi=lane>>5; const int wid=__builtin_amdgcn_readfirstlane(tid>>6);
  const bf16*Qw=Qu+(long)(wid*QBLK)*QKP;
  const unsigned lds0=(unsigned)(uintptr_t)shm;
  float*wsf=(float*)(shm+LDS_WS)+wid*64;
  const bf16*ksrc=Kh+(long)lane*QKP+wid*8;
  const bf16*vsrc=Vh+(long)(16*(wid&3)+(lane>>2))*QKP+(wid>>2)*32+(lane&3)*8;
  const unsigned kdst=lds0+LDS_K+wid*1024, vdst=lds0+LDS_V+wid*1024;
  #define ROWOFF(t) ((long)((t)*KVBLK+(((t)>=4)?kgap:0))*QKP)
  #define DMA_K(t,slot) glds16(ksrc+ROWOFF(t),(unsigned)__builtin_amdgcn_readfirstlane(kdst+(slot)))
  #define DMA_V(t,slot) glds16(vsrc+ROWOFF(t),(unsigned)__builtin_amdgcn_readfirstlane(vdst+(slot)))
  const int vb0=(int)(lds0+LDS_V)+((lane>>4)&1)*32+(lane&3)*8+(4*hi+((lane&15)>>2))*64;
  const char*Kbase=shm+LDS_K; bf16x8 kf[8];
  const lds_cptr shm3=(lds_cptr)shm; const lds_cptr kp0=shm3+LDS_K+hi*1024+r32*16; const lds_cptr vp0=shm3+LDS_V+((lane>>4)&1)*32+(lane&3)*8+(4*hi+((lane&15)>>2))*64;
  DMA_K(0,0);DMA_V(0,0);DMA_K(1,SLOTB);
  bf16x8 qr[4];
  #pragma unroll
  for(int d0=0;d0<4;++d0)qr[d0]=*reinterpret_cast<const bf16x8*>(&Qw[(long)r32*QKP+d0*16+hi*8]);
  float mhat=0.f,l_reg=0.f;f32x16 o[2];o[0]=f32x16{};o[1]=f32x16{};f32x16 negm=f32x16{};asm volatile("":"+v"(negm));
  const int qrel=wid*QBLK+r32;
  #define CMASK(P0,P1,t) do{ if(MODE==1&&(t)>=4)wmask(P0,P1,(t),qrel,hi,qoff); }while(0)
  bool resc=false;
  #define START(P0,P1) do{ const float rm=rowmax(P0,P1); resc=false; \
    { const float dl=rm; mhat=fadd_s(mhat,dl); \
      _Pragma("unroll") for(int r=0;r<16;++r){P0[r]=fsub_s(P0[r],dl);P1[r]=fsub_s(P1[r],dl);} \
      _Pragma("unroll") for(int r=0;r<16;++r)negm[r]=-mhat; asm volatile("":"+v"(negm)); } \
    _Pragma("unroll") for(int r=0;r<16;++r)P0[r]=__builtin_amdgcn_exp2f(P0[r]); }while(0)
  #define RESC() do{ if(resc){ asm volatile("s_waitcnt lgkmcnt(0)":::"memory"); \
      _Pragma("unroll") for(int d_=0;d_<2;++d_) _Pragma("unroll") for(int r=0;r<16;++r)o[d_][r]*=wsf[crow(r,hi)]; } }while(0)
  f32x16 pA0,pA1,pB0,pB1;
  int sl_prev=0,sl_cur=0,sl_next=SLOTB;
  #define ROT() do{sl_prev=sl_cur;sl_cur=sl_next;sl_next=(sl_next==(NSLOT-1)*SLOTB)?0:sl_next+SLOTB;}while(0)
  DMA_K(2,2*SLOTB);
  WAIT_BAR(3);
  qkt(pA0,pA1,Kbase,qr,negm,r32,hi);asm volatile("s_nop 15\n\ts_nop 7":"+v"(pA0),"+v"(pA1));CMASK(pA0,pA1,0);
  START(pA0,pA1);
  _Pragma("unroll") for(int r=0;r<16;++r)pA1[r]=__builtin_amdgcn_exp2f(pA1[r]);
  WAIT_BAR(0);
  DMA_K(3,0);DMA_V(1,SLOTB);
  ROT();
  kload8(kf,kp0+sl_cur);
  WAIT_BAR(2);
  s16x4 vlo[8],vhi[8]; u32x4 pw0,pw1,pw2,pw3;
  #define PKW(P,B) cvtpk_s(P[B],P[B+1])
  #define PAF(k) __builtin_bit_cast(bf16x8,pw##k)
  #define VFR(i) (bf16x8){vlo[i][0],vlo[i][1],vlo[i][2],vlo[i][3],vhi[i][0],vhi[i][1],vhi[i][2],vhi[i][3]}
  #define PIN(x) asm volatile("":"+v"(x))
  #define MX3(a,b,c) __builtin_fmaxf(__builtin_fmaxf((a),(b)),(c))
  #define GAPA(MF,A0,A1,A2,A3,W0,W1,PW) do{ MF; sacc+=A0; sacc+=A1; sacc+=A2; sacc+=A3; PIN(sacc); W0; W1; PIN(PW); SBAR(); }while(0)
  #define EX(v) __builtin_amdgcn_exp2f(v)
  #define GAPB(MF,X,B) do{ MF; X[B]=EX(X[B]); X[B+1]=EX(X[B+1]); X[B+2]=EX(X[B+2]); X[B+3]=EX(X[B+3]); PIN(X); SBAR(); }while(0)
  #define VRD(i) do{ vlo[i]=vtr(vp_+(((i)>>2)*4096+((i)&3)*1024)); vhi[i]=vtr(vp_+(((i)>>2)*4096+((i)&3)*1024+512)); }while(0)
  #define KRD(G,j) do{ if(G){ kload2(kf,kp0+sl_next,j); SBAR(); } }while(0)
  #define STEP(C0,C1,P0,P1,t,GK,GV,GL) do{ SBAR(); \
    const lds_cptr vp_=vp0+sl_prev; \
    VRD(0); SBAR(); float sacc=(P0[0]+P0[1]); \
    GAPA(C0=__builtin_amdgcn_mfma_f32_32x32x16_bf16(kf[0],qr[0],negm,0,0,0), P0[2],P0[3],P0[4],P0[5],     pw0[0]=PKW(P0,0), pw0[1]=PKW(P0,2), pw0); \
    VRD(4); SBAR(); GAPA(C1=__builtin_amdgcn_mfma_f32_32x32x16_bf16(kf[1],qr[0],negm,0,0,0), P0[6],P0[7],P0[8],P0[9],     pw0[2]=PKW(P0,4), pw0[3]=PKW(P0,6), pw0); \
    VRD(1); SBAR(); GAPA(C0=__builtin_amdgcn_mfma_f32_32x32x16_bf16(kf[2],qr[1],C0,0,0,0),   P0[10],P0[11],P0[12],P0[13], pw1[0]=PKW(P0,8), pw1[1]=PKW(P0,10), pw1); \
    VRD(5); SBAR(); GAPA(C1=__builtin_amdgcn_mfma_f32_32x32x16_bf16(kf[3],qr[1],C1,0,0,0),   P0[14],P0[15],P1[0],P1[1],   pw1[2]=PKW(P0,12),pw1[3]=PKW(P0,14), pw1); \
    VRD(2); SBAR(); GAPA(C0=__builtin_amdgcn_mfma_f32_32x32x16_bf16(kf[4],qr[2],C0,0,0,0),   P1[2],P1[3],P1[4],P1[5],     pw2[0]=PKW(P1,0), pw2[1]=PKW(P1,2), pw2); \
    VRD(6); SBAR(); GAPA(C1=__builtin_amdgcn_mfma_f32_32x32x16_bf16(kf[5],qr[2],C1,0,0,0),   P1[6],P1[7],P1[8],P1[9],     pw2[2]=PKW(P1,4), pw2[3]=PKW(P1,6), pw2); \
    VRD(3); SBAR(); GAPA(C0=__builtin_amdgcn_mfma_f32_32x32x16_bf16(kf[6],qr[3],C0,0,0,0),   P1[10],P1[11],P1[12],P1[13], pw3[0]=PKW(P1,8), pw3[1]=PKW(P1,10), pw3); \
    VRD(7); SBAR(); GAPA(C1=__builtin_amdgcn_mfma_f32_32x32x16_bf16(kf[7],qr[3],C1,0,0,0),   P1[14],P1[15],0.f,0.f,       pw3[2]=PKW(P1,12),pw3[3]=PKW(P1,14), pw3); \
    l_reg+=sacc; \
    if(GK){DMA_K((t)+3,sl_cur);} if(GV){DMA_V((t)+1,sl_next);} \
    CMASK(C0,C1,t); \
    { float a=MX3(C0[0],C0[1],C1[0]),b=MX3(C0[2],C0[3],C1[1]); a=MX3(a,C1[2],C1[3]); \
      _Pragma("unroll") for(int r=4;r<16;r+=4){a=MX3(a,C0[r],C0[r+1]);b=MX3(b,C0[r+2],C0[r+3]);a=MX3(a,C1[r],C1[r+1]);b=MX3(b,C1[r+2],C1[r+3]);} \
      float rm=__builtin_fmaxf(a,b); { auto rr=__builtin_amdgcn_permlane32_swap(__float_as_uint(rm),__float_as_uint(rm),false,false); rm=__builtin_fmaxf(__uint_as_float(rr[0]),__uint_as_float(rr[1])); } \
      resc=false; \
      if(__builtin_expect(__any(rm>(float)THRL),0)){ const float dl=__builtin_fmaxf(rm,0.f); mhat+=dl; \
        _Pragma("unroll") for(int r=0;r<16;++r){C0[r]-=dl;C1[r]-=dl;} \
        _Pragma("unroll") for(int r=0;r<16;++r)negm[r]=-mhat; asm volatile("":"+v"(negm)); \
        const float f=__builtin_amdgcn_exp2f(-dl); l_reg*=f; if(hi==0)wsf[r32]=f; resc=true; } } \
    SBAR(); \
    GAPB(o[0]=__builtin_amdgcn_mfma_f32_32x32x16_bf16(PAF(0),VFR(0),o[0],0,0,0), C0,0); \
    GAPB(o[1]=__builtin_amdgcn_mfma_f32_32x32x16_bf16(PAF(0),VFR(4),o[1],0,0,0), C0,4); \
    KRD(GL,0); GAPB(o[0]=__builtin_amdgcn_mfma_f32_32x32x16_bf16(PAF(1),VFR(1),o[0],0,0,0), C0,8); \
    KRD(GL,1); GAPB(o[1]=__builtin_amdgcn_mfma_f32_32x32x16_bf16(PAF(1),VFR(5),o[1],0,0,0), C0,12); \
    KRD(GL,2); GAPB(o[0]=__builtin_amdgcn_mfma_f32_32x32x16_bf16(PAF(2),VFR(2),o[0],0,0,0), C1,0); \
    KRD(GL,3); GAPB(o[1]=__builtin_amdgcn_mfma_f32_32x32x16_bf16(PAF(2),VFR(6),o[1],0,0,0), C1,4); \
    GAPB(o[0]=__builtin_amdgcn_mfma_f32_32x32x16_bf16(PAF(3),VFR(3),o[0],0,0,0), C1,8); \
    GAPB(o[1]=__builtin_amdgcn_mfma_f32_32x32x16_bf16(PAF(3),VFR(7),o[1],0,0,0), C1,12); \
    }while(0)
  int t=1;
  for(;t+5<NT;t+=2){
    STEP(pB0,pB1,pA0,pA1,t,true,true,true);     WAIT_BAR(2); RESC(); ROT();
    STEP(pA0,pA1,pB0,pB1,t+1,true,true,true);   WAIT_BAR(2); RESC(); ROT();
  }
  #define ENDW(tt) do{ if((tt)+3<NT){WAIT_BAR(2);} else if((tt)+2<NT){WAIT_BAR(1);} else {WAIT_BAR(0);} }while(0)
  for(;t+1<NT;t+=2){
    STEP(pB0,pB1,pA0,pA1,t,(t+3<NT),(t+1<NT),(t+1<NT));       ENDW(t);   RESC(); ROT();
    STEP(pA0,pA1,pB0,pB1,t+1,(t+4<NT),(t+2<NT),(t+2<NT));     ENDW(t+1); RESC(); ROT();
  }
  STEP(pB0,pB1,pA0,pA1,NT-1,false,false,false); RESC();
  { float sacc=pB0[0]+pB0[1]; _Pragma("unroll") for(int r=2;r<16;++r)sacc+=pB0[r]; _Pragma("unroll") for(int r=0;r<16;++r)sacc+=pB1[r]; l_reg+=sacc;
    pw0=(u32x4){PKW(pB0,0),PKW(pB0,2),PKW(pB0,4),PKW(pB0,6)};pw1=(u32x4){PKW(pB0,8),PKW(pB0,10),PKW(pB0,12),PKW(pB0,14)};pw2=(u32x4){PKW(pB1,0),PKW(pB1,2),PKW(pB1,4),PKW(pB1,6)};pw3=(u32x4){PKW(pB1,8),PKW(pB1,10),PKW(pB1,12),PKW(pB1,14)};
    SBAR(); pv(o,vb0+sl_cur,PAF(0),PAF(1),PAF(2),PAF(3)); }
  #undef PKW
  #undef PAF
  #undef VFR
  #undef PIN
  #undef MX3
  #undef GAPA
  #undef GAPB
  #undef EX
  #undef VRD
  #undef KRD
  #undef STEP
  #undef ENDW
  {auto rr=__builtin_amdgcn_permlane32_swap(__float_as_uint(l_reg),__float_as_uint(l_reg),false,false);l_reg=__uint_as_float(rr[0])+__uint_as_float(rr[1]);}
  l_reg+=__builtin_amdgcn_exp2f(sink2-mhat);
  if(hi==0)wsf[32+r32]=l_reg;asm volatile("s_waitcnt lgkmcnt(0)":::"memory");
  float rli[16];
  #pragma unroll
  for(int r=0;r<16;++r)rli[r]=__builtin_amdgcn_rcpf(wsf[32+crow(r,hi)]);
  bf16*Ow=Ou+(long)(wid*QBLK)*OPITCH;
  { bf16*stg=(bf16*)(shm+LDS_OST)+wid*2048;
    #pragma unroll
    for(int r=0;r<16;++r){const int orow=crow(r,hi);
      #pragma unroll
      for(int d0=0;d0<2;++d0)stg[orow*64+d0*32+r32]=(bf16)f2bf(o[d0][r]*rli[r]);}
    asm volatile("s_waitcnt lgkmcnt(0)":::"memory");
    #pragma unroll
    for(int i=0;i<4;++i){const int row=i*8+(lane>>3),ch=lane&7; const u32x4 v=*(const u32x4*)(stg+row*64+ch*8); ATTN_STORE16(Ow+(long)row*OPITCH+ch*8,v);} }
  asm volatile("s_waitcnt lgkmcnt(0)\n\ts_barrier":::"memory");
  #undef ROWOFF
  #undef DMA_K
  #undef DMA_V
  #undef CMASK
  #undef START
  #undef RESC
  #undef ROT
}
constexpr int ATTN_LDS_BYTES=LDS_BYTES;
#undef SBAR
#undef WAIT_BAR
}
__device__ __forceinline__ void wait_panel(unsigned* cnt, unsigned* tmo, int pm, int wave_s, unsigned need);
namespace ret {
constexpr int RSV = 136, RSK = 72;
constexpr int NCH = TPB / 128;
typedef short v4i16_t __attribute__((ext_vector_type(4)));
__device__ __forceinline__ s16x4 trd(const LAS char* p) { return __builtin_bit_cast(s16x4, __builtin_amdgcn_ds_read_tr16_b64_v4i16((LAS v4i16_t*)p)); }
#define RET_FRAG(lo, hi) (bf16x8){lo[0], lo[1], lo[2], lo[3], hi[0], hi[1], hi[2], hi[3]}
__device__ __forceinline__ size_t kvs_index(int dir, int b, int cidx, int hd) { return ((((size_t)dir * NB + b) * NCH + cidx) * 4 + hd) * 8192; }

__device__ __forceinline__ void stage_v(const bf16_t* P, int row0, int hd, LAS char* vimg, int tid) {
#pragma unroll
    for (int i = 0; i < 4; ++i) { const int c = tid + 512 * i, j = c >> 4, ch = c & 15;
        const u32x4 v = *(const u32x4*)(P + (size_t)(row0 + j) * PC + 1280 + 128 * hd + 8 * ch);
        *(LAS u32x4*)(vimg + (j * RSV + 8 * ch) * 2) = v; }
}

struct KvLoad { u32x4 kw[2], vv[4]; };
__device__ __forceinline__ void kvinc_load(const bf16_t* P, int u, const int tid, KvLoad& L) {
    const int b = u / (4 * NCH), hd = (u / NCH) & 3, cidx = u % NCH, row0 = b * TPB + 128 * cidx;
#pragma unroll
    for (int i = 0; i < 2; ++i) { const int c = tid + 512 * i, j = c >> 3, ch = c & 7; L.kw[i] = *(const u32x4*)(P + (size_t)(row0 + j) * PC + 1024 + 64 * hd + 8 * ch); }
#pragma unroll
    for (int i = 0; i < 4; ++i) { const int c = tid + 512 * i, j = c >> 4, ch = c & 15; L.vv[i] = *(const u32x4*)(P + (size_t)(row0 + j) * PC + 1280 + 128 * hd + 8 * ch); }
}
__device__ __forceinline__ void kvinc_units(const bf16_t* P, float* KVS, const float* rc, int u0, int ustep, int nU, unsigned* cnt, unsigned* tmo, int wave_s, LAS char* lds, const int tid) {
    const int lane = tid & 63, wid = __builtin_amdgcn_readfirstlane(tid >> 6), r = lane & 31, hh = lane >> 5;
    LAS char* kimg0 = lds; LAS char* kimg1 = lds + 128 * RSK * 2; LAS char* vimg = lds + 2 * 128 * RSK * 2;
    int u = u0; if (u >= nU) return;
    ::wait_panel(cnt, tmo, 17 * (u / (4 * NCH)) + ((u % NCH) >> 1), wave_s, 24u);
    KvLoad L; kvinc_load(P, u, tid, L);
#pragma unroll 1
    for (;;) {
        const int b = u / (4 * NCH), hd = (u / NCH) & 3, cidx = u % NCH;
        const float lgf2 = rc[2 * hd], lgb2 = rc[8 + 2 * hd];
#pragma unroll
        for (int i = 0; i < 2; ++i) { const int c = tid + 512 * i, j = c >> 3, ch = c & 7;
            const float wf = __builtin_amdgcn_exp2f((float)(127 - j) * lgf2), wb = __builtin_amdgcn_exp2f((float)j * lgb2);
            f32x4 a, bq; pg8::unpack8(L.kw[i], a, bq);
            *(LAS u32x4*)(kimg0 + (j * RSK + 8 * ch) * 2) = pg8::pack8(a * wf, bq * wf);
            *(LAS u32x4*)(kimg1 + (j * RSK + 8 * ch) * 2) = pg8::pack8(a * wb, bq * wb); }
#pragma unroll
        for (int i = 0; i < 4; ++i) { const int c = tid + 512 * i, j = c >> 4, ch = c & 15; *(LAS u32x4*)(vimg + (j * RSV + 8 * ch) * 2) = L.vv[i]; }
        LDS_WAIT(); __syncthreads();
        const int un = u + ustep;
        if (un < nU) { ::wait_panel(cnt, tmo, 17 * (un / (4 * NCH)) + ((un % NCH) >> 1), wave_s, 24u); kvinc_load(P, un, tid, L); }
        const int dir = wid >> 2, eb = wid & 3;
        const LAS char* kimg = dir ? kimg1 : kimg0;
        const int q = (lane & 15) >> 2, p = lane & 3, c16 = 16 * ((lane >> 4) & 1) + 4 * p;
        f32x16 acc[2]; acc[0] = f32x16{}; acc[1] = f32x16{};
#pragma unroll
        for (int ks = 0; ks < 8; ++ks) {
            const int j0 = 16 * ks + 8 * hh + q;
            const s16x4 vlo = trd(vimg + (j0 * RSV + 32 * eb + c16) * 2), vhi = trd(vimg + ((j0 + 4) * RSV + 32 * eb + c16) * 2);
            const bf16x8 vf = RET_FRAG(vlo, vhi);
#pragma unroll
            for (int db = 0; db < 2; ++db) {
                const s16x4 klo = trd(kimg + (j0 * RSK + 32 * db + c16) * 2), khi = trd(kimg + ((j0 + 4) * RSK + 32 * db + c16) * 2);
                acc[db] = __builtin_amdgcn_mfma_f32_32x32x16_bf16(RET_FRAG(klo, khi), vf, acc[db], 0, 0, 0);
            }
        }
        float* out = KVS + kvs_index(dir, b, cidx, hd);
#pragma unroll
        for (int db = 0; db < 2; ++db)
#pragma unroll
            for (int reg = 0; reg < 16; ++reg) { const int d = 32 * db + (reg & 3) + 8 * (reg >> 2) + 4 * hh; out[d * 128 + 32 * eb + r] = acc[db][reg]; }
        __syncthreads();
        if (un >= nU) break;
        u = un;
    }
}

__device__ __forceinline__ void scan_phase(const float* KVS, bf16_t* KVB, const float* retc_l, int gtid, int gthreads) {
    for (int idx = gtid; idx < 2 * NB * 4 * 4096; idx += gthreads) {
        const int el = (idx & 4095) * 2, seq = idx >> 12, hd = seq & 3, b = (seq >> 2) & 3, dir = seq >> 4;
        const float dec = retc_l[(dir * 4 + hd) * 2 + 1];
        const size_t off = kvs_index(dir, b, 0, hd) + el;
        f32x2 v[NCH];
#pragma unroll
        for (int n = 0; n < NCH; ++n) { const int cidx = dir == 0 ? n : (n < 2 ? 1 - n : 35 - n); v[n] = *(const f32x2*)(KVS + off + (size_t)cidx * 4 * 8192); }
        f32x2 st = (f32x2){0.f, 0.f};
#pragma unroll
        for (int n = 0; n < NCH; ++n) { const int cidx = dir == 0 ? n : (n < 2 ? 1 - n : 35 - n); *(unsigned*)(KVB + off + (size_t)cidx * 4 * 8192) = pk2(st[0], st[1]); st = st * dec + v[n]; }
    }
}

struct RetLoad { u32x4 vv[4], kk[2]; u32x2 hv[2][4]; bf16x8 qr[4]; };
__device__ __forceinline__ void retout_load(const bf16_t* P, const bf16_t* KVS, int u, const int tid, RetLoad& L) {
    const int b = u / (4 * NCH), hd = (u / NCH) & 3, cidx = u % NCH;
    const int lane = tid & 63, wid = __builtin_amdgcn_readfirstlane(tid >> 6), r = lane & 31, hh = lane >> 5;
    const int row0 = b * TPB + 128 * cidx, ib = wid & 3;
#pragma unroll
    for (int i = 0; i < 4; ++i) { const int c = tid + 512 * i, j = c >> 4, ch = c & 15; L.vv[i] = *(const u32x4*)(P + (size_t)(row0 + j) * PC + 1280 + 128 * hd + 8 * ch); }
#pragma unroll
    for (int i = 0; i < 2; ++i) { const int c = tid + 512 * i, j = c >> 3, ch = c & 7; L.kk[i] = *(const u32x4*)(P + (size_t)(row0 + j) * PC + 1024 + 64 * hd + 8 * ch); }
#pragma unroll
    for (int dir = 0; dir < 2; ++dir) { const bf16_t* H = KVS + kvs_index(dir, b, cidx, hd);
#pragma unroll
        for (int i = 0; i < 4; ++i) { const int c = tid + 512 * i; L.hv[dir][i] = *(const u32x2*)(H + (c >> 5) * 128 + (c & 31) * 4); } }
    const int iloc = 32 * ib + r;
#pragma unroll
    for (int d0 = 0; d0 < 4; ++d0) L.qr[d0] = *(const bf16x8*)(P + (size_t)(row0 + iloc) * PC + 768 + 64 * hd + 16 * d0 + 8 * hh);
}
__device__ __forceinline__ void retout_units(const bf16_t* P, const bf16_t* KVS, bf16_t* Y3, const float* gainl, const float* rc, int u0, int ustep, int nU, bool skip_ctx, LAS char* lds, const int tid) {
    const int lane = tid & 63, wid = __builtin_amdgcn_readfirstlane(tid >> 6), r = lane & 31, hh = lane >> 5;
    const int ib = wid & 3, eh = wid >> 2;
    LAS char* vimg = lds; LAS char* himg0 = lds + 128 * RSV * 2; LAS char* himg1 = himg0 + 64 * RSV * 2; LAS char* kimg = himg1 + 64 * RSV * 2;
    LAS float* part1 = (LAS float*)(kimg + 128 * RSK * 2); LAS float* part2 = part1 + 256;
    const int nV = skip_ctx ? (nU / NCH) * (NCH - 2) : nU;
#define RET_UNIT_OF(v) (skip_ctx ? ((v) / (NCH - 2)) * NCH + 2 + (v) % (NCH - 2) : (v))
    int vi = u0; if (vi >= nV) return;
    int u = RET_UNIT_OF(vi);
    RetLoad L; retout_load(P, KVS, u, tid, L);
#pragma unroll 1
    for (;;) {
    const int b = u / (4 * NCH), hd = (u / NCH) & 3, cidx = u % NCH;
    const float lgf2 = rc[2 * hd], lgb2 = rc[8 + 2 * hd];
    const int row0 = b * TPB + 128 * cidx;
    const int iloc = 32 * ib + r;
    bf16x8 qr[4];
#pragma unroll
    for (int d0 = 0; d0 < 4; ++d0) qr[d0] = L.qr[d0];
#pragma unroll
    for (int i = 0; i < 4; ++i) { const int c = tid + 512 * i, j = c >> 4, ch = c & 15; *(LAS u32x4*)(vimg + (j * RSV + 8 * ch) * 2) = L.vv[i]; }
#pragma unroll
    for (int i = 0; i < 2; ++i) { const int c = tid + 512 * i, j = c >> 3, ch = c & 7; *(LAS u32x4*)(kimg + (j * RSK + 8 * ch) * 2) = L.kk[i]; }
#pragma unroll
    for (int dir = 0; dir < 2; ++dir) { LAS char* himg = dir ? himg1 : himg0;
#pragma unroll
        for (int i = 0; i < 4; ++i) { const int c = tid + 512 * i, d = c >> 5, e4 = (c & 31) * 4; *(LAS u32x2*)(himg + (d * RSV + e4) * 2) = L.hv[dir][i]; } }
    LDS_WAIT(); __syncthreads();
    const int vn = vi + ustep, un = RET_UNIT_OF(vn);
    if (vn < nV) retout_load(P, KVS, un, tid, L);
    const int q = (lane & 15) >> 2, p = lane & 3, c16 = 16 * ((lane >> 4) & 1) + 4 * p;
    f32x16 O[2]; O[0] = f32x16{}; O[1] = f32x16{};
#pragma unroll 2
    for (int jb = 0; jb < 4; ++jb) {
        f32x16 X = f32x16{};
#pragma unroll
        for (int d0 = 0; d0 < 4; ++d0) { const bf16x8 kf = *(const LAS bf16x8*)(kimg + ((32 * jb + r) * RSK + 16 * d0 + 8 * hh) * 2);
            X = __builtin_amdgcn_mfma_f32_32x32x16_bf16(kf, qr[d0], X, 0, 0, 0); }
#pragma unroll
        for (int reg = 0; reg < 16; ++reg) { const int jloc = 32 * jb + (reg & 3) + 8 * (reg >> 2) + 4 * hh, dl = iloc - jloc;
            const float w0 = __builtin_amdgcn_exp2f((float)dl * (dl > 0 ? lgf2 : -lgb2));
            X[reg] *= (dl == 0) ? 2.0f : w0; }
        u32x4 pw[2];
        pw[0] = (u32x4){pk2(X[0], X[1]), pk2(X[2], X[3]), pk2(X[4], X[5]), pk2(X[6], X[7])};
        pw[1] = (u32x4){pk2(X[8], X[9]), pk2(X[10], X[11]), pk2(X[12], X[13]), pk2(X[14], X[15])};
#pragma unroll
        for (int s = 0; s < 2; ++s) { const int j0 = 32 * jb + 16 * s + 4 * hh + q;
#pragma unroll
            for (int eb = 0; eb < 2; ++eb) { const int ec = 32 * (2 * eh + eb) + c16;
                const s16x4 lo = trd(vimg + (j0 * RSV + ec) * 2), hi = trd(vimg + ((j0 + 8) * RSV + ec) * 2);
                O[eb] = __builtin_amdgcn_mfma_f32_32x32x16_bf16(__builtin_bit_cast(bf16x8, pw[s]), RET_FRAG(lo, hi), O[eb], 0, 0, 0); } }
    }
#pragma unroll
    for (int dir = 0; dir < 2; ++dir) {
        const float fac = dir == 0 ? __builtin_amdgcn_exp2f((float)(iloc + 1) * lgf2) : __builtin_amdgcn_exp2f((float)(128 - iloc) * lgb2);
        const LAS char* himg = dir ? himg1 : himg0;
#pragma unroll
        for (int d0 = 0; d0 < 4; ++d0) {
            f32x4 a, bq; pg8::unpack8(__builtin_bit_cast(u32x4, qr[d0]), a, bq);
            const u32x4 qs = (u32x4){pk2(a[0] * fac, a[1] * fac), pk2(a[2] * fac, a[3] * fac), pk2(bq[0] * fac, bq[1] * fac), pk2(bq[2] * fac, bq[3] * fac)};
            const int dd0 = 16 * d0 + 8 * hh + q;
#pragma unroll
            for (int eb = 0; eb < 2; ++eb) { const int ec = 32 * (2 * eh + eb) + c16;
                const s16x4 lo = trd(himg + (dd0 * RSV + ec) * 2), hi = trd(himg + ((dd0 + 4) * RSV + ec) * 2);
                O[eb] = __builtin_amdgcn_mfma_f32_32x32x16_bf16(__builtin_bit_cast(bf16x8, qs), RET_FRAG(lo, hi), O[eb], 0, 0, 0); } }
    }
    u32x4 sgv[4]; f32x4 gn0[4], gn1[4];
#pragma unroll
    for (int i = 0; i < 4; ++i) { const int c = tid + 512 * i, row = c >> 4, ch = c & 15;
        sgv[i] = *(const u32x4*)(P + (size_t)(row0 + row) * PC + 1792 + 128 * hd + 8 * ch);
        gn0[i] = *(const f32x4*)(gainl + 128 * hd + 8 * ch); gn1[i] = *(const f32x4*)(gainl + 128 * hd + 8 * ch + 4); }
    float mean[16], rstd[16];
#pragma unroll
    for (int reg = 0; reg < 16; ++reg) mean[reg] = half_sum(O[0][reg] + O[1][reg]);
    if (r == 0) {
#pragma unroll
        for (int reg = 0; reg < 16; ++reg) part1[eh * 128 + 32 * ib + (reg & 3) + 8 * (reg >> 2) + 4 * hh] = mean[reg]; }
    LDS_WAIT(); __syncthreads();
#pragma unroll
    for (int reg = 0; reg < 16; ++reg) { const int i = 32 * ib + (reg & 3) + 8 * (reg >> 2) + 4 * hh; mean[reg] = (part1[i] + part1[128 + i]) * (1.0f / 128.0f); }
#pragma unroll
    for (int reg = 0; reg < 16; ++reg) { const float d0 = O[0][reg] - mean[reg], d1 = O[1][reg] - mean[reg]; rstd[reg] = half_sum(d0 * d0 + d1 * d1); }
    if (r == 0) {
#pragma unroll
        for (int reg = 0; reg < 16; ++reg) part2[eh * 128 + 32 * ib + (reg & 3) + 8 * (reg >> 2) + 4 * hh] = rstd[reg]; }
    LDS_WAIT(); __syncthreads();
#pragma unroll
    for (int reg = 0; reg < 16; ++reg) { const int i = 32 * ib + (reg & 3) + 8 * (reg >> 2) + 4 * hh; rstd[reg] = rsqrtf((part2[i] + part2[128 + i]) * (1.0f / 128.0f) + EPS); }
    LAS bf16_t* yimg = (LAS bf16_t*)vimg;
#pragma unroll
    for (int eb = 0; eb < 2; ++eb) { const int e = 32 * (2 * eh + eb) + r;
#pragma unroll
        for (int reg = 0; reg < 16; ++reg) { const int i = 32 * ib + (reg & 3) + 8 * (reg >> 2) + 4 * hh; yimg[i * RSV + e] = (bf16_t)f2bf((O[eb][reg] - mean[reg]) * rstd[reg]); } }
    LDS_WAIT(); __syncthreads();
#pragma unroll
    for (int i = 0; i < 4; ++i) { const int c = tid + 512 * i, row = c >> 4, ch = c & 15;
        const u32x4 yv = *(const LAS u32x4*)(vimg + (row * RSV + 8 * ch) * 2);
        f32x4 ya, yb, sa, sb; pg8::unpack8(yv, ya, yb); pg8::unpack8(sgv[i], sa, sb);
        *(u32x4*)(Y3 + (size_t)(row0 + row) * 1536 + 512 + 128 * hd + 8 * ch) = pg8::pack8(ya * gn0[i] * sa, yb * gn1[i] * sb); }
    LDS_WAIT(); __syncthreads();
    if (vn >= nV) break;
    vi = vn; u = un;
    }
#undef RET_UNIT_OF
}
}
struct MatD { const float* src; bf16_t* dst; int K, N, mode, nitems, ldd; float q8; };
__device__ __forceinline__ MatD mat_desc(int id, unsigned char* ws) {
    MatD m;
    if (id < 4) { m.src = KIN(I_w_in) + (size_t)id * D * INC; m.K = D; m.N = INC; m.dst = WSP(bf16_t, WS_WIN) + (size_t)id * INC * D; m.mode = 1; }
    else if (id < 16) { const int q = id - 4, l = q / 3, br = q - 3 * l; m.src = KIN(I_w_br_a + br) + (size_t)l * 512 * D; m.K = 512; m.N = D; m.dst = WSP(bf16_t, WS_WBR) + (size_t)l * D * 1536 + br * 512; m.mode = 0; }
    else if (id < 20) { const int l = id - 16; m.src = KIN(I_w_out) + (size_t)l * D * D; m.K = D; m.N = D; m.dst = WSP(bf16_t, WS_WOUT) + (size_t)l * D * D; m.mode = 0; }
    else if (id < 24) { const int q = id - 20, j = q >> 1, wh = q & 1; m.src = KIN(wh ? I_ffn_w3 : I_ffn_w1) + (size_t)j * D * DFF; m.K = D; m.N = DFF; m.dst = WSP(bf16_t, WS_W13) + (size_t)j * 2 * DFF * D; m.mode = 2 + wh; }
    else if (id < 26) { const int j = id - 24; m.src = KIN(I_ffn_w2) + (size_t)j * DFF * D; m.K = DFF; m.N = D; m.dst = WSP(bf16_t, WS_W2) + (size_t)j * D * DFF; m.mode = 0; }
    else if (id < 58) { const int q = id - 26, je = q >> 1, wh = q & 1; m.src = KIN(wh ? I_exp_w3 : I_exp_w1) + (size_t)je * D * DFE; m.K = D; m.N = DFE; m.dst = (bf16_t*)(ws + WS_E13 + (size_t)je * 2 * DFE * D); m.mode = 2 + wh; }
    else { const int je = id - 58; m.src = KIN(I_exp_w2) + (size_t)je * DFE * D; m.K = DFE; m.N = D; m.dst = (bf16_t*)(ws + WS_E2 + (size_t)je * D * DFE); m.mode = 0; }
    m.nitems = (m.K / 64) * (m.N / 32); m.ldd = (id >= 4 && id < 16) ? 1536 : m.K; m.q8 = id >= 58 ? FP8_SC_W2 : (id >= 26 ? FP8_SC_W13 : 0.f);
    return m;
}
struct ItemRef { const float* src; bf16_t* dst; int K, N, ldd; float q8; };
struct ItemIt { int id, id_end, base, g, W; };
__device__ __forceinline__ bool item_next(ItemIt& it, unsigned char* ws, ItemRef& r) {
    while (it.id < it.id_end) { const MatD m = mat_desc(it.id, ws);
        if (it.g < it.base + m.nitems) { const int item = it.g - it.base; it.g += it.W;
            const int nblk = m.N / 32, kb = item / nblk, nb = item - kb * nblk, k0 = 64 * kb, n0 = 32 * nb;
            int drow0 = n0;
            if (m.mode == 1) { const int T = n0 >> 8, cl = n0 & 255; const bool head = (T <= 4) || (T >= 9 && T <= 11); if (head) drow0 = 256 * T + 128 * ((cl >> 5) & 1) + 32 * (cl >> 6); }
            else if (m.mode >= 2) { drow0 = 256 * (n0 >> 7) + 128 * (m.mode - 2) + (n0 & 127); }
            r.src = m.src + (size_t)k0 * m.N + n0; r.q8 = m.q8; r.dst = m.q8 > 0.f ? (bf16_t*)((unsigned char*)m.dst + (size_t)drow0 * m.ldd + k0) : m.dst + (size_t)drow0 * m.ldd + k0; r.K = m.K; r.N = m.N; r.ldd = m.ldd;
            if (m.mode == 1 && ((g1_mask(it.id) >> (n0 >> 8)) & 1u)) { r.q8 = FP8_SC_WG; r.dst = (bf16_t*)((unsigned char*)m.dst + WG8_OFF + (size_t)drow0 * D + k0); }
            return true; }
        it.base += m.nitems; ++it.id; }
    return false;
}
__device__ __forceinline__ void tr_load(const ItemRef& r, float (&v)[32], int lane) {
    const float* p = r.src + (size_t)(lane >> 5) * r.N + (lane & 31);
#pragma unroll
    for (int i = 0; i < 32; ++i) v[i] = __builtin_nontemporal_load(p + (size_t)(2 * i) * r.N);
}
__device__ __forceinline__ void tr_store(const ItemRef& r, const float (&v)[32], LAS float* scr, int lane) {
#pragma unroll
    for (int i = 0; i < 32; ++i) { const int kk = 2 * i + (lane >> 5); scr[kk * 33 + (lane & 31)] = v[i]; }
    LDS_WAIT(); asm volatile("" ::: "memory");
    if (r.q8 > 0.f) {
#pragma unroll
        for (int jj = 0; jj < 2; ++jj) { const int ch = lane + 64 * jj, n = ch >> 2, c4 = ch & 3; const LAS float* s = scr + (16 * c4) * 33 + n; float e[16];
#pragma unroll
            for (int x = 0; x < 16; ++x) e[x] = s[x * 33] * r.q8;
            u32x4 o; o.x = pk4_fp8(e[0], e[1], e[2], e[3]); o.y = pk4_fp8(e[4], e[5], e[6], e[7]); o.z = pk4_fp8(e[8], e[9], e[10], e[11]); o.w = pk4_fp8(e[12], e[13], e[14], e[15]);
            *(u32x4*)((unsigned char*)r.dst + (size_t)n * r.ldd + 16 * c4) = o; }
        LDS_WAIT(); asm volatile("" ::: "memory");
        return;
    }
    const int c = lane & 7;
#pragma unroll
    for (int j = 0; j < 4; ++j) { const int n = (lane >> 3) + 8 * j; const LAS float* s = scr + (8 * c) * 33 + n;
        u32x4 o; o.x = pg8::cvt_pk_bf16(s[0 * 33], s[1 * 33]); o.y = pg8::cvt_pk_bf16(s[2 * 33], s[3 * 33]); o.z = pg8::cvt_pk_bf16(s[4 * 33], s[5 * 33]); o.w = pg8::cvt_pk_bf16(s[6 * 33], s[7 * 33]);
        *(u32x4*)(r.dst + (size_t)n * r.ldd + 8 * c) = o; }
    LDS_WAIT(); asm volatile("" ::: "memory");
}
__device__ __forceinline__ void convert_mats(unsigned char* ws, LAS unsigned char* lds, int rank, int nrank, int wave, int lane, int id0, int id1) {
    LAS float* scr = (LAS float*)(lds + wave * 8704);
    ItemIt it{id0, id1, 0, rank * NWAVES + wave, nrank * NWAVES};
    ItemRef ra, rb; float va[32], vb[32];
    bool ha = item_next(it, ws, ra);
    if (ha) tr_load(ra, va, lane);
#pragma unroll 1
    while (ha) {
        const bool hb = item_next(it, ws, rb);
        if (hb) tr_load(rb, vb, lane);
        tr_store(ra, va, scr, lane);
        if (!hb) break;
        ha = item_next(it, ws, ra);
        if (ha) tr_load(ra, va, lane);
        tr_store(rb, vb, scr, lane);
    }
}

struct Ptrs {
    const float *x, *c, *ctx, *c_ctx, *w_ada, *b_ada, *norm1_g, *norm2_g, *final_g, *w_in, *b_gate, *qn_a, *kn_a, *ret_a, *ret_g, *sink_c,
                *w_br_a, *w_br_b, *w_br_c, *w_out, *ffn_w1, *ffn_w3, *ffn_w2, *router_w, *router_b, *exp_w1, *exp_w3, *exp_w2;
};

__device__ __forceinline__ void prologue_phase(const Ptrs& I, unsigned char* ws, LAS unsigned char* lds, int tid, int lane, int wave, int G) {
    LAS float* sv = (LAS float*)(lds + 69632);
    LAS float* part = (LAS float*)(lds + 69632 + 20480);
    for (int i = tid; i < 5 * 1024; i += NTHR) { const int who = i >> 10, k = i & 1023; const float cv = who < 4 ? I.c[who * 1024 + k] : I.c_ctx[k]; sv[i] = siluf_(cv); }
    LDS_WAIT(); __syncthreads();
    float* MODS = (float*)(ws + WS_MODS);
#ifdef DUP_MODS
    for (int rep = 0; rep < 2; ++rep)
#endif
    for (int it = blockIdx.x; it < DEPTH * 48; it += G) {
        const int l = it / 48, cg = it % 48, col = cg * 128 + 2 * lane;
        const float* wp = I.w_ada + ((size_t)l * 1024 + wave * 128) * INC + col;
        f32x2 a0 = {0.f, 0.f}, a1 = a0, a2 = a0, a3 = a0, a4 = a0;
#pragma unroll 16
        for (int k = 0; k < 128; ++k) { const f32x2 w = *(const f32x2*)(wp + (size_t)k * INC); const int kk = wave * 128 + k;
            a0 += sv[kk] * w; a1 += sv[1024 + kk] * w; a2 += sv[2048 + kk] * w; a3 += sv[3072 + kk] * w; a4 += sv[4096 + kk] * w; }
        *(LAS f32x2*)(part + (wave * 5 + 0) * 128 + 2 * lane) = a0; *(LAS f32x2*)(part + (wave * 5 + 1) * 128 + 2 * lane) = a1; *(LAS f32x2*)(part + (wave * 5 + 2) * 128 + 2 * lane) = a2;
        *(LAS f32x2*)(part + (wave * 5 + 3) * 128 + 2 * lane) = a3; *(LAS f32x2*)(part + (wave * 5 + 4) * 128 + 2 * lane) = a4;
        LDS_WAIT(); __syncthreads();
        for (int o = tid; o < 640; o += NTHR) { const int who = o >> 7, ln = o & 127; float s = I.b_ada[(size_t)l * INC + cg * 128 + ln];
#pragma unroll
            for (int w = 0; w < 8; ++w) s += part[(w * 5 + who) * 128 + ln];
            MODS[((size_t)l * 5 + who) * INC + cg * 128 + ln] = s; }
        __syncthreads();
    }
    if (blockIdx.x == G - 1) { float* R = (float*)(ws + WS_ROPE);
        for (int i = tid; i < 1024; i += NTHR) { const int pos = i >> 4, f = i & 15; const float inv = powf(10000.0f, -(float)f / 16.0f); const float ang = (float)pos * inv; R[2 * i] = cosf(ang); R[2 * i + 1] = sinf(ang); } }
    if (blockIdx.x == (G > 1 ? G - 2 : 0) && tid < DEPTH * 8) { float* RC = (float*)(ws + WS_RETC); const float a = I.ret_a[tid]; const float lg = -log1pf(expf(-a)); RC[2 * tid] = lg * LOG2E; RC[2 * tid + 1] = expf(128.0f * lg); }
    convert_mats(ws, lds, blockIdx.x, G, wave, lane, 0, 74);
}

struct NormArgs {
    const float* g; const float* shift; const float* scale;
    const float* gate2p; const bf16_t* Y; const int* DST;
    const LAS float* rw; const float* rb; LAS int* route; int* PE; float* PW;
    unsigned char* hn8;
};
struct RowJob { const float* src; const bf16_t* srcb; bf16_t* xs_out; bf16_t* hn; int row; NormArgs A; };
struct RowData { u32x4 x[4]; u32x2 y0[4], y1[4]; };
struct NormStat { f32x4 am[4], sh[4], gt[4]; const float* key; };
template <bool COMB> __device__ __forceinline__ void norm_idx(const RowJob& J, int (&d)[2]) { if constexpr (COMB) { d[0] = J.A.DST[2 * J.row]; d[1] = J.A.DST[2 * J.row + 1]; } }
template <bool SRC32, bool COMB> __device__ __forceinline__ void norm_load(const RowJob& J, const int (&d)[2], RowData& R, int lane) {
#pragma unroll
    for (int j = 0; j < 4; ++j) { const int c = 4 * lane + 256 * j;
        if constexpr (SRC32) R.x[j] = *(const u32x4*)(J.src + c); else { const u32x2 t = *(const u32x2*)(J.srcb + c); R.x[j].x = t.x; R.x[j].y = t.y; } }
    if constexpr (COMB) {
#pragma unroll
        for (int j = 0; j < 4; ++j) { const int c = 4 * lane + 256 * j; R.y0[j] = *(const u32x2*)(J.A.Y + (size_t)d[0] * D + c); R.y1[j] = *(const u32x2*)(J.A.Y + (size_t)d[1] * D + c); } }
}
template <bool COMB> __device__ __forceinline__ void norm_stat_build(const RowJob& J, const f32x4 (&gq)[4], NormStat& S, int lane) {
#pragma unroll
    for (int j = 0; j < 4; ++j) { const int c = 4 * lane + 256 * j; const f32x4 sc = *(const f32x4*)(J.A.scale + c); S.sh[j] = *(const f32x4*)(J.A.shift + c); S.am[j] = gq[j] * (sc + 1.0f);
        if constexpr (COMB) S.gt[j] = *(const f32x4*)(J.A.gate2p + c); }
    S.key = J.A.shift;
}
template <bool SRC32, bool COMB> __device__ __forceinline__ void norm_finish(const RowJob& J, const RowData& R, const NormStat& S, int lane) {
    const NormArgs& A = J.A; const int row = J.row; bf16_t* xs_out = J.xs_out; bf16_t* hn = J.hn;
    f32x4 v[4]; float ss = 0.f;
#pragma unroll
    for (int j = 0; j < 4; ++j) { if constexpr (SRC32) v[j] = __builtin_bit_cast(f32x4, R.x[j]); else v[j] = (f32x4){bflo(R.x[j].x), bfhi(R.x[j].x), bflo(R.x[j].y), bfhi(R.x[j].y)}; }
    if constexpr (COMB) {
#pragma unroll
        for (int j = 0; j < 4; ++j) { const u32x2 y0 = R.y0[j], y1 = R.y1[j]; const f32x4 gt = S.gt[j];
            v[j][0] += gt[0] * (bflo(y0.x) + bflo(y1.x)); v[j][1] += gt[1] * (bfhi(y0.x) + bfhi(y1.x)); v[j][2] += gt[2] * (bflo(y0.y) + bflo(y1.y)); v[j][3] += gt[3] * (bfhi(y0.y) + bfhi(y1.y)); } }
    if (xs_out) {
#pragma unroll
        for (int j = 0; j < 4; ++j) { u32x2 w; w.x = pk2(v[j][0], v[j][1]); w.y = pk2(v[j][2], v[j][3]); *(u32x2*)(xs_out + 4 * lane + 256 * j) = w; } }
#pragma unroll
    for (int j = 0; j < 4; ++j) ss += (v[j][0] * v[j][0] + v[j][1] * v[j][1]) + (v[j][2] * v[j][2] + v[j][3] * v[j][3]);
    const float rs = rsqrtf(wave_sum(ss) * (1.0f / D) + EPS);
    float lg[8];
#pragma unroll
    for (int e = 0; e < 8; ++e) lg[e] = 0.f;
#pragma unroll
    for (int j = 0; j < 4; ++j) { const int c = 4 * lane + 256 * j;
        f32x4 h = v[j] * rs * S.am[j] + S.sh[j];
        if (hn) { u32x2 w; w.x = pk2(h[0], h[1]); w.y = pk2(h[2], h[3]); *(u32x2*)(hn + c) = w; }
        if (A.hn8) { const f32x4 q = h * FP8_SC_X; *(unsigned*)(A.hn8 + c) = pk4_fp8(q[0], q[1], q[2], q[3]); }
        if (A.rw) {
#pragma unroll
            for (int e = 0; e < 8; ++e) { const f32x4 r = *(const LAS f32x4*)(A.rw + e * 1024 + c); lg[e] += (h[0] * r[0] + h[1] * r[1]) + (h[2] * r[2] + h[3] * r[3]); } } }
    if (A.rw) {
#pragma unroll
        for (int e = 0; e < 8; ++e) lg[e] = wave_sum(lg[e]) + A.rb[e];
        int i1 = 0; float v1 = lg[0];
#pragma unroll
        for (int e = 1; e < 8; ++e) if (lg[e] > v1) { v1 = lg[e]; i1 = e; }
        int i2 = -1; float v2 = -INFINITY;
#pragma unroll
        for (int e = 0; e < 8; ++e) if (e != i1 && lg[e] > v2) { v2 = lg[e]; i2 = e; }
        if (i2 < 0) i2 = (i1 + 1) & 7;
        if (lane == 0) { const float w1 = 1.0f / (1.0f + __expf(v2 - v1));
            A.route[0] = i1; A.route[1] = i2;
            A.PE[2 * row] = i1; A.PE[2 * row + 1] = i2; A.PW[2 * row] = w1; A.PW[2 * row + 1] = 1.0f - w1; }
    }
}
template <bool SRC32, bool COMB, class F> __device__ __forceinline__ void norm_rows(int first, int stride, int end, const F& f, int lane) {
    if (first >= end) return;
    RowJob J, Jt; RowData A, B, C; NormStat S; int dn[2] = {0, 0};
    f(first, J);
    f32x4 gq[4];
#pragma unroll
    for (int j = 0; j < 4; ++j) gq[j] = *(const f32x4*)(J.A.g + 4 * lane + 256 * j);
    norm_stat_build<COMB>(J, gq, S, lane);
    norm_idx<COMB>(J, dn); norm_load<SRC32, COMB>(J, dn, A, lane);
    if (first + stride < end) { f(first + stride, Jt); norm_idx<COMB>(Jt, dn); norm_load<SRC32, COMB>(Jt, dn, B, lane); }
    { const int ri = first + 2 * stride < end ? first + 2 * stride : end - 1; f(ri, Jt); norm_idx<COMB>(Jt, dn); }
    int r = first;
#define NR_STEP(LD, FIN, k) { const int rl = r + ((k) + 2) * stride, rf = r + (k) * stride; \
        if (rl < end) { f(rl, Jt); norm_load<SRC32, COMB>(Jt, dn, LD, lane); } \
        if constexpr (COMB) { const int ri = rl + stride < end ? rl + stride : end - 1; f(ri, Jt); norm_idx<COMB>(Jt, dn); }     \
        f(rf, J); if (J.A.shift != S.key) norm_stat_build<COMB>(J, gq, S, lane); norm_finish<SRC32, COMB>(J, FIN, S, lane); \
        if (rf + stride >= end) break; }
#pragma unroll 1
    for (;;) {
        NR_STEP(C, A, 0)
        NR_STEP(A, B, 1)
        NR_STEP(B, C, 2)
        r += 3 * stride;
    }
#undef NR_STEP
}
struct SchedPlain {
    const char* A; const char* B; size_t aTile, bTile; int nM, nN, G, c; bool latOnly; int ntk, lda, ldb;
    __device__ __forceinline__ void a_ready(const pg8::Unit&) const {}
    __device__ __forceinline__ void done(const pg8::Unit&, int) const {}
    __device__ __forceinline__ bool next(int i, pg8::Unit& u) const {
        int pm, pn; if (!pg8::tile_of((long)i * G + c, nM, nN, pm, pn)) return false;
        if (latOnly) pm = pm + pm / 16 + 1;
        u.pm = pm; u.pn = pn; u.aux = 0; u.ntk = ntk; u.mode = 0; u.peer = 0; u.kt0 = 0; u.kind = 0; u.lda = lda; u.ldb = ldb; u.A = A + (size_t)pm * aTile; u.B = B + (size_t)pn * bTile; return true; }
};
template <int KIND> struct SchedG1 {
    const char* A; const char* B; int nM, G, c; unsigned mask; unsigned* cnt;
    __device__ __forceinline__ bool next(int i, pg8::Unit& u) const {
        const unsigned mk = KIND ? mask : (~mask & 0xFFFFFFu), mkA = mk & 0x70u, mkB = mk & ~0x70u;
        const int nA = __builtin_popcount(mkA), nB = __builtin_popcount(mkB); const long L = (long)i * G + (KIND ? G - 1 - c : c), LA = (long)nM * nA;
        int pm, j, pn;
        if (L < LA) { pg8::tile_of(L, nM, nA, pm, j); pn = nth_bit(mkA, j); }
        else { if (nB == 0 || !pg8::tile_of(L - LA, nM, nB, pm, j)) return false; pn = nth_bit(mkB, j); }
        u.pm = pm; u.pn = pn; u.aux = 0; u.mode = 0; u.peer = 0; u.kt0 = 0; u.kind = 0;
        if (KIND) { u.ntk = D / 128; u.lda = D / 2; u.ldb = D / 2; u.A = A + (size_t)pm * (256 * D); u.B = B + (size_t)pn * (256 * D); }
        else { u.ntk = D / 64; u.lda = D; u.ldb = D; u.A = A + (size_t)pm * (256 * D * 2); u.B = B + (size_t)pn * (256 * D * 2); }
        return true; }
    __device__ __forceinline__ void a_ready(const pg8::Unit&) const {}
    __device__ __forceinline__ void done(const pg8::Unit& u, int lane) const {
        if (u.pn >= 4 && u.pn <= 6) { asm volatile("s_waitcnt vmcnt(0)" ::: "memory"); if (lane == 0) __hip_atomic_fetch_add(cnt + 32 * u.pm, 1u, __ATOMIC_RELAXED, __HIP_MEMORY_SCOPE_AGENT); } }
};
struct SchedMoE {
    const char* A; const char* B; size_t aTile, bTile, eStride; int nM, nN, G, c; int ts1, ts2, ts3, ts4, ts5, ts6, ts7; int ntk, lda, ldb;
    __device__ __forceinline__ void a_ready(const pg8::Unit&) const {}
    __device__ __forceinline__ void done(const pg8::Unit&, int) const {}
    __device__ __forceinline__ bool next(int i, pg8::Unit& u) const {
        int pm, pn; if (!pg8::tile_of((long)i * G + c, nM, nN, pm, pn)) return false;
        const int e = (pm >= ts1) + (pm >= ts2) + (pm >= ts3) + (pm >= ts4) + (pm >= ts5) + (pm >= ts6) + (pm >= ts7);
        u.pm = pm; u.pn = pn; u.aux = e; u.ntk = ntk; u.mode = 0; u.peer = 0; u.kt0 = 0; u.kind = 0; u.lda = lda; u.ldb = ldb; u.A = A + (size_t)pm * aTile; u.B = B + (size_t)e * eStride + (size_t)pn * bTile; return true; }
};
template <int P> struct SchedSK {
    const char* A; const char* B; size_t aTile, bTile, eStride; int U, G, vc; bool latOnly; int ts1, ts2, ts3, ts4, ts5, ts6, ts7; int s, e; int lda, ldb;
    __device__ __forceinline__ void a_ready(const pg8::Unit&) const {}
    __device__ __forceinline__ void done(const pg8::Unit&, int) const {}
    __device__ __forceinline__ int bound(int c) const { const unsigned b = (unsigned)c * (unsigned)(U * P) / (unsigned)G; int u = (int)(b / (unsigned)P), o = (int)b - u * P; if (o < 2) o = 0; else if (o > P - 2) { o = 0; ++u; } return u * P + o; }
    __device__ __forceinline__ void init() { s = bound(vc); e = bound(vc + 1); }
    __device__ __forceinline__ bool next(int i, pg8::Unit& u) const {
        const int u0 = s / P, un = u0 + i, st = (i == 0) ? s : un * P; if (st >= e) return false;
        const int uend = (un + 1) * P, en = e < uend ? e : uend, o = st - un * P, oe = en - un * P;
        u.mode = (o > 0) ? 2 : (oe < P ? 1 : 0); u.peer = vc + 1; u.ntk = 2 * (oe - o); u.kt0 = 2 * o; u.kind = 0; u.lda = lda; u.ldb = ldb;
        const int nP = U >> 2; const int pn = un / nP; int pm = un - pn * nP;
        const int ex = (pm >= ts1) + (pm >= ts2) + (pm >= ts3) + (pm >= ts4) + (pm >= ts5) + (pm >= ts6) + (pm >= ts7);
        if (latOnly) pm = pm + pm / 16 + 1;
        u.pm = pm; u.pn = pn; u.aux = ex; u.A = A + (size_t)pm * aTile + (size_t)o * 256; u.B = B + (size_t)ex * eStride + (size_t)pn * bTile + (size_t)o * 256; return true; }
};

template <int P> struct SchedWR {
    const char* A; const char* B; size_t aTile, bTile, eStride; int nP  , G, c; bool latOnly; int ts1, ts2, ts3, ts4, ts5, ts6, ts7; int lda, ldb;
    __device__ __forceinline__ void a_ready(const pg8::Unit&) const {}
    __device__ __forceinline__ void done(const pg8::Unit&, int) const {}
    __device__ __forceinline__ bool next(int i, pg8::Unit& u) const {
        const int U = nP * 4, R = U / G, rem = U - R * G; int p, q = -1;
        const int S = (P >= 16 && 4 * rem <= G) ? 4 : 2;
        if (i < R) p = i * G + c;
        else if (i == R && 2 * rem <= G) { if (c >= S * rem) return false; p = R * G + c / S; q = c % S; }
        else if (i == R) { p = R * G + c; if (p >= U) return false; }
        else return false;
        int pm, pn; pg8::tile_of((long)p, nP, 4, pm, pn);
        const int ex = (pm >= ts1) + (pm >= ts2) + (pm >= ts3) + (pm >= ts4) + (pm >= ts5) + (pm >= ts6) + (pm >= ts7);
        if (latOnly) pm = pm + pm / 16 + 1;
        const int base = P / S, extra = P % S;
        const int o = q < 0 ? 0 : q * base + (q < extra ? q : extra), np = q < 0 ? P : base + (q < extra ? 1 : 0);
        u.pm = pm; u.pn = pn; u.aux = ex; u.kind = 0; u.lda = lda; u.ldb = ldb; u.peer = c + 1; u.mode = q < 0 ? 0 : (q == 0 ? (S == 2 ? 1 : S) : 2); u.kt0 = 2 * o; u.ntk = 2 * np;
        u.A = A + (size_t)pm * aTile + (size_t)o * 256; u.B = B + (size_t)ex * eStride + (size_t)pn * bTile + (size_t)o * 256; return true; }
};
struct SchedM1 {
    const char* Y3; const char* WBR; unsigned* cnt; int c; bool ctx;
    __device__ __forceinline__ bool next(int i, pg8::Unit& u) const {
        int pm, pn;
        if (i == 0) { if (!pg8::tile_of((long)c, 64, 4, pm, pn)) return false; pm = pm + pm / 16 + 1; u.mode = 0; u.kt0 = 0; u.ntk = 24; }
        else if (i == 1 && ctx && c < 48) { const int e = c / 3, br = c - 3 * e; pm = 17 * (e >> 2); pn = e & 3; u.mode = br == 0 ? 3 : 2; u.kt0 = 8 * br; u.ntk = 8; }
        else return false;
        u.pm = pm; u.pn = pn; u.aux = 0; u.kind = 0; u.lda = 1536; u.ldb = 1536; u.peer = c + 1;
        u.A = Y3 + (size_t)pm * (256 * 1536 * 2) + (size_t)u.kt0 * 128; u.B = WBR + (size_t)pn * (256 * 1536 * 2) + (size_t)u.kt0 * 128; return true; }
    __device__ __forceinline__ void a_ready(const pg8::Unit&) const {}
    __device__ __forceinline__ void done(const pg8::Unit& u, int lane) const {
        asm volatile("s_waitcnt vmcnt(0)" ::: "memory"); if (lane == 0) __hip_atomic_fetch_add(cnt + 32 * u.pm, 1u, __ATOMIC_RELAXED, __HIP_MEMORY_SCOPE_AGENT); }
};
struct SchedM2One {
    const char* MB; const char* WOUT; int c; bool ctx; int which;
    __device__ __forceinline__ bool unit(pg8::Unit& u) const {
        int pm, pn;
        if (which == 1) { if (!pg8::tile_of((long)((c + 32) & 255), 64, 4, pm, pn)) return false; pm = pm + pm / 16 + 1; u.mode = 0; u.kt0 = 0; u.ntk = 16; }
        else if (ctx && c >= 224 && c < 256) { const int q = c - 224, e = q >> 1, half = q & 1; pm = 17 * (e >> 2); pn = e & 3; u.mode = half == 0 ? 1 : 2; u.kt0 = 8 * half; u.ntk = 8; }
        else return false;
        u.pm = pm; u.pn = pn; u.aux = 0; u.peer = c + 1; u.kind = 0; u.lda = 1024; u.ldb = 1024;
        u.A = MB + (size_t)pm * (256 * 1024 * 2) + (size_t)u.kt0 * 128; u.B = WOUT + (size_t)pn * (256 * 1024 * 2) + (size_t)u.kt0 * 128; return true; }
    __device__ __forceinline__ bool next(int i, pg8::Unit& u) const { return i == 0 && unit(u); }
    __device__ __forceinline__ void a_ready(const pg8::Unit&) const {}
    __device__ __forceinline__ void done(const pg8::Unit&, int) const {}
};
__device__ __forceinline__ void wait_panel(unsigned* cnt, unsigned* tmo, int pm, int wave_s, unsigned need) {
    if (wave_s == 0) { unsigned spins = 0;
        while ((unsigned)__builtin_amdgcn_readfirstlane(__hip_atomic_load(cnt + 32 * pm, __ATOMIC_RELAXED, __HIP_MEMORY_SCOPE_AGENT)) < need) {
            __builtin_amdgcn_s_sleep(1);
            if (++spins > (1u << 18)) { __hip_atomic_store(tmo, 1u, __ATOMIC_RELAXED, __HIP_MEMORY_SCOPE_AGENT); break; } }
        __builtin_amdgcn_fence(__ATOMIC_ACQUIRE, "agent");
        asm volatile("s_waitcnt vmcnt(0)" ::: "memory"); }
    __syncthreads();
}

struct Args { Ptrs in; float* out; unsigned char* ws; };
static_assert(sizeof(Args) == 30 * 8, "Args layout");
__global__ void __launch_bounds__(NTHR, 2) fwd_kernel(Args) {
    extern __shared__ __attribute__((aligned(16))) unsigned char lds_raw[];
    LAS unsigned char* lds = (LAS unsigned char*)lds_raw;
    volatile LAS unsigned* MISC = (volatile LAS unsigned*)(lds + MISC_OFF);
    const int G = gridDim.x, bx = blockIdx.x, wave_s = __builtin_amdgcn_readfirstlane((int)threadIdx.x >> 6);
#define PHASE_IDS() const int tid = fresh_tid(wave_s), lane = tid & 63, wave = __builtin_amdgcn_readfirstlane(tid >> 6), gw = bx * NWAVES + wave, NGW = G * NWAVES; (void)lane; (void)gw; (void)NGW
    const int vcu = (G % 8 == 0) ? (bx % 8) * (G / 8) + bx / 8 : bx;
    for (int u = threadIdx.x; u < (LDS_BYTES - LDSCTL_OFF) / 4; u += NTHR) ((LAS unsigned*)(lds + LDSCTL_OFF))[u] = 0u;
    __syncthreads();
    (void)xcd_barrier_post((unsigned*)(KWS() + WS_CTL) + CW_BAR, MISC + 8);
#ifdef TPROBE
#ifndef TPROBE_L0
#define TPROBE_L0 -1
#define TPROBE_L1 99
#endif
    int tp_l = -1;
#define TP(type) do { if (bx == 0 && fresh_tid(wave_s) == 0) { const unsigned now_ = (unsigned)__builtin_amdgcn_s_memrealtime(); if (tp_l >= TPROBE_L0 && tp_l <= TPROBE_L1) MISC[16 + (type)] += now_ - MISC[15]; MISC[15] = now_; } } while (0)
#else
#define TP(type) do {} while (0)
#endif
#define GRID_BAR() do { XcdBarrier b_; b_.bar = (unsigned*)(KWS() + WS_CTL) + CW_BAR; b_.x = xb_xcc_id(); b_.st = MISC + 8; xcd_barrier(b_); } while (0)

#ifdef TPROBE
    if (bx == 0 && fresh_tid(wave_s) == 0) MISC[15] = (unsigned)__builtin_amdgcn_s_memrealtime();
#endif
#ifndef SKIP_P0
    {
        PHASE_IDS(); Ptrs I; { const float** pp = (const float**)&I; kargp_t kp = kfresh();
#pragma unroll
            for (int i = 0; i < 28; ++i) pp[i] = ((const float* const __attribute__((address_space(4)))*)kp)[i]; }
        prologue_phase(I, KWS(), lds, tid, lane, wave, G);
#ifdef DUP_P0
        __syncthreads(); prologue_phase(I, KWS(), lds, tid, lane, wave, G);
#endif
    }
#endif
    GRID_BAR(); TP(0);

#pragma unroll 1
    for (int l = 0; l < DEPTH; ++l) {
        const bool need_ctx = (l < DEPTH - 1), moe = (l & 1) != 0; const int jf = l >> 1;
#ifdef TPROBE
        tp_l = l;
#endif
#ifndef SKIP_N1
        {
            PHASE_IDS(); unsigned char* ws = KWS(); bf16_t* XS = WSP(bf16_t, WS_XS); bf16_t* HN = WSP(bf16_t, WS_HN); const float* MODS = WSP(float, WS_MODS);
            const float* modl = MODS + (size_t)l * 5 * INC;
            const bool comb = (l == 2);
            const float* xin = KIN(I_x); const float* cin = KIN(I_ctx); const float* g1 = KIN(I_norm1_g) + (size_t)l * D;
            const bf16_t* YYp = WSP(bf16_t, WS_R2); const int* DSTp = (const int*)(ws + WS_META + MT_DST);
            struct N1Job { int l; bool comb, hn16; bf16_t* XS; bf16_t* HN; unsigned char* HN8; const float* MODS; const float* modl; const float* xin; const float* cin; const float* g1; const bf16_t* Y; const int* DST;
                __device__ __forceinline__ void operator()(int row, RowJob& J) const {
                    const int b = row / TPB, tq = row - b * TPB, who = tq < CTXL ? 4 : b;
                    J.src = (l == 0) ? (tq < CTXL ? cin + ((size_t)b * CTXL + tq) * D : xin + ((size_t)b * SEQ + (tq - CTXL)) * D) : nullptr; J.srcb = XS + (size_t)row * D;
                    J.xs_out = (l == 0 || comb) ? XS + (size_t)row * D : nullptr; J.hn = hn16 ? HN + (size_t)row * D : nullptr; J.row = row;
                    J.A = NormArgs{}; J.A.g = g1; J.A.shift = modl + (size_t)who * INC; J.A.scale = modl + (size_t)who * INC + D; J.A.hn8 = HN8 + (size_t)row * D;
                    if (comb) { J.A.gate2p = MODS + ((size_t)(l - 1) * 5 + who) * INC + 5 * D; J.A.Y = Y; J.A.DST = DST; } } };
            const N1Job job{l, comb, (g1_mask(l) & 0xFFFFFFu) != 0xFFFFFFu  , XS, HN, ws + WS_HN8, MODS, modl, xin, cin, g1, YYp, DSTp};
            { const int RPB = (M + G - 1) / G, r0 = bx * RPB, r1 = (r0 + RPB < M) ? r0 + RPB : M; if (l == 0) norm_rows<true, false>(r0 + wave, NWAVES, r1, job, lane); else if (comb) norm_rows<false, true>(r0 + wave, NWAVES, r1, job, lane); else norm_rows<false, false>(r0 + wave, NWAVES, r1, job, lane); }
        }
#endif
        GRID_BAR(); TP(1);
#ifdef DUP_BAR
        for (int r_ = 0; r_ < 8; ++r_) GRID_BAR();
#endif
#ifndef SKIP_G1
        {
            unsigned char* ws = KWS();
            unsigned* cnt = WSP(unsigned, WS_CTL) + CW_PAN + (4 + l) * 68 * 32;
            {
                SchedG1<0> S{(const char*)WSP(bf16_t, WS_HN), (const char*)(WSP(bf16_t, WS_WIN) + (size_t)l * INC * D), NMT, G, bx, g1_mask(l), cnt};
                pg8::EpiInProj E{WSP(bf16_t, WS_P), WSP(bf16_t, WS_G), KIN(I_qn_a) + l * 64, KIN(I_kn_a) + l * 64, KIN(I_b_gate) + (size_t)l * 3 * D, WSP(float, WS_ROPE), 1.0f};
                pg8::gemm_phase<pg8::EpiInProj, SchedG1<0>, true>(lds, fresh_tid(wave_s), S, E);
            }
            {
                unsigned char* ws2 = KWS();
                SchedG1<1> S{(const char*)(ws2 + WS_HN8), (const char*)(ws2 + WS_WIN + (size_t)l * INC * D * 2 + WG8_OFF), NMT, G, bx, g1_mask(l), (unsigned*)(ws2 + WS_CTL) + CW_PAN + (4 + l) * 68 * 32};
                pg8::EpiInProj E{(bf16_t*)(ws2 + WS_P), (bf16_t*)(ws2 + WS_G), KIN(I_qn_a) + l * 64, KIN(I_kn_a) + l * 64, KIN(I_b_gate) + (size_t)l * 3 * D, (const float*)(ws2 + WS_ROPE), 1.0f / (FP8_SC_X * FP8_SC_WG)};
                pg8::gemm_phase<pg8::EpiInProj, SchedG1<1>, true, true>(lds, fresh_tid(wave_s), S, E);
            }
            TP(3);
            {
                const int nf = __builtin_popcount(g1_mask(l)), remb = (NMT * (24 - nf)) % G, remf = (NMT * nf) % G; const bool mid = remb + remf < G; const int nidle = mid ? G - remb - remf : G, rank = mid ? bx - remb : bx;
                const bool share = mid && remb == 0 && remf > 0 && remf < NB * 4 * ret::NCH; const int nO = share ? remf : 0;
                int u0 = -1, ustep = 1;
                if (rank >= 0 && rank < nidle) { u0 = nO + rank; ustep = nidle; }
                else if (share && bx >= G - remf) { u0 = bx - (G - remf); ustep = NB * 4 * ret::NCH; }
                if (u0 >= 0)
                    ret::kvinc_units(WSP(bf16_t, WS_P), WSP(float, WS_KVS), WSP(float, WS_RETC) + l * 16, u0, ustep, NB * 4 * ret::NCH, cnt, WSP(unsigned, WS_CTL) + CW_TMO, wave_s, (LAS char*)lds, fresh_tid(wave_s));
            }
        }
#endif
        GRID_BAR(); TP(2);
#ifndef SKIP_A2
        { PHASE_IDS(); unsigned char* ws = KWS(); ret::scan_phase(WSP(float, WS_KVS), WSP(bf16_t, WS_KVB), WSP(float, WS_RETC) + l * 16, bx * NTHR + tid, G * NTHR); }
#endif
        GRID_BAR(); TP(4);
#ifndef SKIP_RO
        {
            unsigned char* ws = KWS(); const float* rc = WSP(float, WS_RETC) + l * 16; const float* rg = KIN(I_ret_g) + (size_t)l * 512;
            ret::retout_units(WSP(bf16_t, WS_P), WSP(bf16_t, WS_KVB), WSP(bf16_t, WS_Y3), rg, rc, bx, G, NB * 4 * ret::NCH, !need_ctx, (LAS char*)lds, fresh_tid(wave_s));
        }
#endif
        TP(7);
#ifndef SKIP_AT0
        {
            unsigned char* ws = KWS(); const bf16_t* P = WSP(bf16_t, WS_P); bf16_t* Y3 = WSP(bf16_t, WS_Y3); const float* snk = KIN(I_sink_c) + l * 8;
            const int nU0 = 512 + (need_ctx ? 64 : 0);
#pragma unroll 1
            for (int k = 0;; ++k) {
                int uu;
                if (G == 256) { if (k < 2) uu = (vcu >> 5) * 64 + (vcu & 31) * 2 + k; else if (k == 2 && bx >= 32 && bx < 96 && need_ctx) uu = 512 + (bx - 32); else break; }
                else { uu = bx + k * G; if (uu >= nU0) break; }
                const bf16_t *Qu, *Kh, *Vh; bf16_t* Ou; int NT; float sk = -INFINITY;
                if (uu < 512) {
                    const int xs = uu >> 6, b = xs >> 1, kvh = xs & 1, h = 4 * kvh + ((uu >> 4) & 3), qb = uu & 15;
                    const size_t rb = (size_t)b * TPB, rq = rb + 256 + 256 * qb;
                    Qu = P + rq * PC + 64 * h; Kh = P + rb * PC + 512 + 64 * kvh; Vh = P + rb * PC + 640 + 64 * kvh; Ou = Y3 + rq * 1536 + 64 * h; NT = 68;
                } else {
                    const int v = uu - 512, type = v >> 5, b = (v >> 3) & 3, h = v & 7, kvh = h >> 2; const size_t rb = (size_t)b * TPB;
                    if (type) sk = snk[h] * LOG2E;
                    Qu = P + rb * PC + (type ? 2304 : 0) + 64 * h; Kh = P + rb * PC + (type ? 2816 : 512) + 64 * kvh; Vh = P + rb * PC + (type ? 2944 : 640) + 64 * kvh; Ou = Y3 + rb * 1536 + (type ? 1024 : 0) + 64 * h; NT = 4;
                }
                attn_body::attn_unit<8, 0>(Qu, Kh, Vh, Ou, NT, 0, 0, sk, (char*)lds_raw, fresh_tid(wave_s));
            }
        }
#endif
#ifndef SKIP_AT1
        {
            unsigned char* ws = KWS(); const bf16_t* P = WSP(bf16_t, WS_P); bf16_t* Y3 = WSP(bf16_t, WS_Y3); const float* snk = KIN(I_sink_c) + l * 8;
#pragma unroll 1
            for (int k = 0;; ++k) {
                int uu;
                if (G == 256) { if (k < 2) uu = (vcu >> 5) * 64 + (vcu & 31) * 2 + k; else break;
                    const int j = uu & 63; const int hq = j < 8 ? (j >> 1) : (j - 8) / 14, qq = j < 8 ? ((j & 1) ? 15 : 0) : 1 + (j - 8) % 14; uu = (uu & ~63) | (hq << 4) | qq; }
                else { uu = bx + k * G; if (uu >= 512) break; }
                const int xs = uu >> 6, b = xs >> 1, kvh = xs & 1, h = 4 * kvh + ((uu >> 4) & 3), qb = uu & 15;
                const size_t rb = (size_t)b * TPB, rq = rb + 256 + 256 * qb;
                const int q0 = 256 * qb, kstart = q0 >= 128 ? q0 - 128 : 0, kend = q0 + 384 <= SEQ ? q0 + 384 : SEQ;
                attn_body::attn_unit<8, 1>(P + rq * PC + 2304 + 64 * h, P + rb * PC + 2816 + 64 * kvh, P + rb * PC + 2944 + 64 * kvh, Y3 + rq * 1536 + 1024 + 64 * h, 4 + (kend - kstart) / 64, kstart, q0 - kstart, snk[h] * LOG2E, (char*)lds_raw, fresh_tid(wave_s));
            }
        }
#endif
        GRID_BAR(); TP(5);
#ifndef SKIP_M1
        {
            unsigned char* ws = KWS();
            unsigned* cnt = WSP(unsigned, WS_CTL) + CW_PAN + l * 68 * 32;
            {
                SchedM1 S{(const char*)WSP(bf16_t, WS_Y3), (const char*)(WSP(bf16_t, WS_WBR) + (size_t)l * D * 1536), cnt, bx, need_ctx};
                pg8::EpiBranch E{WSP(bf16_t, WS_G), WSP(bf16_t, WS_MB)};
                pg8::SKCtx X{ws + WS_PART, WSP(unsigned, WS_CTL) + CW_FLG + 8192 * (8 + l), WSP(unsigned, WS_CTL) + CW_TMO, bx};
                pg8::gemm_phase<pg8::EpiBranch, SchedM1, true>(lds, fresh_tid(wave_s), S, E, X);
            }
#pragma unroll 1
            for (int i = 1; i < 3; ++i) {
                unsigned char* ws2 = KWS();
                SchedM2One S{(const char*)(ws2 + WS_MB), (const char*)((bf16_t*)(ws2 + WS_WOUT) + (size_t)l * D * D), bx, need_ctx, i};
                pg8::Unit u;
                if (S.unit(u)) {
                    wait_panel(cnt, (unsigned*)(ws2 + WS_CTL) + CW_TMO, u.pm, wave_s, 32u);
                    pg8::EpiResid E{(bf16_t*)(ws2 + WS_XS), (float*)(ws2 + WS_MODS) + (size_t)l * 5 * INC + 2 * D};
                    pg8::SKCtx X{ws2 + WS_PART, (unsigned*)(ws2 + WS_CTL) + CW_FLG + 8192 * (12 + l), (unsigned*)(ws2 + WS_CTL) + CW_TMO, bx};
                    pg8::gemm_phase<pg8::EpiResid, SchedM2One, true>(lds, fresh_tid(wave_s), S, E, X);
                }
            }
        }
#endif
        GRID_BAR(); TP(6);
#ifndef SKIP_N2
        {
            PHASE_IDS(); unsigned char* ws = KWS(); const bf16_t* XS = WSP(bf16_t, WS_XS); bf16_t* HN = WSP(bf16_t, WS_HN); const float* modl = WSP(float, WS_MODS) + (size_t)l * 5 * INC;
            const float* g2 = KIN(I_norm2_g) + (size_t)l * D;
            const int nrows = need_ctx ? M : NB * SEQ;
            if (!moe) {
                struct N2Job { bool need_ctx; const bf16_t* XS; bf16_t* HN; const float* modl; const float* g2;
                    __device__ __forceinline__ void operator()(int rr, RowJob& J) const {
                        const int row = need_ctx ? rr : (rr / SEQ) * TPB + CTXL + (rr % SEQ);
                        const int b = row / TPB, tq = row - b * TPB, who = tq < CTXL ? 4 : b;
                        J.src = nullptr; J.srcb = XS + (size_t)row * D; J.xs_out = nullptr; J.hn = HN + (size_t)row * D; J.row = row;
                        J.A = NormArgs{}; J.A.g = g2; J.A.shift = modl + (size_t)who * INC + 3 * D; J.A.scale = modl + (size_t)who * INC + 4 * D; } };
                const N2Job job{need_ctx, XS, HN, modl, g2};
                { const int RPB = (nrows + G - 1) / G, r0 = bx * RPB, r1 = (r0 + RPB < nrows) ? r0 + RPB : nrows; norm_rows<false, false>(r0 + wave, NWAVES, r1, job, lane); }
            } else {
                const int RPB = (nrows + G - 1) / G, r0 = bx * RPB, r1 = (r0 + RPB < nrows) ? r0 + RPB : nrows;
                LAS int* route = (LAS int*)lds;
                const float* rw = KIN(I_router_w) + (size_t)jf * D * NEXP; const float* rb = KIN(I_router_b) + jf * NEXP;
                int* PE = (int*)(ws + WS_META + MT_PE); int* PPOS = (int*)(ws + WS_META + MT_PPOS); float* PW = (float*)(ws + WS_META + MT_PW); int* BC = (int*)(ws + WS_META + MT_BC);
                LAS float* rwl = (LAS float*)(lds + 4096);
                for (int i = tid; i < D * NEXP; i += NTHR) rwl[(i & 7) * 1024 + (i >> 3)] = rw[i];
                LDS_WAIT(); __syncthreads();
                struct N2MJob { bool need_ctx; const bf16_t* XS; bf16_t* HN; const float* modl; const float* g2; const LAS float* rw; const float* rb; LAS int* route; int r0; int* PE; float* PW;
                    __device__ __forceinline__ void operator()(int rr, RowJob& J) const {
                        const int row = need_ctx ? rr : (rr / SEQ) * TPB + CTXL + (rr % SEQ);
                        const int b = row / TPB, tq = row - b * TPB, who = tq < CTXL ? 4 : b;
                        J.src = nullptr; J.srcb = XS + (size_t)row * D; J.xs_out = nullptr; J.hn = nullptr; J.row = row;
                        J.A = NormArgs{}; J.A.g = g2; J.A.shift = modl + (size_t)who * INC + 3 * D; J.A.scale = modl + (size_t)who * INC + 4 * D; J.A.hn8 = (unsigned char*)HN + (size_t)row * D;
                        J.A.rw = rw; J.A.rb = rb; J.A.route = route + 2 * (rr - r0); J.A.PE = PE; J.A.PW = PW; } };
                const N2MJob job{need_ctx, XS, HN, modl, g2, rwl, rb, route, r0, PE, PW};
                norm_rows<false, false>(r0 + wave, NWAVES, r1, job, lane);
                LDS_WAIT(); __syncthreads();
                {
                    const int npair = 2 * (r1 - r0 > 0 ? r1 - r0 : 0); int cnt = 0;
                    for (int k0 = 0; k0 < npair; k0 += 64) { const int k = k0 + lane; const bool mine = (k < npair) && (route[k] == wave);
                        const unsigned long long bal = __ballot(mine);
                        if (mine) { const int rr = r0 + (k >> 1); const int row = need_ctx ? rr : (rr / SEQ) * TPB + CTXL + (rr % SEQ);
                            PPOS[2 * row + (k & 1)] = cnt + __popcll(bal & ((1ull << lane) - 1ull)); }
                        cnt += __popcll(bal); }
                    if (lane == 0) BC[bx * 8 + wave] = cnt;
                }
                __syncthreads();
            }
        }
#endif
        GRID_BAR(); TP(8);
        if (!moe) {
#ifndef SKIP_F1
            {
                unsigned char* ws = KWS();
                SchedPlain S{(const char*)WSP(bf16_t, WS_HN), (const char*)(WSP(bf16_t, WS_W13) + (size_t)jf * 2 * DFF * D), (size_t)256 * D * 2, (size_t)256 * D * 2, need_ctx ? NMT : 64, 2 * DFF / 256, G, bx, !need_ctx, D / 64, D, D};
                pg8::EpiSwiGLU E{WSP(bf16_t, WS_H), DFF};
                pg8::gemm_phase<pg8::EpiSwiGLU, SchedPlain, true>(lds, fresh_tid(wave_s), S, E);
            }
#endif
            GRID_BAR(); TP(9);
#ifndef SKIP_F2
            {
                unsigned char* ws = KWS();
                SchedWR<DFF / 128> S{(const char*)WSP(bf16_t, WS_H), (const char*)(WSP(bf16_t, WS_W2) + (size_t)jf * D * DFF), (size_t)256 * DFF * 2, (size_t)256 * DFF * 2, 0, need_ctx ? NMT : 64, G, bx, !need_ctx, 1 << 30, 1 << 30, 1 << 30, 1 << 30, 1 << 30, 1 << 30, 1 << 30, DFF, DFF};
                pg8::EpiResid E{WSP(bf16_t, WS_XS), WSP(float, WS_MODS) + (size_t)l * 5 * INC + 5 * D};
                pg8::SKCtx X{ws + WS_PART, WSP(unsigned, WS_CTL) + CW_FLG + 8192 * (4 + jf), WSP(unsigned, WS_CTL) + CW_TMO, bx};
                pg8::gemm_phase<pg8::EpiResid, SchedWR<DFF / 128>, true>(lds, fresh_tid(wave_s), S, E, X);
            }
#endif
            GRID_BAR(); TP(10);
        } else {
#ifndef SKIP_GA
            {
                PHASE_IDS(); unsigned char* ws = KWS(); const bf16_t* HN = WSP(bf16_t, WS_HN); bf16_t* HS = WSP(bf16_t, WS_R2);
                const int* PE = (const int*)(ws + WS_META + MT_PE); const int* PPOS = (const int*)(ws + WS_META + MT_PPOS); const float* PW = (const float*)(ws + WS_META + MT_PW);
                int* DST = (int*)(ws + WS_META + MT_DST); float* CW = (float*)(ws + WS_META + MT_CW); const int* BC = (const int*)(ws + WS_META + MT_BC);
                const int nrows = need_ctx ? M : NB * SEQ, RPB = (nrows + G - 1) / G;
                LAS int* PRE = (LAS int*)lds; LAS int* LT = PRE + 8 * 256; LAS int* TOT = LT + 8 * 64;
                if (G <= 256) {
                    int c4[4], sum = 0;
#pragma unroll
                    for (int q = 0; q < 4; ++q) { const int b = 4 * lane + q; c4[q] = (b < G) ? BC[b * 8 + wave] : 0; sum += c4[q]; }
                    LT[wave * 64 + lane] = sum;
                    LDS_WAIT();
                    int pre = 0; for (int q = 0; q < lane; ++q) pre += LT[wave * 64 + q];
                    if (lane == 63) TOT[wave] = pre + sum;
#pragma unroll
                    for (int q = 0; q < 4; ++q) { PRE[(4 * lane + q) * 8 + wave] = pre; pre += c4[q]; }
                }
                LDS_WAIT(); __syncthreads();
                int ts[9]; ts[0] = 0;
#pragma unroll
                for (int e = 0; e < 8; ++e) ts[e + 1] = ts[e] + ((TOT[e] + 255) >> 8);
                if (bx == 0 && tid < 8) __hip_atomic_store(WSP(unsigned, WS_CTL) + CW_CNT + 1024 * jf + 64 * tid, (unsigned)TOT[tid], RLX_AGENT);
                unsigned char* HS8 = (unsigned char*)HS;
#pragma unroll 1
                for (int rr0 = gw; rr0 < nrows; rr0 += 4 * NGW) {
                    int row[4], pe[4][2], pp[4][2]; float pw[4][2]; u32x4 q[4]; bool ok[4];
#pragma unroll
                    for (int k = 0; k < 4; ++k) { const int rr = rr0 + k * NGW; ok[k] = rr < nrows; const int rc = ok[k] ? rr : rr0; row[k] = need_ctx ? rc : (rc / SEQ) * TPB + CTXL + (rc % SEQ); }
#pragma unroll
                    for (int k = 0; k < 4; ++k) { q[k] = *(const u32x4*)((const unsigned char*)HN + (size_t)row[k] * D + 16 * lane);
#pragma unroll
                        for (int s = 0; s < 2; ++s) { pe[k][s] = PE[2 * row[k] + s]; pp[k][s] = PPOS[2 * row[k] + s]; pw[k][s] = PW[2 * row[k] + s]; } }
#pragma unroll
                    for (int k = 0; k < 4; ++k) { const int rr = rr0 + k * NGW, blk = (ok[k] ? rr : rr0) / RPB;
                        if (ok[k]) {
#pragma unroll
                            for (int s = 0; s < 2; ++s) { const int e = pe[k][s], pos = pp[k][s] + PRE[blk * 8 + e];
                                int t0 = 0;
#pragma unroll
                                for (int kk = 1; kk < 8; ++kk) t0 = (e == kk) ? ts[kk] : t0;
                                const int d = 256 * t0 + pos;
                                *(u32x4*)(HS8 + (size_t)d * D + 16 * lane) = q[k];
                                if (lane == 0) { CW[d] = pw[k][s]; DST[2 * row[k] + s] = d; } } } }
                }
            }
#endif
            GRID_BAR(); TP(11);
#ifndef SKIP_E1
            {
                unsigned char* ws = KWS();
                int ts[9]; ts[0] = 0;
#pragma unroll
                for (int e = 0; e < 8; ++e) { const unsigned c = __hip_atomic_load(WSP(unsigned, WS_CTL) + CW_CNT + 1024 * jf + 64 * e, RLX_AGENT); ts[e + 1] = ts[e] + (int)((c + 255u) >> 8); }
                SchedMoE S{(const char*)(ws + WS_R2), (const char*)(ws + WS_E13 + (size_t)jf * 8 * 2 * DFE * D), (size_t)256 * D, (size_t)256 * D, (size_t)2 * DFE * D, ts[8], 2 * DFE / 256, G, bx, ts[1], ts[2], ts[3], ts[4], ts[5], ts[6], ts[7], D / 128, D / 2, D / 2};
                pg8::EpiSwiGLU8 E{ws + WS_H, DFE, 1.0f / (FP8_SC_X * FP8_SC_W13), FP8_SC_H};
                pg8::gemm_phase<pg8::EpiSwiGLU8, SchedMoE, true, true>(lds, fresh_tid(wave_s), S, E);
            }
#endif
            GRID_BAR(); TP(12);
#ifndef SKIP_E2
            {
                unsigned char* ws = KWS();
                int ts[9]; ts[0] = 0;
#pragma unroll
                for (int e = 0; e < 8; ++e) { const unsigned c = __hip_atomic_load(WSP(unsigned, WS_CTL) + CW_CNT + 1024 * jf + 64 * e, RLX_AGENT); ts[e + 1] = ts[e] + (int)((c + 255u) >> 8); }
                SchedWR<DFE / 256> S{(const char*)(ws + WS_H), (const char*)(ws + WS_E2 + (size_t)jf * 8 * D * DFE), (size_t)256 * DFE, (size_t)256 * DFE, (size_t)D * DFE, ts[8], G, bx, false, ts[1], ts[2], ts[3], ts[4], ts[5], ts[6], ts[7], DFE / 2, DFE / 2};
                pg8::EpiMoEDown E{WSP(bf16_t, WS_R2), (const float*)(ws + WS_META + MT_CW), 1.0f / (FP8_SC_H * FP8_SC_W2)};
                pg8::SKCtx X{ws + WS_PART, WSP(unsigned, WS_CTL) + CW_FLG + 8192 * (6 + jf), WSP(unsigned, WS_CTL) + CW_TMO, bx};
                pg8::gemm_phase<pg8::EpiMoEDown, SchedWR<DFE / 256>, true, true>(lds, fresh_tid(wave_s), S, E, X);
            }
#endif
            GRID_BAR(); TP(13);
        }
    }
#ifdef TPROBE
    { unsigned char* ws = KWS(); if (bx == 0 && fresh_tid(wave_s) < 16) WSP(unsigned, WS_RETC + 4096)[fresh_tid(wave_s)] = MISC[16 + fresh_tid(wave_s)]; }
    GRID_BAR();
#endif
    {
        PHASE_IDS(); unsigned char* ws = KWS(); const bf16_t* XS = WSP(bf16_t, WS_XS); const float* MODS = WSP(float, WS_MODS); const bf16_t* YY = WSP(bf16_t, WS_R2); const int* DST = (const int*)(ws + WS_META + MT_DST);
        const float* fgp = KIN(I_final_g); float* outp = KOUT();
        const unsigned tmo = __hip_atomic_load(WSP(unsigned, WS_CTL) + CW_BAR + XB_TMO, RLX_AGENT) | __hip_atomic_load(WSP(unsigned, WS_CTL) + CW_TMO, RLX_AGENT);
#pragma unroll 1
        for (int rr0 = gw; rr0 < NB * SEQ; rr0 += 4 * NGW) {
            int rrk[4], rowk[4], dk[4][2]; const float* gtk[4]; bool ok[4];
#pragma unroll
            for (int k = 0; k < 4; ++k) { const int rr = rr0 + k * NGW; ok[k] = rr < NB * SEQ; rrk[k] = ok[k] ? rr : rr0; const int b = rrk[k] / SEQ; rowk[k] = b * TPB + CTXL + (rrk[k] % SEQ);
                gtk[k] = MODS + ((size_t)3 * 5 + b) * INC + 5 * D; dk[k][0] = DST[2 * rowk[k]]; dk[k][1] = DST[2 * rowk[k] + 1]; }
            u32x2 xb[4][4], y0[4][4], y1[4][4]; f32x4 g4[4][4];
#pragma unroll
            for (int k = 0; k < 4; ++k)
#pragma unroll
                for (int j = 0; j < 4; ++j) { const int c = 4 * lane + 256 * j; xb[k][j] = *(const u32x2*)(XS + (size_t)rowk[k] * D + c);
                    y0[k][j] = *(const u32x2*)(YY + (size_t)dk[k][0] * D + c); y1[k][j] = *(const u32x2*)(YY + (size_t)dk[k][1] * D + c); g4[k][j] = *(const f32x4*)(gtk[k] + c); }
#pragma unroll
            for (int k = 0; k < 4; ++k) {
                const int rr = rrk[k];
                f32x4 v[4]; float ss = 0.f;
#pragma unroll
                for (int j = 0; j < 4; ++j) { v[j] = (f32x4){bflo(xb[k][j].x), bfhi(xb[k][j].x), bflo(xb[k][j].y), bfhi(xb[k][j].y)};
                    v[j][0] += g4[k][j][0] * (bflo(y0[k][j].x) + bflo(y1[k][j].x)); v[j][1] += g4[k][j][1] * (bfhi(y0[k][j].x) + bfhi(y1[k][j].x)); v[j][2] += g4[k][j][2] * (bflo(y0[k][j].y) + bflo(y1[k][j].y)); v[j][3] += g4[k][j][3] * (bfhi(y0[k][j].y) + bfhi(y1[k][j].y));
                    ss += (v[j][0] * v[j][0] + v[j][1] * v[j][1]) + (v[j][2] * v[j][2] + v[j][3] * v[j][3]); }
                float rs = rsqrtf(wave_sum(ss) * (1.0f / D) + EPS);
                if (tmo) rs = __builtin_nanf("");
                if (ok[k]) {
#pragma unroll
                    for (int j = 0; j < 4; ++j) { const int c = 4 * lane + 256 * j; const f32x4 fg = *(const f32x4*)(fgp + c); *(f32x4*)(outp + (size_t)rr * D + c) = v[j] * rs * fg; }
#ifdef TPROBE
            { const unsigned* T = WSP(unsigned, WS_RETC + 4096); const float c2 = (TPROBE_B >= 0 ? (float)T[TPROBE_B < 0 ? 0 : TPROBE_B] : (float)(T[0] + T[1] + T[2] + T[3] + T[4] + T[5] + T[6] + T[7] + T[8] + T[9] + T[10] + T[11] + T[12] + T[13])) * 0.01f * TPROBE_SB;
#pragma unroll
              for (int j = 0; j < 4; ++j) { const int c = 4 * lane + 256 * j; f32x4 o = (f32x4){100.f, 100.f, 100.f, 100.f}; if (rr == 0 && c == 0) o[0] = c2; *(f32x4*)(outp + (size_t)rr * D + c) = o; } }
#endif
                }
            }
        }
    }
#undef GRID_BAR
}

extern "C" void kernel_launch(void* const* d_in, const int* in_sizes, int n_in, void* d_out, int out_size, void* d_ws, size_t ws_size, hipStream_t stream) {
    static int grid = 0;
    if (grid == 0) {
        if (n_in != 28 || out_size != NB * SEQ * D || ws_size < WS_END) { fprintf(stderr, "kernel_launch: unexpected shapes: n_in %d out %d ws %zu (need %zu)\n", n_in, out_size, ws_size, (size_t)WS_END); grid = -1; return; }
        int dev = 0, cus = 0, per_cu = 0;
        if (hipGetDevice(&dev) != hipSuccess || hipDeviceGetAttribute(&cus, hipDeviceAttributeMultiprocessorCount, dev) != hipSuccess) { grid = -1; return; }
        if (hipFuncSetAttribute((const void*)fwd_kernel, hipFuncAttributeMaxDynamicSharedMemorySize, LDS_BYTES) != hipSuccess) { fprintf(stderr, "kernel_launch: hipFuncSetAttribute failed\n"); grid = -1; return; }
        if (hipOccupancyMaxActiveBlocksPerMultiprocessor(&per_cu, (const void*)fwd_kernel, NTHR, LDS_BYTES) != hipSuccess || per_cu < 1) fprintf(stderr, "kernel_launch: occupancy query reports %d\n", per_cu);
        (void)hipGetLastError();
        grid = cus < 256 ? cus : 256;
    }
    if (grid < 0) return;
    if (hipMemsetAsync((char*)d_ws + WS_CTL, 0, CTL_ZERO_BYTES, stream) != hipSuccess) return;
    Args a{};
    const float** pp = (const float**)&a.in;
    for (int i = 0; i < 28; ++i) pp[i] = (const float*)d_in[i];
    a.out = (float*)d_out; a.ws = (unsigned char*)d_ws;
    hipLaunchKernelGGL(fwd_kernel, dim3(grid), dim3(NTHR), LDS_BYTES, stream, a);
}
```
